# Optimizing an MI355X kernel written in HIP

```python
import math
import jax, jax.numpy as jnp
from jax import lax
import numpy as np

D_MODEL = 1024
BATCH = 2
SEQ = 8192
DEPTH = 2

N_MIXERS = 2
EPS = 1e-6
POOL_WINDOWS = (2, 4, 8, 16)
N_POOL_GROUPS = len(POOL_WINDOWS)
POOL_GROUP_DIM = D_MODEL // N_POOL_GROUPS
HEAD_DIM = 64
N_HEADS = D_MODEL // HEAD_DIM
D_ATTN = N_HEADS * HEAD_DIM
ATTN_PATTERNS = ((128, 1), (512, 4), (2048, 16))
N_ATTN_GROUPS = len(ATTN_PATTERNS)
HEAD_GROUPS = tuple(N_HEADS // N_ATTN_GROUPS + (1 if g < N_HEADS % N_ATTN_GROUPS else 0) for g in range(N_ATTN_GROUPS))
ROPE_THETA = 10000.0
D_FF = -(-8 * D_MODEL // (3 * 256)) * 256
N_POOL_LAYERS = (DEPTH + 1) // 2
N_ATTN_LAYERS = DEPTH // 2
NEG_INF = -1e30

kernel_name = "hybrid_pool_dilated_swa_swiglu"


def rmsnorm(x, g):
    xf = x.astype(jnp.float32)
    y = xf * lax.rsqrt(jnp.mean(xf * xf, axis=-1, keepdims=True) + EPS)
    return (y * g.astype(jnp.float32)).astype(x.dtype)


def rope(t):
    S, hd = t.shape[1], t.shape[-1]
    inv_freq = 1.0 / (ROPE_THETA ** (jnp.arange(0, hd, 2, dtype=jnp.float32) / hd))
    ang = jnp.arange(S, dtype=jnp.float32)[:, None] * inv_freq[None, :]
    ang = jnp.concatenate([ang, ang], axis=-1)[None, :, None, :]
    tf = t.astype(jnp.float32)
    t1, t2 = tf[..., : hd // 2], tf[..., hd // 2 :]
    rot = jnp.concatenate([-t2, t1], axis=-1)
    return (tf * jnp.cos(ang) + rot * jnp.sin(ang)).astype(t.dtype)


def pool_mixer(h, w_in, w_group, scale, w_out):
    B, S, _ = h.shape
    u = jnp.einsum('bsd,de->bse', h, w_in).reshape(B, S, N_POOL_GROUPS, POOL_GROUP_DIM)
    cs = jnp.cumsum(u.astype(jnp.float32), axis=1)
    pos = jnp.arange(S)
    outs = []
    for g, w in enumerate(POOL_WINDOWS):
        c = cs[:, :, g]
        lag = jnp.pad(c, ((0, 0), (w, 0), (0, 0)))[:, :S]
        cnt = jnp.minimum(pos + 1, w).astype(jnp.float32)[None, :, None]
        outs.append((c - lag) / cnt - u[:, :, g].astype(jnp.float32))
    p = jnp.stack(outs, axis=2).astype(h.dtype)
    z = jnp.einsum('bsgc,gce->bsge', p, w_group).reshape(B, S, D_MODEL) * scale
    return jnp.einsum('bsd,de->bse', z, w_out)


def dilated_window_attention(q, k, v, window, dilation):
    B, S, H, hd = q.shape
    w = window // dilation
    L = S // dilation
    nb = -(-L // w)
    Lp = nb * w

    def to_blocks(t):
        t = t.reshape(B, L, dilation, H, hd)
        t = jnp.pad(t, ((0, 0), (0, Lp - L), (0, 0), (0, 0), (0, 0)))
        return t.reshape(B, nb, w, dilation, H, hd)

    qb, kb, vb = to_blocks(q), to_blocks(k), to_blocks(v)

    def with_prev(t):
        prev = jnp.concatenate([jnp.zeros_like(t[:, :1]), t[:, :-1]], axis=1)
        return jnp.concatenate([prev, t], axis=2)

    kc, vc = with_prev(kb), with_prev(vb)
    s = jnp.einsum('bnqrhd,bnkrhd->bnrhqk', qb, kc).astype(jnp.float32)
    qi = jnp.arange(w)[:, None]
    kj = jnp.arange(2 * w)[None, :]
    dist = w + qi - kj
    key_idx = jnp.arange(nb)[:, None, None] * w - w + kj[None]
    mask = (dist >= 0)[None] & (dist <= w)[None] & (key_idx >= 0)
    s = jnp.where(mask[None, :, None, None], s, NEG_INF)
    m = jnp.max(s, axis=-1, keepdims=True)
    e = jnp.exp(s - m)
    den = jnp.sum(e, axis=-1, keepdims=True)
    p = (e / den).astype(v.dtype)
    o = jnp.einsum('bnrhqk,bnkrhd->bnqrhd', p, vc)
    lse = (m + jnp.log(den))[..., 0]
    lse = jnp.transpose(lse, (0, 1, 4, 2, 3))
    o = o.reshape(B, Lp, dilation, H, hd)[:, :L].reshape(B, S, H, hd)
    lse = lse.reshape(B, Lp, dilation, H)[:, :L].reshape(B, S, H)
    return o, lse


def attn_mixer(h, w_qkv, w_out):
    B, S, _ = h.shape
    qkv = jnp.einsum('bsd,de->bse', h, w_qkv).reshape(B, S, 3, N_HEADS, HEAD_DIM)
    q = rope(qkv[:, :, 0]) * jnp.asarray(HEAD_DIM ** -0.5, dtype=h.dtype)
    k = rope(qkv[:, :, 1])
    v = qkv[:, :, 2]
    outs, lses = [], []
    start = 0
    for (window, dilation), n_g in zip(ATTN_PATTERNS, HEAD_GROUPS):
        sl = slice(start, start + n_g)
        o_g, lse_g = dilated_window_attention(q[:, :, sl], k[:, :, sl], v[:, :, sl], window, dilation)
        outs.append(o_g)
        lses.append(jax.nn.logsumexp(lse_g, axis=-1) - math.log(n_g))
        start += n_g
    alpha = jax.nn.softmax(jnp.stack(lses, axis=-1), axis=-1)
    merged = jnp.concatenate(
        [o_g * (N_ATTN_GROUPS * alpha[:, :, g]).astype(o_g.dtype)[:, :, None, None] for g, o_g in enumerate(outs)],
        axis=2,
    ).reshape(B, S, D_ATTN)
    return jnp.einsum('bse,ed->bsd', merged, w_out)


def swiglu(h, w_gate, w_up, w_down):
    g = jnp.einsum('bsd,df->bsf', h, w_gate)
    u = jnp.einsum('bsd,df->bsf', h, w_up)
    return jnp.einsum('bsf,fd->bsd', jax.nn.silu(g) * u, w_down)


def setup_inputs(seed: int = 0) -> dict:
    key = jax.random.key(seed)
    ks = jax.random.split(key, 14)
    f32 = jnp.float32
    nrm = lambda k, shape, fan_in: jax.random.normal(k, shape, f32) * (fan_in ** -0.5)
    return {
        "x": jax.random.normal(ks[0], (BATCH, SEQ, D_MODEL), f32),
        "norm_mix": 1.0 + 0.05 * jax.random.normal(ks[1], (DEPTH, D_MODEL), f32),
        "norm_ffn": 1.0 + 0.05 * jax.random.normal(ks[2], (DEPTH, D_MODEL), f32),
        "norm_final": 1.0 + 0.05 * jax.random.normal(ks[3], (D_MODEL,), f32),
        "pool_w_in": nrm(ks[4], (N_POOL_LAYERS, D_MODEL, D_MODEL), D_MODEL),
        "pool_w_group": nrm(ks[5], (N_POOL_LAYERS, N_POOL_GROUPS, POOL_GROUP_DIM, POOL_GROUP_DIM), POOL_GROUP_DIM),
        "pool_scale": 1.0 + 0.1 * jax.random.normal(ks[6], (N_POOL_LAYERS, D_MODEL), f32),
        "pool_w_out": nrm(ks[7], (N_POOL_LAYERS, D_MODEL, D_MODEL), D_MODEL),
        "attn_w_qkv": nrm(ks[8], (N_ATTN_LAYERS, D_MODEL, 3 * D_ATTN), D_MODEL),
        "attn_w_out": nrm(ks[9], (N_ATTN_LAYERS, D_ATTN, D_MODEL), D_ATTN),
        "ffn_w_gate": nrm(ks[10], (DEPTH, D_MODEL, D_FF), D_MODEL),
        "ffn_w_up": nrm(ks[11], (DEPTH, D_MODEL, D_FF), D_MODEL),
        "ffn_w_down": nrm(ks[12], (DEPTH, D_FF, D_MODEL), D_FF),
    }


def reference(x, norm_mix, norm_ffn, norm_final, pool_w_in, pool_w_group, pool_scale, pool_w_out,
              attn_w_qkv, attn_w_out, ffn_w_gate, ffn_w_up, ffn_w_down):
    for i in range(DEPTH):
        h = rmsnorm(x, norm_mix[i])
        j = i // N_MIXERS
        if i % N_MIXERS == 0:
            y = pool_mixer(h, pool_w_in[j], pool_w_group[j], pool_scale[j], pool_w_out[j])
        else:
            y = attn_mixer(h, attn_w_qkv[j], attn_w_out[j])
        x = x + y
        h = rmsnorm(x, norm_ffn[i])
        x = x + swiglu(h, ffn_w_gate[i], ffn_w_up[i], ffn_w_down[i])
    return rmsnorm(x, norm_final)
```

```cpp
#include <hip/hip_runtime.h>
#include <hip/hip_cooperative_groups.h>
#include <cstdio>
#include <cstdint>
namespace cg = cooperative_groups;

#ifndef MK_N_LAUNCHES
#define MK_N_LAUNCHES 13
#endif

namespace pg8 {
#define PG8_LAS __attribute__((address_space(3)))
typedef unsigned short bf16_t;
typedef short bf16x8 __attribute__((ext_vector_type(8)));
typedef float f32x4 __attribute__((ext_vector_type(4)));
typedef unsigned u32x4 __attribute__((ext_vector_type(4)));
constexpr int BM = 256, BK = 64, HALF = 128, HTB = HALF * BK * 2, STAGE_BYTES = 8 * HTB, NXCD = 8, WGM = 8;

__host__ __device__ __forceinline__ int lds_byte(int r, int c) { const int st = (r >> 4) * 2 + (c >> 5), rr = r & 15, cc = c & 31, ob = rr * 64 + cc * 2; return st * 1024 + (ob ^ (((ob >> 9) & 1) << 5)); }
__host__ __device__ __forceinline__ void stage_rc(int b, int& R, int& C) { const int st = b / 1024, sb = b % 1024, swz = sb ^ (((sb >> 9) & 1) << 5); R = (st >> 1) * 16 + swz / 64; C = (st & 1) * 32 + (swz % 64) / 2; }
__host__ __device__ __forceinline__ int perm32(int rho) { const int n = rho >> 4, i = rho & 15; return 8 * (i >> 2) + 4 * n + (i & 3); }

struct Unit { int pm, pn; };
struct Gemm { const bf16_t* A; const bf16_t* Bt; int M, N, K, lda, ldb; size_t a_pn_bytes; };

struct StaticOrder {
    int nM, nN, nwg, G, c;
    __host__ __device__ void init(int M, int N, int G_, int c_) { nM = M / BM; nN = N / BM; nwg = nM * nN; G = G_; c = c_; }
    __host__ __device__ bool next(int i, Unit& u) const {
        const long L = (long)i * G + c; if (L >= nwg) return false;
        int wgid = (int)L; { const int q = nwg / NXCD, r = nwg % NXCD, xcd = wgid % NXCD, off = wgid / NXCD; wgid = (xcd < r ? xcd * (q + 1) : r * (q + 1) + (xcd - r) * q) + off; }
        const int nig = WGM * nN, gid = wgid / nig, fm = gid * WGM, gsz = (nM - fm) < WGM ? (nM - fm) : WGM;
        u.pm = fm + ((wgid % nig) % gsz); u.pn = (wgid % nig) / gsz; return true;
    }
};

__device__ __forceinline__ unsigned cvt_pk_bf16(float lo, float hi) { unsigned r; asm volatile("v_cvt_pk_bf16_f32 %0, %1, %2" : "=v"(r) : "v"(lo), "v"(hi)); return r; }

constexpr float RMS_EPS = 1e-6f;

struct EpiBf16 {
    bf16_t* O; int ldc;
    __device__ __forceinline__ void operator()(const f32x4 (&acc)[2][2][4][2], const Unit& u, int wr, int wc, int fr, int fq) const {
        const int row0 = u.pm * BM + wr * 64 + fr, col0 = u.pn * BM + wc * 32 + 8 * fq;
#pragma unroll
        for (int ai = 0; ai < 2; ++ai)
#pragma unroll
            for (int m = 0; m < 4; ++m) { bf16_t* rowp = O + (size_t)(row0 + ai * HALF + m * 16) * ldc + col0;
#pragma unroll
                for (int bj = 0; bj < 2; ++bj) { const f32x4 v0 = acc[ai][bj][m][0], v1 = acc[ai][bj][m][1];
                    u32x4 w; w.x = cvt_pk_bf16(v0[0], v0[1]); w.y = cvt_pk_bf16(v0[2], v0[3]); w.z = cvt_pk_bf16(v1[0], v1[1]); w.w = cvt_pk_bf16(v1[2], v1[3]);
                    *(u32x4*)(rowp + bj * HALF) = w; } }
    }
};
struct EpiRes {
    const float* base; float* out; bf16_t* xb; float* ss;
    __device__ __forceinline__ void operator()(const f32x4 (&acc)[2][2][4][2], const Unit& u, int wr, int wc, int fr, int fq) const {
        const int row0 = u.pm * BM + wr * 64 + fr, col0 = u.pn * BM + wc * 32 + 8 * fq;
#pragma unroll
        for (int ai = 0; ai < 2; ++ai)
#pragma unroll
            for (int m = 0; m < 4; ++m) { const size_t row = (size_t)(row0 + ai * HALF + m * 16); const size_t off = row * 1024 + col0; float s = 0.f;
#pragma unroll
                for (int bj = 0; bj < 2; ++bj) {
                    const f32x4 b0 = *(const f32x4*)(base + off + bj * HALF), b1 = *(const f32x4*)(base + off + bj * HALF + 4);
                    const f32x4 v0 = acc[ai][bj][m][0] + b0, v1 = acc[ai][bj][m][1] + b1;
                    *(f32x4*)(out + off + bj * HALF) = v0; *(f32x4*)(out + off + bj * HALF + 4) = v1;
                    s += (v0[0] * v0[0] + v0[1] * v0[1]) + (v0[2] * v0[2] + v0[3] * v0[3]) + (v1[0] * v1[0] + v1[1] * v1[1]) + (v1[2] * v1[2] + v1[3] * v1[3]);
                    u32x4 w; w.x = cvt_pk_bf16(v0[0], v0[1]); w.y = cvt_pk_bf16(v0[2], v0[3]); w.z = cvt_pk_bf16(v1[0], v1[1]); w.w = cvt_pk_bf16(v1[2], v1[3]);
                    *(u32x4*)(xb + off + bj * HALF) = w; }
                s += __shfl_xor(s, 16); s += __shfl_xor(s, 32);
                if (fq == 0) ss[row * 16 + u.pn * 4 + wc] = s; }
    }
};
__device__ __forceinline__ float row_rstd(const float* ss, size_t row, int fq) {
    const f32x4 p = *(const f32x4*)(ss + row * 16 + 4 * fq); float s = (p[0] + p[1]) + (p[2] + p[3]);
    s += __shfl_xor(s, 16); s += __shfl_xor(s, 32);
    return rsqrtf(s * (1.0f / 1024.0f) + RMS_EPS);
}
struct EpiSwiGLU {
    bf16_t* act; const float* ss; int ldc;
    __device__ __forceinline__ void operator()(const f32x4 (&acc)[2][2][4][2], const Unit& u, int wr, int wc, int fr, int fq) const {
        const int row0 = u.pm * BM + wr * 64 + fr, col0 = u.pn * HALF + wc * 32 + 8 * fq;
#pragma unroll
        for (int ai = 0; ai < 2; ++ai)
#pragma unroll
            for (int m = 0; m < 4; ++m) { const size_t row = (size_t)(row0 + ai * HALF + m * 16); const float rstd = row_rstd(ss, row, fq);
                float a[8];
#pragma unroll
                for (int n = 0; n < 2; ++n)
#pragma unroll
                    for (int i = 0; i < 4; ++i) { const float g = acc[ai][0][m][n][i] * rstd, up = acc[ai][1][m][n][i] * rstd;
                        a[n * 4 + i] = g * up * __builtin_amdgcn_rcpf(1.0f + __builtin_amdgcn_exp2f(-1.4426950408889634f * g)); }
                u32x4 w; w.x = cvt_pk_bf16(a[0], a[1]); w.y = cvt_pk_bf16(a[2], a[3]); w.z = cvt_pk_bf16(a[4], a[5]); w.w = cvt_pk_bf16(a[6], a[7]);
                *(u32x4*)(act + row * ldc + col0) = w; }
    }
};
struct EpiQKV {
    bf16_t* qkv; const float* ss; const float* rope;
    __device__ __forceinline__ void operator()(const f32x4 (&acc)[2][2][4][2], const Unit& u, int wr, int wc, int fr, int fq) const {
        const int row0 = u.pm * BM + wr * 64 + fr; const int sect = u.pn >> 2, head = (u.pn & 3) * 4 + wc;
        const int dsh = head < 6 ? 0 : (head < 11 ? 2 : 4);
        bf16_t* dst = qkv + (size_t)sect * ((size_t)16384 * 1024);
        const float qs = sect == 0 ? 0.125f * 1.4426950408889634f : 1.0f;
#pragma unroll
        for (int ai = 0; ai < 2; ++ai)
#pragma unroll
            for (int m = 0; m < 4; ++m) { const int row = row0 + ai * HALF + m * 16; const float rstd = row_rstd(ss, (size_t)row, fq) * qs;
                const int b = row >> 13, t = row & 8191; const int pos = ((t & ((1 << dsh) - 1)) << (13 - dsh)) + (t >> dsh);
                bf16_t* o = dst + ((size_t)(b * 16 + head) * 8192 + pos) * 64 + 8 * fq;
                float lo[8], hi[8];
#pragma unroll
                for (int n = 0; n < 2; ++n)
#pragma unroll
                    for (int i = 0; i < 4; ++i) { lo[n * 4 + i] = acc[ai][0][m][n][i] * rstd; hi[n * 4 + i] = acc[ai][1][m][n][i] * rstd; }
                if (sect < 2) {
                    const float* rp = rope + (size_t)t * 64 + 8 * fq;
                    const f32x4 c0 = *(const f32x4*)(rp), c1 = *(const f32x4*)(rp + 4), s0 = *(const f32x4*)(rp + 32), s1 = *(const f32x4*)(rp + 36);
#pragma unroll
                    for (int i = 0; i < 8; ++i) { const float cs = i < 4 ? c0[i & 3] : c1[i & 3], sn = i < 4 ? s0[i & 3] : s1[i & 3];
                        const float l = lo[i], h = hi[i]; lo[i] = l * cs - h * sn; hi[i] = h * cs + l * sn; }
                }
                u32x4 w; w.x = cvt_pk_bf16(lo[0], lo[1]); w.y = cvt_pk_bf16(lo[2], lo[3]); w.z = cvt_pk_bf16(lo[4], lo[5]); w.w = cvt_pk_bf16(lo[6], lo[7]);
                *(u32x4*)(o) = w;
                w.x = cvt_pk_bf16(hi[0], hi[1]); w.y = cvt_pk_bf16(hi[2], hi[3]); w.z = cvt_pk_bf16(hi[4], hi[5]); w.w = cvt_pk_bf16(hi[6], hi[7]);
                *(u32x4*)(o + 32) = w; }
    }
};

template <class Epi, class Sched, bool ALIGN_EPI>
__device__ __forceinline__ void gemm_phase(PG8_LAS unsigned char* lds, const Gemm g, const Sched& S, const Epi& E) {
    int tid = threadIdx.x; asm volatile("" : "+v"(tid));
    const int wid = __builtin_amdgcn_readfirstlane(tid >> 6), lane = tid & 63, wr = wid >> 2, wc = wid & 3, fr = lane & 15, fq = lane >> 4;
    const int K = g.K, nt = K / BK;
    unsigned voffA[2], voffB[2];
#pragma unroll
    for (int i = 0; i < 2; ++i) { int R, C; stage_rc(tid * 16 + i * 8192, R, C); const int Rb = (R & ~31) + perm32(R & 31);
        voffA[i] = (unsigned)(R * g.lda + C) * 2u; voffB[i] = (unsigned)(Rb * g.ldb + C) * 2u; }
    const size_t kstep = (size_t)(BK * 2);
    const size_t hstepA = (size_t)HALF * g.lda * 2, hstepB = (size_t)HALF * g.ldb * 2;
    const size_t tstepA = 2 * hstepA, tstepB = 2 * hstepB;
    const unsigned ldsw = (unsigned)wid * 1024u;
    const int aoff = lds_byte(wr * 64 + fr, fq * 8), boff = lds_byte(wc * 32 + fr, fq * 8);
#define PG8_SA(b, h) (((b) * 2 + (h)) * HTB)
#define PG8_SB(b, h) ((4 + (b) * 2 + (h)) * HTB)
#define PG8_STAGE(bufoff, gbase, voff) do { _Pragma("unroll") for (int _i = 0; _i < 2; ++_i) \
        __builtin_amdgcn_global_load_lds((const unsigned*)((const char*)(gbase) + (voff)[_i]), (PG8_LAS unsigned*)(lds + (bufoff) + ldsw + _i * 8192), 16, 0, 0); } while (0)
#define PG8_LDA(dst, b, h) do { _Pragma("unroll") for (int m = 0; m < 4; ++m) _Pragma("unroll") for (int k = 0; k < 2; ++k) dst[m][k] = *(const PG8_LAS bf16x8*)(lds + PG8_SA(b, h) + aoff + m * 2048 + k * 1024); } while (0)
#define PG8_LDB(dst, b, h) do { _Pragma("unroll") for (int n = 0; n < 2; ++n) _Pragma("unroll") for (int k = 0; k < 2; ++k) dst[n][k] = *(const PG8_LAS bf16x8*)(lds + PG8_SB(b, h) + boff + n * 2048 + k * 1024); } while (0)
#define PG8_MMA(ai, bj, At, Bt) do { __builtin_amdgcn_s_setprio(1); _Pragma("unroll") for (int m = 0; m < 4; ++m) _Pragma("unroll") for (int n = 0; n < 2; ++n) _Pragma("unroll") for (int k = 0; k < 2; ++k) \
        acc[ai][bj][m][n] = __builtin_amdgcn_mfma_f32_16x16x32_bf16(Bt[n][k], At[m][k], acc[ai][bj][m][n], 0, 0, 0); __builtin_amdgcn_s_setprio(0); } while (0)
#define PG8_WAIT_V(n) asm volatile("s_waitcnt vmcnt(" #n ")" ::: "memory")
#define PG8_WAIT_L(n) asm volatile("s_waitcnt lgkmcnt(" #n ")" ::: "memory")
#define PG8_BAR __builtin_amdgcn_s_barrier()
#define PG8_SCHED __builtin_amdgcn_sched_barrier(0)
    Unit cur, nxt; int ui = 0;
    if (!S.next(0, cur)) return;
    f32x4 acc[2][2][4][2];
#pragma unroll
    for (int a = 0; a < 2; ++a)
#pragma unroll
        for (int b = 0; b < 2; ++b)
#pragma unroll
            for (int m = 0; m < 4; ++m)
#pragma unroll
                for (int n = 0; n < 2; ++n) acc[a][b][m][n] = (f32x4){0.f, 0.f, 0.f, 0.f};
    bf16x8 At[4][2], B0[2][2], B1[2][2];
    const char* cA = (const char*)g.A + (size_t)cur.pm * tstepA + (size_t)cur.pn * g.a_pn_bytes; const char* cB = (const char*)g.Bt + (size_t)cur.pn * tstepB;
    PG8_STAGE(PG8_SB(0, 0), cB, voffB); PG8_STAGE(PG8_SB(0, 1), cB + hstepB, voffB); PG8_STAGE(PG8_SA(0, 0), cA, voffA); PG8_STAGE(PG8_SA(0, 1), cA + hstepA, voffA);
    if (wr == 1) PG8_BAR;
    PG8_WAIT_V(2); PG8_BAR;
    PG8_STAGE(PG8_SB(1, 0), cB + kstep, voffB); PG8_STAGE(PG8_SA(1, 0), cA + kstep, voffA); PG8_STAGE(PG8_SB(1, 1), cB + hstepB + kstep, voffB);
    PG8_WAIT_V(6); PG8_BAR;
    for (;;) {
        const bool has_next = S.next(ui + 1, nxt);
        const char* nA = has_next ? (const char*)g.A + (size_t)nxt.pm * tstepA + (size_t)nxt.pn * g.a_pn_bytes : cA; const char* nB = has_next ? (const char*)g.Bt + (size_t)nxt.pn * tstepB : cB;
        for (int t = 0; t < nt; t += 2) {
            const bool last = (t == nt - 2);
            const char* a1 = cA + (size_t)(t + 1) * kstep;
            const char* a2 = last ? nA : cA + (size_t)(t + 2) * kstep; const char* b2 = last ? nB : cB + (size_t)(t + 2) * kstep;
            const char* a3 = a2 + kstep; const char* b3 = b2 + kstep;
            PG8_LDB(B0, 0, 0); PG8_LDB(B1, 0, 1); PG8_SCHED; PG8_LDA(At, 0, 0); PG8_STAGE(PG8_SA(1, 1), a1 + hstepA, voffA);
            PG8_WAIT_V(8); PG8_WAIT_L(0); PG8_BAR; PG8_MMA(0, 0, At, B0); PG8_MMA(0, 1, At, B1); PG8_BAR; PG8_SCHED;
            PG8_LDA(At, 0, 1); PG8_STAGE(PG8_SB(0, 0), b2, voffB); PG8_STAGE(PG8_SB(0, 1), b2 + hstepB, voffB); PG8_STAGE(PG8_SA(0, 0), a2, voffA);
            PG8_WAIT_V(8); PG8_WAIT_L(0); PG8_BAR; PG8_MMA(1, 0, At, B0); PG8_MMA(1, 1, At, B1); PG8_BAR; PG8_SCHED;
            PG8_LDB(B0, 1, 0); PG8_LDB(B1, 1, 1); PG8_SCHED; PG8_LDA(At, 1, 0); PG8_STAGE(PG8_SA(0, 1), a2 + hstepA, voffA);
            PG8_WAIT_V(8); PG8_WAIT_L(0); PG8_BAR; PG8_MMA(0, 0, At, B0); PG8_MMA(0, 1, At, B1); PG8_BAR; PG8_SCHED;
            PG8_LDA(At, 1, 1); PG8_STAGE(PG8_SB(1, 0), b3, voffB); PG8_STAGE(PG8_SB(1, 1), b3 + hstepB, voffB); PG8_STAGE(PG8_SA(1, 0), a3, voffA);
            PG8_WAIT_V(8); PG8_WAIT_L(0); PG8_BAR; PG8_MMA(1, 0, At, B0); PG8_MMA(1, 1, At, B1); PG8_BAR; PG8_SCHED;
        }
        if constexpr (ALIGN_EPI) { if (wr == 0) PG8_BAR; }
        E(acc, cur, wr, wc, fr, fq);
        if (!has_next) break;
#pragma unroll
        for (int a = 0; a < 2; ++a)
#pragma unroll
            for (int b = 0; b < 2; ++b)
#pragma unroll
                for (int m = 0; m < 4; ++m)
#pragma unroll
                    for (int n = 0; n < 2; ++n) acc[a][b][m][n] = (f32x4){0.f, 0.f, 0.f, 0.f};
        cur = nxt; cA = nA; cB = nB; ++ui;
        if constexpr (ALIGN_EPI) { if (wr == 1) PG8_BAR; }
    }
    PG8_WAIT_V(0);
    if constexpr (!ALIGN_EPI) { if (wr == 0) PG8_BAR; }
    PG8_BAR;
#undef PG8_SA
#undef PG8_SB
#undef PG8_STAGE
#undef PG8_LDA
#undef PG8_LDB
#undef PG8_MMA
#undef PG8_WAIT_V
#undef PG8_WAIT_L
#undef PG8_BAR
#undef PG8_SCHED
}
}

constexpr int NWAVES = 8;
constexpr int BATCH = 2, SEQ = 8192, D = 1024, H = 16, HD = 64, FF = 2816;
constexpr int M = BATCH * SEQ;
constexpr size_t MiB = 1u << 20;
constexpr size_t WS_CTL = 0, CTL_ZERO_BYTES = 64 * 1024;
constexpr size_t WS_ROPE = 1 * MiB;
constexpr size_t WS_SS = 3 * MiB;
constexpr size_t WS_LSE = 4 * MiB;
constexpr size_t WS_WIN = 6 * MiB;
constexpr size_t WS_WG = 8 * MiB;
constexpr size_t WS_WPO = 9 * MiB;
constexpr size_t WS_WGU0 = 11 * MiB;
constexpr size_t WS_WD0 = 22 * MiB;
constexpr size_t WS_WQKV = 28 * MiB;
constexpr size_t WS_WAO = 34 * MiB;
constexpr size_t WS_WGU1 = 36 * MiB;
constexpr size_t WS_WD1 = 47 * MiB;
constexpr size_t WS_BIG = 56 * MiB;
constexpr size_t WS_XB = 184 * MiB;
constexpr size_t WS_ZO = 216 * MiB;
constexpr size_t WS_END = 248 * MiB;
constexpr int CW_BAR = 1024;

constexpr int LDS_BYTES = 147456;

#define GAS __attribute__((address_space(1)))
#define LAS __attribute__((address_space(3)))
typedef unsigned short bf16;
typedef unsigned v4u __attribute__((ext_vector_type(4)));
typedef unsigned v2u __attribute__((ext_vector_type(2)));
typedef float f32x4 __attribute__((ext_vector_type(4)));
#define LDS_WAIT() asm volatile("s_waitcnt lgkmcnt(0)" ::: "memory")
__device__ __forceinline__ unsigned f2bf(float f) { unsigned u = __builtin_bit_cast(unsigned, f); return (u + 0x7fffu + ((u >> 16) & 1u)) >> 16; }
__device__ __forceinline__ unsigned pk2(float lo, float hi) { return f2bf(lo) | (f2bf(hi) << 16); }
__device__ __forceinline__ float bflo(unsigned w) { return __builtin_bit_cast(float, w << 16); }
__device__ __forceinline__ float bfhi(unsigned w) { return __builtin_bit_cast(float, w & 0xffff0000u); }

#define XB_TMO      128
#define XB_XCNT(j)  (256  + 64 * (j))
#define XB_XSUB(j)  (1280 + 64 * (j))
#define XB_XGEN(j)  (2304 + 64 * (j))
#define XB_TOP      3328
#define XB_TOPGEN   3392
#define XCD_BAR_WORDS 3456
#define XB_SPIN_CAP (1u << 22)
__device__ __forceinline__ unsigned xb_ld(unsigned* p)              { return __hip_atomic_load(p, __ATOMIC_RELAXED, __HIP_MEMORY_SCOPE_AGENT); }
__device__ __forceinline__ unsigned xb_add(unsigned* p, unsigned v) { return __hip_atomic_fetch_add(p, v, __ATOMIC_RELAXED, __HIP_MEMORY_SCOPE_AGENT); }
__device__ __forceinline__ unsigned xb_xcc_id() { return (unsigned)__builtin_amdgcn_s_getreg((3 << 11) | 20) & 0xFu; }
#define XB_SPIN(cond, bar) do { unsigned _sp = 0; while (cond) { __builtin_amdgcn_s_sleep(1); \
    if ((++_sp & 255u) == 0u) { if (xb_ld(&(bar)[XB_TMO])) break; if (_sp > XB_SPIN_CAP) { atomicAdd(&(bar)[XB_TMO], 1u); break; } } } } while (0)
struct XcdBarrier { unsigned* bar; unsigned x; volatile LAS unsigned* st; };
__device__ __forceinline__ XcdBarrier xcd_barrier_post(unsigned* bar, volatile LAS unsigned* st) {
    XcdBarrier b; b.bar = bar; b.x = xb_xcc_id(); b.st = st;
    if (threadIdx.x == 0) (void)xb_add(&bar[XB_XCNT(b.x)], 1u);
    return b;
}
__device__ __forceinline__ void xcd_barrier_complete(unsigned* bar, unsigned x, unsigned& nloc, unsigned& nx) {
    const unsigned G = gridDim.x * gridDim.y * gridDim.z;
    unsigned sum, cnt, mine, sp = 0u;
    for (;;) {
        sum = 0u; cnt = 0u; mine = 0u;
#pragma unroll
        for (unsigned j = 0; j < 16; ++j) { const unsigned c = xb_ld(&bar[XB_XCNT(j)]); sum += c; cnt += (c > 0u) ? 1u : 0u; mine = (j == x) ? c : mine; }
        if (sum == G) break;
        __builtin_amdgcn_s_sleep(1);
        if ((++sp & 255u) == 0u) { if (xb_ld(&bar[XB_TMO])) break; if (sp > XB_SPIN_CAP) { atomicAdd(&bar[XB_TMO], 1u); break; } }
    }
    nloc = mine > 0u ? mine : 1u; nx = cnt > 0u ? cnt : 1u;
}
__device__ __forceinline__ void xcd_barrier(const XcdBarrier& b) {
    asm volatile("s_waitcnt vmcnt(0)" ::: "memory");
    __syncthreads();
    if (threadIdx.x == 0) {
        unsigned* bar = b.bar;
        __builtin_amdgcn_s_waitcnt(0);
        unsigned nloc = b.st[0], nx = b.st[1];
        if (nloc == 0u) { xcd_barrier_complete(bar, b.x, nloc, nx); b.st[0] = nloc; b.st[1] = nx; }
        const unsigned old = xb_add(&bar[XB_XSUB(b.x)], 1u);
        const unsigned gen = old / nloc;
        if (old + 1u == (gen + 1u) * nloc) {
            __builtin_amdgcn_fence(__ATOMIC_RELEASE, "agent");
            asm volatile("s_waitcnt vmcnt(0)" ::: "memory");
            const unsigned og = xb_add(&bar[XB_TOP], 1u);
            const unsigned tg = og / nx;
            if (og + 1u == (tg + 1u) * nx) xb_add(&bar[XB_TOPGEN], 1u);
            else XB_SPIN(xb_ld(&bar[XB_TOPGEN]) == tg, bar);
            __builtin_amdgcn_fence(__ATOMIC_ACQUIRE, "agent");
            xb_add(&bar[XB_XGEN(b.x)], 1u);
            asm volatile("s_waitcnt vmcnt(0)" ::: "memory");
        } else {
            XB_SPIN(xb_ld(&bar[XB_XGEN(b.x)]) == gen, bar);
            __builtin_amdgcn_fence(__ATOMIC_ACQUIRE, "agent");
            asm volatile("s_waitcnt vmcnt(0)" ::: "memory");
        }
    }
    __syncthreads();
}

struct Frame {
    LAS unsigned char* lds;
    int tid, lane, wave, vcu, G;
};
__device__ __forceinline__ float wave_sum(float v) {
#pragma unroll
    for (int o = 1; o < 64; o <<= 1) v += __shfl_xor(v, o);
    return v;
}

__device__ __forceinline__ void p0_tr_item(const float* W, int K, int N, bf16* WT, int mode, int sel, int row_off, const float* kgain, const float* nscale, LAS float* scr, int item, int lane) {
    const int nblk = N / 32, kb = item / nblk, nb = item % nblk, k0 = 64 * kb, n0 = 32 * nb;
    const float ns = nscale ? nscale[n0 + (lane & 31)] : 1.0f;
#pragma unroll 8
    for (int i = 0; i < 32; ++i) { const int kk = 2 * i + (lane >> 5); float v = W[(size_t)(k0 + kk) * N + n0 + (lane & 31)] * ns; if (kgain) v *= kgain[k0 + kk]; scr[kk * 33 + (lane & 31)] = v; }
    LDS_WAIT(); asm volatile("" ::: "memory");
    int rb;
    if (mode == 0) rb = row_off + n0;
    else if (mode == 1) rb = 256 * (n0 >> 7) + 128 * sel + (n0 & 127);
    else { const int pn = n0 >> 8, w = n0 & 255, wc = w >> 6, bj = (w & 63) >> 5; rb = 256 * pn + 128 * bj + 32 * wc; }
    const int c = lane & 7;
#pragma unroll
    for (int j = 0; j < 4; ++j) { const int n = (lane >> 3) + 8 * j; const LAS float* s = scr + (8 * c) * 33 + n;
        v4u o; o.x = pk2(s[0 * 33], s[1 * 33]); o.y = pk2(s[2 * 33], s[3 * 33]); o.z = pk2(s[4 * 33], s[5 * 33]); o.w = pk2(s[6 * 33], s[7 * 33]);
        *(GAS v4u*)(WT + (size_t)(rb + n) * K + k0 + 8 * c) = o; }
    LDS_WAIT(); asm volatile("" ::: "memory");
}

struct Args { const float* in[13]; float* out; unsigned char* ws; int ph_lo, ph_hi; };

__device__ __forceinline__ void sincos_acc(float angf, float& c, float& s) {
    const double x = (double)angf; const double k = __builtin_rint(x * 0.15915494309189535);
    double y = (x - k * 6.283185307179586) * 0.25;
    const double y2 = y * y;
    double sn = y * (1.0 + y2 * (-1.0 / 6 + y2 * (1.0 / 120 + y2 * (-1.0 / 5040 + y2 * (1.0 / 362880 + y2 * (-1.0 / 39916800 + y2 * (1.0 / 6227020800.0)))))));
    double cs = 1.0 + y2 * (-0.5 + y2 * (1.0 / 24 + y2 * (-1.0 / 720 + y2 * (1.0 / 40320 + y2 * (-1.0 / 3628800 + y2 * (1.0 / 479001600.0 + y2 * (-1.0 / 87178291200.0)))))));
#pragma unroll
    for (int i = 0; i < 2; ++i) { const double s2 = 2.0 * sn * cs, c2 = 1.0 - 2.0 * sn * sn; sn = s2; cs = c2; }
    c = (float)cs; s = (float)sn;
}

__device__ __forceinline__ void p0_prologue(Frame& F, const Args& a) {
    unsigned char* ws = a.ws;
    LAS float* scr = (LAS float*)(F.lds + F.wave * 16384);
    const int gw = F.vcu * NWAVES + F.wave, NGW = F.G * NWAVES;
    constexpr int I_SQ = 16 * 32, I_WG = 4 * 8, I_GU = 16 * 88, I_DN = 44 * 32, I_QKV = 16 * 96;
    constexpr int NITEMS = I_SQ + 4 * I_WG + I_SQ + 3 * I_GU + I_QKV + I_SQ + 3 * I_GU;
    static_assert(I_GU == I_DN, "items");
    const float* norm_mix = a.in[1]; const float* norm_ffn = a.in[2];
    for (int it = gw; it < NITEMS; it += NGW) {
        int r = it;
        if (r < I_SQ) { p0_tr_item(a.in[4], D, D, (bf16*)(ws + WS_WIN), 0, 0, 0, nullptr, nullptr, scr, r, F.lane); continue; } r -= I_SQ;
        if (r < 4 * I_WG) { const int g = r / I_WG; p0_tr_item(a.in[5] + (size_t)g * 256 * 256, 256, 256, (bf16*)(ws + WS_WG), 0, 0, g * 256, nullptr, a.in[6] + g * 256, scr, r % I_WG, F.lane); continue; } r -= 4 * I_WG;
        if (r < I_SQ) { p0_tr_item(a.in[7], D, D, (bf16*)(ws + WS_WPO), 0, 0, 0, nullptr, nullptr, scr, r, F.lane); continue; } r -= I_SQ;
        if (r < I_GU) { p0_tr_item(a.in[10], D, FF, (bf16*)(ws + WS_WGU0), 1, 0, 0, norm_ffn, nullptr, scr, r, F.lane); continue; } r -= I_GU;
        if (r < I_GU) { p0_tr_item(a.in[11], D, FF, (bf16*)(ws + WS_WGU0), 1, 1, 0, norm_ffn, nullptr, scr, r, F.lane); continue; } r -= I_GU;
        if (r < I_DN) { p0_tr_item(a.in[12], FF, D, (bf16*)(ws + WS_WD0), 0, 0, 0, nullptr, nullptr, scr, r, F.lane); continue; } r -= I_DN;
        if (r < I_QKV) { p0_tr_item(a.in[8], D, 3 * D, (bf16*)(ws + WS_WQKV), 2, 0, 0, norm_mix + D, nullptr, scr, r, F.lane); continue; } r -= I_QKV;
        if (r < I_SQ) { p0_tr_item(a.in[9], D, D, (bf16*)(ws + WS_WAO), 0, 0, 0, nullptr, nullptr, scr, r, F.lane); continue; } r -= I_SQ;
        if (r < I_GU) { p0_tr_item(a.in[10] + (size_t)D * FF, D, FF, (bf16*)(ws + WS_WGU1), 1, 0, 0, norm_ffn + D, nullptr, scr, r, F.lane); continue; } r -= I_GU;
        if (r < I_GU) { p0_tr_item(a.in[11] + (size_t)D * FF, D, FF, (bf16*)(ws + WS_WGU1), 1, 1, 0, norm_ffn + D, nullptr, scr, r, F.lane); continue; } r -= I_GU;
        p0_tr_item(a.in[12] + (size_t)D * FF, FF, D, (bf16*)(ws + WS_WD1), 0, 0, 0, nullptr, nullptr, scr, r, F.lane);
    }
    {
        float* rope = (float*)(ws + WS_ROPE);
        for (int e = (F.vcu * NWAVES * 64 + F.tid); e < SEQ * 32; e += F.G * NWAVES * 64) {
            const int t = e >> 5, j = e & 31;
            const float invf = (float)(1.0 / (double)(float)exp2(13.287712379549449 * (double)j / 32.0));
            const float ang = (float)t * invf; float c, s; sincos_acc(ang, c, s);
            rope[(size_t)t * 64 + j] = c; rope[(size_t)t * 64 + 32 + j] = s;
        }
    }
    __syncthreads();
    {
        const float* x = a.in[0]; const float* g0 = norm_mix;
        bf16* hp = (bf16*)(ws + WS_BIG);
        LAS float* rs = (LAS float*)(F.lds + 131072);
        const int half = F.tid >> 8, c4 = F.tid & 255, wq = F.wave & 3;
        const f32x4 gv = *(const f32x4*)(g0 + 4 * c4);
        for (int blk = F.vcu; blk < M / 64; blk += F.G) {
            const int R0 = blk * 64 + half * 32;
            const bool bstart = (R0 & (SEQ - 1)) == 0;
            for (int k = wq; k < 48; k += 4) {
                const int row = R0 - 16 + k; float r = 0.f;
                if (!(bstart && k < 16)) {
                    const GAS f32x4* xr = (const GAS f32x4*)(x + (size_t)row * D) + F.lane; float s = 0.f;
#pragma unroll
                    for (int j = 0; j < 4; ++j) { const f32x4 v = xr[64 * j]; s += (v[0] * v[0] + v[1] * v[1]) + (v[2] * v[2] + v[3] * v[3]); }
                    r = rsqrtf(wave_sum(s) * (1.0f / D) + 1e-6f);
                }
                if (F.lane == 0) rs[half * 48 + k] = r;
            }
            LDS_WAIT(); __syncthreads();
            f32x4 ring[16];
#pragma unroll
            for (int j = 0; j < 16; ++j) ring[j] = (f32x4){0.f, 0.f, 0.f, 0.f};
            f32x4 S2 = ring[0], S4 = ring[0], S8 = ring[0], S16 = ring[0];
            for (int kk = 0; kk < 3; ++kk) {
#pragma unroll
                for (int j = 0; j < 16; ++j) {
                    const int k = kk * 16 + j, row = R0 - 16 + k;
                    f32x4 hv = (f32x4){0.f, 0.f, 0.f, 0.f};
                    if (!(bstart && kk == 0)) { const f32x4 xv = *(const GAS f32x4*)(x + (size_t)row * D + 4 * c4); hv = xv * rs[half * 48 + k] * gv; }
                    S2 = S2 + hv - ring[(j + 14) & 15]; S4 = S4 + hv - ring[(j + 12) & 15]; S8 = S8 + hv - ring[(j + 8) & 15]; S16 = S16 + hv - ring[j];
                    ring[j] = hv;
                    if (kk > 0) {
                        const int t = row & (SEQ - 1);
                        const float i2 = t >= 1 ? 0.5f : 1.0f, i4 = t >= 3 ? 0.25f : 1.0f / (float)(t + 1), i8 = t >= 7 ? 0.125f : 1.0f / (float)(t + 1), i16 = t >= 15 ? 0.0625f : 1.0f / (float)(t + 1);
                        const f32x4 o2 = S2 * i2 - hv, o4 = S4 * i4 - hv, o8 = S8 * i8 - hv, o16 = S16 * i16 - hv;
                        const size_t off = (size_t)row * D + 4 * c4;
                        *(GAS v2u*)(hp + off) = (v2u){pk2(o2[0], o2[1]), pk2(o2[2], o2[3])};
                        *(GAS v2u*)(hp + (size_t)M * D + off) = (v2u){pk2(o4[0], o4[1]), pk2(o4[2], o4[3])};
                        *(GAS v2u*)(hp + 2 * (size_t)M * D + off) = (v2u){pk2(o8[0], o8[1]), pk2(o8[2], o8[3])};
                        *(GAS v2u*)(hp + 3 * (size_t)M * D + off) = (v2u){pk2(o16[0], o16[1]), pk2(o16[2], o16[3])};
                    }
                }
            }
            __syncthreads();
        }
    }
}

namespace att {
typedef short bf16x8 __attribute__((ext_vector_type(8)));
typedef short s16x4 __attribute__((ext_vector_type(4)));
typedef float f32x16 __attribute__((ext_vector_type(16)));
typedef unsigned u32x4 __attribute__((ext_vector_type(4)));
constexpr int KCH = 6160;
constexpr int LDS_K = 0, LDS_V = 8 * KCH, VDH = 24 * 1024 + 64, LDS_OST = LDS_V + 2 * VDH, LDS_TOTAL = LDS_OST + 8 * 4096;
static_assert(LDS_TOTAL <= LDS_BYTES, "attention LDS");
__device__ __forceinline__ int crow(int r, int hi) { return (r & 3) + 8 * (r >> 2) + 4 * hi; }
__device__ __forceinline__ s16x4 vtr(const LAS unsigned char* p) { return __builtin_bit_cast(s16x4, __builtin_amdgcn_ds_read_tr16_b64_v4i16((LAS s16x4*)p)); }
__device__ __forceinline__ void attn_item(int bh, int j, const bf16* Qp, const bf16* Kp, const bf16* Vp, bf16* O, float* lse, LAS unsigned char* shm) {
    int tid = threadIdx.x; asm volatile("" : "+v"(tid));
    const int lane = tid & 63, r32 = lane & 31, hi = lane >> 5; const int wid = __builtin_amdgcn_readfirstlane(tid >> 6);
    const int b = bh >> 4, h = bh & 15;
    const int dsh = h < 6 ? 0 : (h < 11 ? 2 : 4);
    const int nqb = 32 >> dsh, r = j >> (5 - dsh), qb = j & (nqb - 1);
    const bool first = (qb == 0);
    const size_t hb = (size_t)bh * (SEQ * 64);
    const int pos0 = j * 256;
#pragma unroll
    for (int it = 0; it < 6; ++it) {
        const int p = tid + 512 * it, key = p >> 3, c = p & 7;
        u32x4 kv = (u32x4){0u, 0u, 0u, 0u}, vv = (u32x4){0u, 0u, 0u, 0u};
        if (!(first && key < 128)) { const size_t go = hb + (size_t)(pos0 - 128 + key) * 64 + c * 8; kv = *(const GAS u32x4*)(Kp + go); vv = *(const GAS u32x4*)(Vp + go); }
        *(LAS u32x4*)(shm + LDS_K + c * KCH + key * 16) = kv;
        *(LAS u32x4*)(shm + LDS_V + (c >> 2) * VDH + (key >> 4) * 1024 + (key & 15) * 64 + (c & 3) * 16) = vv;
    }
    bf16x8 qr[4];
#pragma unroll
    for (int d0 = 0; d0 < 4; ++d0) qr[d0] = *(const GAS bf16x8*)(Qp + hb + (size_t)(pos0 + 32 * wid + r32) * 64 + d0 * 16 + hi * 8);
    LDS_WAIT(); __syncthreads();
    f32x16 P[5];
    const LAS unsigned char* kbase = shm + LDS_K + hi * KCH + (32 * wid + r32) * 16;
#pragma unroll
    for (int kt = 0; kt < 5; ++kt) {
        f32x16 acc = {0.f, 0.f, 0.f, 0.f, 0.f, 0.f, 0.f, 0.f, 0.f, 0.f, 0.f, 0.f, 0.f, 0.f, 0.f, 0.f};
#pragma unroll
        for (int d0 = 0; d0 < 4; ++d0) { const bf16x8 kf = *(const LAS bf16x8*)(kbase + (2 * d0) * KCH + kt * 512); acc = __builtin_amdgcn_mfma_f32_32x32x16_bf16(kf, qr[d0], acc, 0, 0, 0); }
        P[kt] = acc;
    }
    const float NEG = -INFINITY;
    const int lowlim = first ? (128 - 32 * wid) : 0;
    const int lo0 = r32 > lowlim ? r32 : lowlim;
#pragma unroll
    for (int rr = 0; rr < 16; ++rr) { const int cr = crow(rr, hi); if (cr < lo0) P[0][rr] = NEG; if (cr > r32) P[4][rr] = NEG; }
    if (first) {
#pragma unroll
        for (int kt = 1; kt < 4; ++kt)
#pragma unroll
            for (int rr = 0; rr < 16; ++rr) if (32 * kt + crow(rr, hi) < lowlim) P[kt][rr] = NEG;
    }
    float mx = NEG;
#pragma unroll
    for (int kt = 0; kt < 5; ++kt)
#pragma unroll
        for (int rr = 0; rr < 16; ++rr) mx = fmaxf(mx, P[kt][rr]);
    mx = fmaxf(mx, __shfl_xor(mx, 32));
    float l = 0.f;
#pragma unroll
    for (int kt = 0; kt < 5; ++kt)
#pragma unroll
        for (int rr = 0; rr < 16; ++rr) { const float e = __builtin_amdgcn_exp2f(P[kt][rr] - mx); P[kt][rr] = e; l += e; }
    l += __shfl_xor(l, 32);
    const float inv = 1.0f / l;
    {
        const int i = qb * 256 + 32 * wid + r32, t = (i << dsh) + r;
        if (hi == 0) lse[((size_t)b * SEQ + t) * 16 + h] = (mx + log2f(l)) * 0.6931471805599453f;
    }
    f32x16 o[2];
    o[0] = (f32x16){0.f, 0.f, 0.f, 0.f, 0.f, 0.f, 0.f, 0.f, 0.f, 0.f, 0.f, 0.f, 0.f, 0.f, 0.f, 0.f}; o[1] = o[0];
    const LAS unsigned char* vb = shm + LDS_V + ((lane >> 4) & 1) * 32 + (lane & 3) * 8 + (4 * hi + ((lane & 15) >> 2)) * 64;
#pragma unroll
    for (int kt = 0; kt < 5; ++kt)
#pragma unroll
        for (int s = 0; s < 2; ++s) {
            u32x4 pw;
            pw.x = pg8::cvt_pk_bf16(P[kt][8 * s + 0] * inv, P[kt][8 * s + 1] * inv); pw.y = pg8::cvt_pk_bf16(P[kt][8 * s + 2] * inv, P[kt][8 * s + 3] * inv);
            pw.z = pg8::cvt_pk_bf16(P[kt][8 * s + 4] * inv, P[kt][8 * s + 5] * inv); pw.w = pg8::cvt_pk_bf16(P[kt][8 * s + 6] * inv, P[kt][8 * s + 7] * inv);
            const bf16x8 pa = __builtin_bit_cast(bf16x8, pw);
            const int kblk = 2 * wid + 2 * kt + s;
#pragma unroll
            for (int dh = 0; dh < 2; ++dh) {
                const s16x4 vlo = vtr(vb + dh * VDH + kblk * 1024), vhi = vtr(vb + dh * VDH + kblk * 1024 + 512);
                const bf16x8 vf = (bf16x8){vlo[0], vlo[1], vlo[2], vlo[3], vhi[0], vhi[1], vhi[2], vhi[3]};
                o[dh] = __builtin_amdgcn_mfma_f32_32x32x16_bf16(pa, vf, o[dh], 0, 0, 0);
            }
        }
    {
        LAS bf16* stg = (LAS bf16*)(shm + LDS_OST + wid * 4096);
#pragma unroll
        for (int rr = 0; rr < 16; ++rr) { const int orow = crow(rr, hi);
#pragma unroll
            for (int dh = 0; dh < 2; ++dh) stg[orow * 64 + dh * 32 + r32] = (bf16)f2bf(o[dh][rr]); }
        LDS_WAIT(); asm volatile("" ::: "memory");
#pragma unroll
        for (int i4 = 0; i4 < 4; ++i4) { const int row = i4 * 8 + (lane >> 3), ch = lane & 7; const u32x4 v = *(const LAS u32x4*)(stg + row * 64 + ch * 8);
            const int i = qb * 256 + 32 * wid + row, t = (i << dsh) + r;
            *(GAS u32x4*)(O + ((size_t)b * SEQ + t) * D + h * 64 + ch * 8) = v; }
    }
    LDS_WAIT(); __syncthreads();
}
}

__global__ void __launch_bounds__(NWAVES * 64, 2) fwd_megakernel(Args args) {
    extern __shared__ __attribute__((aligned(16))) unsigned char lds[];
    Frame F;
    F.lds = (LAS unsigned char*)lds;
    F.tid = threadIdx.x; F.lane = F.tid & 63; F.wave = __builtin_amdgcn_readfirstlane(F.tid >> 6);
    F.G = gridDim.x; { const int bx = blockIdx.x; F.vcu = (F.G % 8 == 0) ? (bx % 8) * (F.G / 8) + bx / 8 : bx; }
    unsigned char* ws = args.ws;
    const int lo = args.ph_lo, hi = args.ph_hi;
    const bool one_launch = (hi - lo) > 1;
    volatile LAS unsigned* bst = (volatile LAS unsigned*)(F.lds + 131072 + 1024);
    if (F.tid < 2) bst[F.tid] = 0u;
    __syncthreads();
    XcdBarrier bar; bar.bar = (unsigned*)(ws + WS_CTL) + CW_BAR; bar.x = 0; bar.st = bst;
    if (one_launch) bar = xcd_barrier_post((unsigned*)(ws + WS_CTL) + CW_BAR, bst);
#define IN(k) (lo <= (k) && (k) < hi)
#define SEAM(k) do { if (IN(k) && IN((k) + 1)) { if ((k) == 0) cg::this_grid().sync(); else xcd_barrier(bar); } } while (0)

    float* resid = args.out;
    float* ssb = (float*)(ws + WS_SS);
    bf16* xb = (bf16*)(ws + WS_XB);
    bf16* zo = (bf16*)(ws + WS_ZO);
    bf16* big = (bf16*)(ws + WS_BIG);

    if (IN(0)) { p0_prologue(F, args); }
    SEAM(0);
    if (IN(1)) {
        pg8::Gemm g{big, (const bf16*)(ws + WS_WIN), M, D, D, D, D, (size_t)M * D * 2};
        pg8::StaticOrder S; S.init(M, D, F.G, (int)blockIdx.x);
        pg8::EpiBf16 E{xb, D};
        pg8::gemm_phase<pg8::EpiBf16, pg8::StaticOrder, true>(F.lds, g, S, E);
    }
    SEAM(1);
    if (IN(2)) {
        pg8::Gemm g{xb, (const bf16*)(ws + WS_WG), M, D, 256, D, 256, (size_t)256 * 2};
        pg8::StaticOrder S; S.init(M, D, F.G, (int)blockIdx.x);
        pg8::EpiBf16 E{zo, D};
        pg8::gemm_phase<pg8::EpiBf16, pg8::StaticOrder, true>(F.lds, g, S, E);
    }
    SEAM(2);
    if (IN(3)) {
        pg8::Gemm g{zo, (const bf16*)(ws + WS_WPO), M, D, D, D, D, 0};
        pg8::StaticOrder S; S.init(M, D, F.G, (int)blockIdx.x);
        pg8::EpiRes E{args.in[0], resid, xb, ssb};
        pg8::gemm_phase<pg8::EpiRes, pg8::StaticOrder, true>(F.lds, g, S, E);
    }
    SEAM(3);
#pragma unroll 1
    for (int layer = 0; layer < 2; ++layer) {
        const int pb = layer == 0 ? 4 : 10;
        if (IN(pb)) {
            pg8::Gemm g{xb, (const bf16*)(ws + (layer == 0 ? WS_WGU0 : WS_WGU1)), M, 2 * FF, D, D, D, 0};
            pg8::StaticOrder S; S.init(M, 2 * FF, F.G, (int)blockIdx.x);
            pg8::EpiSwiGLU E{big, ssb, FF};
            pg8::gemm_phase<pg8::EpiSwiGLU, pg8::StaticOrder, true>(F.lds, g, S, E);
        }
        SEAM(pb);
        if (IN(pb + 1)) {
            pg8::Gemm g{big, (const bf16*)(ws + (layer == 0 ? WS_WD0 : WS_WD1)), M, D, FF, FF, FF, 0};
            pg8::StaticOrder S; S.init(M, D, F.G, (int)blockIdx.x);
            pg8::EpiRes E{resid, resid, xb, ssb};
            pg8::gemm_phase<pg8::EpiRes, pg8::StaticOrder, true>(F.lds, g, S, E);
        }
        SEAM(pb + 1);
        if (layer == 0) {
            bf16* qb_ = big; bf16* kb_ = big + (size_t)M * D; bf16* vb_ = big + 2 * (size_t)M * D;
            if (IN(6)) {
                pg8::Gemm g{xb, (const bf16*)(ws + WS_WQKV), M, 3 * D, D, D, D, 0};
                pg8::StaticOrder S; S.init(M, 3 * D, F.G, (int)blockIdx.x);
                pg8::EpiQKV E{qb_, ssb, (const float*)(ws + WS_ROPE)};
                pg8::gemm_phase<pg8::EpiQKV, pg8::StaticOrder, true>(F.lds, g, S, E);
            }
            SEAM(6);
            if (IN(7)) {
                const int ipw = (1024 + F.G - 1) / F.G;
                for (int i = 0; i < ipw; ++i) { const int item = F.vcu * ipw + i; if (item < 1024) att::attn_item(item >> 5, item & 31, qb_, kb_, vb_, zo, (float*)(ws + WS_LSE), F.lds); }
            }
            SEAM(7);
            if (IN(8)) {
                const float* lse = (const float*)(ws + WS_LSE);
                for (int m = F.vcu * NWAVES + F.wave; m < M; m += F.G * NWAVES) {
                    float L[16];
#pragma unroll
                    for (int q4 = 0; q4 < 4; ++q4) { const f32x4 v = *(const GAS f32x4*)(lse + (size_t)m * 16 + 4 * q4); L[4 * q4] = v[0]; L[4 * q4 + 1] = v[1]; L[4 * q4 + 2] = v[2]; L[4 * q4 + 3] = v[3]; }
                    float lg[3];
                    { float mx = L[0];
_Pragma("unroll") for (int i = 1; i < 6; ++i) mx = fmaxf(mx, L[i]); float s = 0.f;
_Pragma("unroll") for (int i = 0; i < 6; ++i) s += __expf(L[i] - mx); lg[0] = mx + __logf(s) - 1.791759469228055f; }
                    { float mx = L[6];
_Pragma("unroll") for (int i = 7; i < 11; ++i) mx = fmaxf(mx, L[i]); float s = 0.f;
_Pragma("unroll") for (int i = 6; i < 11; ++i) s += __expf(L[i] - mx); lg[1] = mx + __logf(s) - 1.6094379124341003f; }
                    { float mx = L[11];
_Pragma("unroll") for (int i = 12; i < 16; ++i) mx = fmaxf(mx, L[i]); float s = 0.f;
_Pragma("unroll") for (int i = 11; i < 16; ++i) s += __expf(L[i] - mx); lg[2] = mx + __logf(s) - 1.6094379124341003f; }
                    const float mx = fmaxf(lg[0], fmaxf(lg[1], lg[2]));
                    const float e0 = __expf(lg[0] - mx), e1 = __expf(lg[1] - mx), e2 = __expf(lg[2] - mx); const float is = 3.0f / (e0 + e1 + e2);
                    const int head = F.lane >> 2; const float sc = (head < 6 ? e0 : (head < 11 ? e1 : e2)) * is;
                    GAS v4u* p = (GAS v4u*)(zo + (size_t)m * D + 16 * F.lane);
#pragma unroll
                    for (int q2 = 0; q2 < 2; ++q2) { v4u w = p[q2];
                        w.x = pk2(bflo(w.x) * sc, bfhi(w.x) * sc); w.y = pk2(bflo(w.y) * sc, bfhi(w.y) * sc); w.z = pk2(bflo(w.z) * sc, bfhi(w.z) * sc); w.w = pk2(bflo(w.w) * sc, bfhi(w.w) * sc);
                        p[q2] = w; }
                }
            }
            SEAM(8);
            if (IN(9)) {
                pg8::Gemm g{zo, (const bf16*)(ws + WS_WAO), M, D, D, D, D, 0};
                pg8::StaticOrder S; S.init(M, D, F.G, (int)blockIdx.x);
                pg8::EpiRes E{resid, resid, xb, ssb};
                pg8::gemm_phase<pg8::EpiRes, pg8::StaticOrder, true>(F.lds, g, S, E);
            }
            SEAM(9);
        }
    }
    if (IN(12)) {
        const float* gf = args.in[3];
        for (int m = F.vcu * NWAVES + F.wave; m < M; m += F.G * NWAVES) {
            float s = 0.f;
#pragma unroll
            for (int q4 = 0; q4 < 4; ++q4) { const f32x4 v = *(const GAS f32x4*)(ssb + (size_t)m * 16 + 4 * q4); s += (v[0] + v[1]) + (v[2] + v[3]); }
            const float rstd = rsqrtf(s * (1.0f / D) + 1e-6f);
            GAS f32x4* xr = (GAS f32x4*)(resid + (size_t)m * D) + F.lane;
#pragma unroll
            for (int j = 0; j < 4; ++j) { const f32x4 gq = *(const GAS f32x4*)(gf + 4 * F.lane + 256 * j); xr[64 * j] = xr[64 * j] * rstd * gq; }
        }
    }
#undef IN
#undef SEAM
}

extern "C" void kernel_launch(void* const* d_in, const int* in_sizes, int n_in, void* d_out, int out_size, void* d_ws, size_t ws_size, hipStream_t stream) {
    static int grid = 0;
    if (grid == 0) {
        if (n_in != 13 || in_sizes[0] != M * D || out_size != M * D || ws_size < WS_END) { fprintf(stderr, "kernel_launch: unexpected shapes (n_in %d, in0 %d, out %d, ws %zu); nothing launched\n", n_in, n_in > 0 ? in_sizes[0] : -1, out_size, ws_size); grid = -1; return; }
        int dev = 0, cus = 0, per_cu = 0;
        if (hipGetDevice(&dev) != hipSuccess || hipDeviceGetAttribute(&cus, hipDeviceAttributeMultiprocessorCount, dev) != hipSuccess) { grid = -1; return; }
        if (hipFuncSetAttribute((const void*)fwd_megakernel, hipFuncAttributeMaxDynamicSharedMemorySize, LDS_BYTES) != hipSuccess) { fprintf(stderr, "kernel_launch: hipFuncSetAttribute failed\n"); grid = -1; return; }
        if (hipOccupancyMaxActiveBlocksPerMultiprocessor(&per_cu, (const void*)fwd_megakernel, NWAVES * 64, LDS_BYTES) != hipSuccess || per_cu < 1) { fprintf(stderr, "kernel_launch: occupancy query says %d blocks per CU\n", per_cu); per_cu = 1; }
        (void)hipGetLastError();
        grid = cus;
    }
    if (grid < 0) return;
    if (hipMemsetAsync((char*)d_ws + WS_CTL, 0, CTL_ZERO_BYTES, stream) != hipSuccess) { fprintf(stderr, "kernel_launch: memset failed\n"); return; }
    Args a{};
    for (int i = 0; i < 13; ++i) a.in[i] = (const float*)d_in[i];
    a.out = (float*)d_out; a.ws = (unsigned char*)d_ws;
#if MK_N_LAUNCHES == 1
    a.ph_lo = 0; a.ph_hi = 13;
    void* kargs[] = {&a};
    hipError_t e = hipLaunchCooperativeKernel((const void*)fwd_megakernel, dim3(grid), dim3(NWAVES * 64), kargs, LDS_BYTES, stream);
    if (e != hipSuccess) fprintf(stderr, "kernel_launch: cooperative launch failed: %s (grid %d)\n", hipGetErrorString(e), grid);
#else
    for (int p = 0; p < 13; ++p) { a.ph_lo = p; a.ph_hi = p + 1; hipLaunchKernelGGL(fwd_megakernel, dim3(grid), dim3(NWAVES * 64), LDS_BYTES, stream, a); }
#endif
}
```

```cpp
#include <hip/hip_runtime.h>
#include <hip/hip_cooperative_groups.h>
#include <cstdio>
#include <cstdint>
namespace cg = cooperative_groups;

#ifndef MK_N_LAUNCHES
#define MK_N_LAUNCHES 1
#endif

namespace pg8 {
#define PG8_LAS __attribute__((address_space(3)))
typedef unsigned short bf16_t;
typedef short bf16x8 __attribute__((ext_vector_type(8)));
typedef float f32x4 __attribute__((ext_vector_type(4)));
typedef unsigned u32x4 __attribute__((ext_vector_type(4)));
constexpr int BM = 256, BK = 64, HALF = 128, HTB = HALF * BK * 2, STAGE_BYTES = 8 * HTB, NXCD = 8, WGM = 8;

__host__ __device__ __forceinline__ int lds_byte(int r, int c) { const int st = (r >> 4) * 2 + (c >> 5), rr = r & 15, cc = c & 31, ob = rr * 64 + cc * 2; return st * 1024 + (ob ^ (((ob >> 9) & 1) << 5)); }
__host__ __device__ __forceinline__ void stage_rc(int b, int& R, int& C) { const int st = b / 1024, sb = b % 1024, swz = sb ^ (((sb >> 9) & 1) << 5); R = (st >> 1) * 16 + swz / 64; C = (st & 1) * 32 + (swz % 64) / 2; }
__host__ __device__ __forceinline__ int perm32(int rho) { const int n = rho >> 4, i = rho & 15; return 8 * (i >> 2) + 4 * n + (i & 3); }

struct Unit { int pm, pn; };
struct Gemm { const bf16_t* A; const bf16_t* Bt; int M, N, K, lda, ldb; size_t a_pn_bytes; };

struct StaticOrder {
    int nM, nN, nwg, G, c;
    __host__ __device__ void init(int M, int N, int G_, int c_) { nM = M / BM; nN = N / BM; nwg = nM * nN; G = G_; c = c_; }
    __host__ __device__ bool next(int i, Unit& u) const {
        const long L = (long)i * G + c; if (L >= nwg) return false;
        int wgid = (int)L; { const int q = nwg / NXCD, r = nwg % NXCD, xcd = wgid % NXCD, off = wgid / NXCD; wgid = (xcd < r ? xcd * (q + 1) : r * (q + 1) + (xcd - r) * q) + off; }
        const int nig = WGM * nN, gid = wgid / nig, fm = gid * WGM, gsz = (nM - fm) < WGM ? (nM - fm) : WGM;
        u.pm = fm + ((wgid % nig) % gsz); u.pn = (wgid % nig) / gsz; return true;
    }
};

__device__ __forceinline__ unsigned cvt_pk_bf16(float lo, float hi) { unsigned r; asm volatile("v_cvt_pk_bf16_f32 %0, %1, %2" : "=v"(r) : "v"(lo), "v"(hi)); return r; }

constexpr float RMS_EPS = 1e-6f;

struct EpiBf16 {
    bf16_t* O; int ldc;
    __device__ __forceinline__ void operator()(const f32x4 (&acc)[2][2][4][2], const Unit& u, int wr, int wc, int fr, int fq) const {
        const int row0 = u.pm * BM + wr * 64 + fr, col0 = u.pn * BM + wc * 32 + 8 * fq;
#pragma unroll
        for (int ai = 0; ai < 2; ++ai)
#pragma unroll
            for (int m = 0; m < 4; ++m) { bf16_t* rowp = O + (size_t)(row0 + ai * HALF + m * 16) * ldc + col0;
#pragma unroll
                for (int bj = 0; bj < 2; ++bj) { const f32x4 v0 = acc[ai][bj][m][0], v1 = acc[ai][bj][m][1];
                    u32x4 w; w.x = cvt_pk_bf16(v0[0], v0[1]); w.y = cvt_pk_bf16(v0[2], v0[3]); w.z = cvt_pk_bf16(v1[0], v1[1]); w.w = cvt_pk_bf16(v1[2], v1[3]);
                    *(u32x4*)(rowp + bj * HALF) = w; } }
    }
};
struct EpiRes {
    const float* base; float* out; bf16_t* xb; float* ss;
    __device__ __forceinline__ void operator()(const f32x4 (&acc)[2][2][4][2], const Unit& u, int wr, int wc, int fr, int fq) const {
        const int row0 = u.pm * BM + wr * 64 + fr, col0 = u.pn * BM + wc * 32 + 8 * fq;
#pragma unroll
        for (int ai = 0; ai < 2; ++ai)
#pragma unroll
            for (int m = 0; m < 4; ++m) { const size_t row = (size_t)(row0 + ai * HALF + m * 16); const size_t off = row * 1024 + col0; float s = 0.f;
#pragma unroll
                for (int bj = 0; bj < 2; ++bj) {
                    const f32x4 b0 = *(const f32x4*)(base + off + bj * HALF), b1 = *(const f32x4*)(base + off + bj * HALF + 4);
                    const f32x4 v0 = acc[ai][bj][m][0] + b0, v1 = acc[ai][bj][m][1] + b1;
                    *(f32x4*)(out + off + bj * HALF) = v0; *(f32x4*)(out + off + bj * HALF + 4) = v1;
                    s += (v0[0] * v0[0] + v0[1] * v0[1]) + (v0[2] * v0[2] + v0[3] * v0[3]) + (v1[0] * v1[0] + v1[1] * v1[1]) + (v1[2] * v1[2] + v1[3] * v1[3]);
                    u32x4 w; w.x = cvt_pk_bf16(v0[0], v0[1]); w.y = cvt_pk_bf16(v0[2], v0[3]); w.z = cvt_pk_bf16(v1[0], v1[1]); w.w = cvt_pk_bf16(v1[2], v1[3]);
                    *(u32x4*)(xb + off + bj * HALF) = w; }
                s += __shfl_xor(s, 16); s += __shfl_xor(s, 32);
                if (fq == 0) ss[row * 16 + u.pn * 4 + wc] = s; }
    }
};
__device__ __forceinline__ float row_rstd(const float* ss, size_t row, int fq) {
    const f32x4 p = *(const f32x4*)(ss + row * 16 + 4 * fq); float s = (p[0] + p[1]) + (p[2] + p[3]);
    s += __shfl_xor(s, 16); s += __shfl_xor(s, 32);
    return rsqrtf(s * (1.0f / 1024.0f) + RMS_EPS);
}
struct EpiSwiGLU {
    bf16_t* act; const float* ss; int ldc;
    __device__ __forceinline__ void operator()(const f32x4 (&acc)[2][2][4][2], const Unit& u, int wr, int wc, int fr, int fq) const {
        const int row0 = u.pm * BM + wr * 64 + fr, col0 = u.pn * HALF + wc * 32 + 8 * fq;
#pragma unroll
        for (int ai = 0; ai < 2; ++ai)
#pragma unroll
            for (int m = 0; m < 4; ++m) { const size_t row = (size_t)(row0 + ai * HALF + m * 16); const float rstd = row_rstd(ss, row, fq);
                float a[8];
#pragma unroll
                for (int n = 0; n < 2; ++n)
#pragma unroll
                    for (int i = 0; i < 4; ++i) { const float g = acc[ai][0][m][n][i] * rstd, up = acc[ai][1][m][n][i] * rstd;
                        a[n * 4 + i] = g * up * __builtin_amdgcn_rcpf(1.0f + __builtin_amdgcn_exp2f(-1.4426950408889634f * g)); }
                u32x4 w; w.x = cvt_pk_bf16(a[0], a[1]); w.y = cvt_pk_bf16(a[2], a[3]); w.z = cvt_pk_bf16(a[4], a[5]); w.w = cvt_pk_bf16(a[6], a[7]);
                *(u32x4*)(act + row * ldc + col0) = w; }
    }
};
struct EpiQKV {
    bf16_t* qkv; const float* ss; const float* rope;
    __device__ __forceinline__ void operator()(const f32x4 (&acc)[2][2][4][2], const Unit& u, int wr, int wc, int fr, int fq) const {
        const int row0 = u.pm * BM + wr * 64 + fr; const int sect = u.pn >> 2, head = (u.pn & 3) * 4 + wc;
        const int dsh = head < 6 ? 0 : (head < 11 ? 2 : 4);
        bf16_t* dst = qkv + (size_t)sect * ((size_t)16384 * 1024);
        const float qs = sect == 0 ? 0.125f * 1.4426950408889634f : 1.0f;
#pragma unroll
        for (int ai = 0; ai < 2; ++ai)
#pragma unroll
            for (int m = 0; m < 4; ++m) { const int row = row0 + ai * HALF + m * 16; const float rstd = row_rstd(ss, (size_t)row, fq) * qs;
                const int b = row >> 13, t = row & 8191; const int pos = ((t & ((1 << dsh) - 1)) << (13 - dsh)) + (t >> dsh);
                bf16_t* o = dst + ((size_t)(b * 16 + head) * 8192 + pos) * 64 + 8 * fq;
                float lo[8], hi[8];
#pragma unroll
                for (int n = 0; n < 2; ++n)
#pragma unroll
                    for (int i = 0; i < 4; ++i) { lo[n * 4 + i] = acc[ai][0][m][n][i] * rstd; hi[n * 4 + i] = acc[ai][1][m][n][i] * rstd; }
                if (sect < 2) {
                    const float* rp = rope + (size_t)t * 64 + 8 * fq;
                    const f32x4 c0 = *(const f32x4*)(rp), c1 = *(const f32x4*)(rp + 4), s0 = *(const f32x4*)(rp + 32), s1 = *(const f32x4*)(rp + 36);
#pragma unroll
                    for (int i = 0; i < 8; ++i) { const float cs = i < 4 ? c0[i & 3] : c1[i & 3], sn = i < 4 ? s0[i & 3] : s1[i & 3];
                        const float l = lo[i], h = hi[i]; lo[i] = l * cs - h * sn; hi[i] = h * cs + l * sn; }
                }
                u32x4 w; w.x = cvt_pk_bf16(lo[0], lo[1]); w.y = cvt_pk_bf16(lo[2], lo[3]); w.z = cvt_pk_bf16(lo[4], lo[5]); w.w = cvt_pk_bf16(lo[6], lo[7]);
                *(u32x4*)(o) = w;
                w.x = cvt_pk_bf16(hi[0], hi[1]); w.y = cvt_pk_bf16(hi[2], hi[3]); w.z = cvt_pk_bf16(hi[4], hi[5]); w.w = cvt_pk_bf16(hi[6], hi[7]);
                *(u32x4*)(o + 32) = w; }
    }
};

template <class Epi, class Sched, bool ALIGN_EPI>
__device__ __forceinline__ void gemm_phase(PG8_LAS unsigned char* lds, const Gemm g, const Sched& S, const Epi& E) {
    int tid = threadIdx.x; asm volatile("" : "+v"(tid));
    const int wid = __builtin_amdgcn_readfirstlane(tid >> 6), lane = tid & 63, wr = wid >> 2, wc = wid & 3, fr = lane & 15, fq = lane >> 4;
    const int K = g.K, nt = K / BK;
    unsigned voffA[2], voffB[2];
#pragma unroll
    for (int i = 0; i < 2; ++i) { int R, C; stage_rc(tid * 16 + i * 8192, R, C); const int Rb = (R & ~31) + perm32(R & 31);
        voffA[i] = (unsigned)(R * g.lda + C) * 2u; voffB[i] = (unsigned)(Rb * g.ldb + C) * 2u; }
    const size_t kstep = (size_t)(BK * 2);
    const size_t hstepA = (size_t)HALF * g.lda * 2, hstepB = (size_t)HALF * g.ldb * 2;
    const size_t tstepA = 2 * hstepA, tstepB = 2 * hstepB;
    const unsigned ldsw = (unsigned)wid * 1024u;
    const int aoff = lds_byte(wr * 64 + fr, fq * 8), boff = lds_byte(wc * 32 + fr, fq * 8);
#define PG8_SA(b, h) (((b) * 2 + (h)) * HTB)
#define PG8_SB(b, h) ((4 + (b) * 2 + (h)) * HTB)
#define PG8_STAGE(bufoff, gbase, voff) do { _Pragma("unroll") for (int _i = 0; _i < 2; ++_i) \
        __builtin_amdgcn_global_load_lds((const unsigned*)((const char*)(gbase) + (voff)[_i]), (PG8_LAS unsigned*)(lds + (bufoff) + ldsw + _i * 8192), 16, 0, 0); } while (0)
#define PG8_LDA(dst, b, h) do { _Pragma("unroll") for (int m = 0; m < 4; ++m) _Pragma("unroll") for (int k = 0; k < 2; ++k) dst[m][k] = *(const PG8_LAS bf16x8*)(lds + PG8_SA(b, h) + aoff + m * 2048 + k * 1024); } while (0)
#define PG8_LDB(dst, b, h) do { _Pragma("unroll") for (int n = 0; n < 2; ++n) _Pragma("unroll") for (int k = 0; k < 2; ++k) dst[n][k] = *(const PG8_LAS bf16x8*)(lds + PG8_SB(b, h) + boff + n * 2048 + k * 1024); } while (0)
#define PG8_MMA(ai, bj, At, Bt) do { __builtin_amdgcn_s_setprio(1); _Pragma("unroll") for (int m = 0; m < 4; ++m) _Pragma("unroll") for (int n = 0; n < 2; ++n) _Pragma("unroll") for (int k = 0; k < 2; ++k) \
        acc[ai][bj][m][n] = __builtin_amdgcn_mfma_f32_16x16x32_bf16(Bt[n][k], At[m][k], acc[ai][bj][m][n], 0, 0, 0); __builtin_amdgcn_s_setprio(0); } while (0)
#define PG8_WAIT_V(n) asm volatile("s_waitcnt vmcnt(" #n ")" ::: "memory")
#define PG8_WAIT_L(n) asm volatile("s_waitcnt lgkmcnt(" #n ")" ::: "memory")
#define PG8_BAR __builtin_amdgcn_s_barrier()
#define PG8_SCHED __builtin_amdgcn_sched_barrier(0)
    Unit cur, nxt; int ui = 0;
    if (!S.next(0, cur)) return;
    f32x4 acc[2][2][4][2];
#pragma unroll
    for (int a = 0; a < 2; ++a)
#pragma unroll
        for (int b = 0; b < 2; ++b)
#pragma unroll
            for (int m = 0; m < 4; ++m)
#pragma unroll
                for (int n = 0; n < 2; ++n) acc[a][b][m][n] = (f32x4){0.f, 0.f, 0.f, 0.f};
    bf16x8 At[4][2], B0[2][2], B1[2][2];
    const char* cA = (const char*)g.A + (size_t)cur.pm * tstepA + (size_t)cur.pn * g.a_pn_bytes; const char* cB = (const char*)g.Bt + (size_t)cur.pn * tstepB;
    PG8_STAGE(PG8_SB(0, 0), cB, voffB); PG8_STAGE(PG8_SB(0, 1), cB + hstepB, voffB); PG8_STAGE(PG8_SA(0, 0), cA, voffA); PG8_STAGE(PG8_SA(0, 1), cA + hstepA, voffA);
    if (wr == 1) PG8_BAR;
    PG8_WAIT_V(2); PG8_BAR;
    PG8_STAGE(PG8_SB(1, 0), cB + kstep, voffB); PG8_STAGE(PG8_SA(1, 0), cA + kstep, voffA); PG8_STAGE(PG8_SB(1, 1), cB + hstepB + kstep, voffB);
    PG8_WAIT_V(6); PG8_BAR;
    for (;;) {
        const bool has_next = S.next(ui + 1, nxt);
        const char* nA = has_next ? (const char*)g.A + (size_t)nxt.pm * tstepA + (size_t)nxt.pn * g.a_pn_bytes : cA; const char* nB = has_next ? (const char*)g.Bt + (size_t)nxt.pn * tstepB : cB;
        for (int t = 0; t < nt; t += 2) {
            const bool last = (t == nt - 2);
            const char* a1 = cA + (size_t)(t + 1) * kstep;
            const char* a2 = last ? nA : cA + (size_t)(t + 2) * kstep; const char* b2 = last ? nB : cB + (size_t)(t + 2) * kstep;
            const char* a3 = a2 + kstep; const char* b3 = b2 + kstep;
            PG8_LDB(B0, 0, 0); PG8_LDB(B1, 0, 1); PG8_SCHED; PG8_LDA(At, 0, 0); PG8_STAGE(PG8_SA(1, 1), a1 + hstepA, voffA);
            PG8_WAIT_V(8); PG8_WAIT_L(0); PG8_BAR; PG8_MMA(0, 0, At, B0); PG8_MMA(0, 1, At, B1); PG8_BAR; PG8_SCHED;
            PG8_LDA(At, 0, 1); PG8_STAGE(PG8_SB(0, 0), b2, voffB); PG8_STAGE(PG8_SB(0, 1), b2 + hstepB, voffB); PG8_STAGE(PG8_SA(0, 0), a2, voffA);
            PG8_WAIT_V(8); PG8_WAIT_L(0); PG8_BAR; PG8_MMA(1, 0, At, B0); PG8_MMA(1, 1, At, B1); PG8_BAR; PG8_SCHED;
            PG8_LDB(B0, 1, 0); PG8_LDB(B1, 1, 1); PG8_SCHED; PG8_LDA(At, 1, 0); PG8_STAGE(PG8_SA(0, 1), a2 + hstepA, voffA);
            PG8_WAIT_V(8); PG8_WAIT_L(0); PG8_BAR; PG8_MMA(0, 0, At, B0); PG8_MMA(0, 1, At, B1); PG8_BAR; PG8_SCHED;
            PG8_LDA(At, 1, 1); PG8_STAGE(PG8_SB(1, 0), b3, voffB); PG8_STAGE(PG8_SB(1, 1), b3 + hstepB, voffB); PG8_STAGE(PG8_SA(1, 0), a3, voffA);
            PG8_WAIT_V(8); PG8_WAIT_L(0); PG8_BAR; PG8_MMA(1, 0, At, B0); PG8_MMA(1, 1, At, B1); PG8_BAR; PG8_SCHED;
        }
        if constexpr (ALIGN_EPI) { if (wr == 0) PG8_BAR; }
        E(acc, cur, wr, wc, fr, fq);
        if (!has_next) break;
#pragma unroll
        for (int a = 0; a < 2; ++a)
#pragma unroll
            for (int b = 0; b < 2; ++b)
#pragma unroll
                for (int m = 0; m < 4; ++m)
#pragma unroll
                    for (int n = 0; n < 2; ++n) acc[a][b][m][n] = (f32x4){0.f, 0.f, 0.f, 0.f};
        cur = nxt; cA = nA; cB = nB; ++ui;
        if constexpr (ALIGN_EPI) { if (wr == 1) PG8_BAR; }
    }
    PG8_WAIT_V(0);
    if constexpr (!ALIGN_EPI) { if (wr == 0) PG8_BAR; }
    PG8_BAR;
#undef PG8_SA
#undef PG8_SB
#undef PG8_STAGE
#undef PG8_LDA
#undef PG8_LDB
#undef PG8_MMA
#undef PG8_WAIT_V
#undef PG8_WAIT_L
#undef PG8_BAR
#undef PG8_SCHED
}
}

constexpr int NWAVES = 8;
constexpr int BATCH = 2, SEQ = 8192, D = 1024, H = 16, HD = 64, FF = 2816;
constexpr int M = BATCH * SEQ;
constexpr size_t MiB = 1u << 20;
constexpr size_t WS_CTL = 0, CTL_ZERO_BYTES = 64 * 1024;
constexpr size_t WS_ROPE = 1 * MiB;
constexpr size_t WS_SS = 3 * MiB;
constexpr size_t WS_LSE = 4 * MiB;
constexpr size_t WS_WIN = 6 * MiB;
constexpr size_t WS_WG = 8 * MiB;
constexpr size_t WS_WPO = 9 * MiB;
constexpr size_t WS_WGU0 = 11 * MiB;
constexpr size_t WS_WD0 = 22 * MiB;
constexpr size_t WS_WQKV = 28 * MiB;
constexpr size_t WS_WAO = 34 * MiB;
constexpr size_t WS_WGU1 = 36 * MiB;
constexpr size_t WS_WD1 = 47 * MiB;
constexpr size_t WS_BIG = 56 * MiB;
constexpr size_t WS_XB = 184 * MiB;
constexpr size_t WS_ZO = 216 * MiB;
constexpr size_t WS_END = 248 * MiB;
constexpr int CW_BAR = 1024;

constexpr int LDS_BYTES = 147456;

#define GAS __attribute__((address_space(1)))
#define LAS __attribute__((address_space(3)))
typedef unsigned short bf16;
typedef unsigned v4u __attribute__((ext_vector_type(4)));
typedef unsigned v2u __attribute__((ext_vector_type(2)));
typedef float f32x4 __attribute__((ext_vector_type(4)));
#define LDS_WAIT() asm volatile("s_waitcnt lgkmcnt(0)" ::: "memory")
__device__ __forceinline__ unsigned f2bf(float f) { unsigned u = __builtin_bit_cast(unsigned, f); return (u + 0x7fffu + ((u >> 16) & 1u)) >> 16; }
__device__ __forceinline__ unsigned pk2(float lo, float hi) { return f2bf(lo) | (f2bf(hi) << 16); }
__device__ __forceinline__ float bflo(unsigned w) { return __builtin_bit_cast(float, w << 16); }
__device__ __forceinline__ float bfhi(unsigned w) { return __builtin_bit_cast(float, w & 0xffff0000u); }

#define XB_TMO      128
#define XB_XCNT(j)  (256  + 64 * (j))
#define XB_XSUB(j)  (1280 + 64 * (j))
#define XB_XGEN(j)  (2304 + 64 * (j))
#define XB_TOP      3328
#define XB_TOPGEN   3392
#define XCD_BAR_WORDS 3456
#define XB_SPIN_CAP (1u << 22)
__device__ __forceinline__ unsigned xb_ld(unsigned* p)              { return __hip_atomic_load(p, __ATOMIC_RELAXED, __HIP_MEMORY_SCOPE_AGENT); }
__device__ __forceinline__ unsigned xb_add(unsigned* p, unsigned v) { return __hip_atomic_fetch_add(p, v, __ATOMIC_RELAXED, __HIP_MEMORY_SCOPE_AGENT); }
__device__ __forceinline__ unsigned xb_xcc_id() { return (unsigned)__builtin_amdgcn_s_getreg((3 << 11) | 20) & 0xFu; }
#define XB_SPIN(cond, bar) do { unsigned _sp = 0; while (cond) { __builtin_amdgcn_s_sleep(1); \
    if ((++_sp & 255u) == 0u) { if (xb_ld(&(bar)[XB_TMO])) break; if (_sp > XB_SPIN_CAP) { atomicAdd(&(bar)[XB_TMO], 1u); break; } } } } while (0)
struct XcdBarrier { unsigned* bar; unsigned x; volatile LAS unsigned* st; };
__device__ __forceinline__ XcdBarrier xcd_barrier_post(unsigned* bar, volatile LAS unsigned* st) {
    XcdBarrier b; b.bar = bar; b.x = xb_xcc_id(); b.st = st;
    if (threadIdx.x == 0) (void)xb_add(&bar[XB_XCNT(b.x)], 1u);
    return b;
}
__device__ __forceinline__ void xcd_barrier_complete(unsigned* bar, unsigned x, unsigned& nloc, unsigned& nx) {
    const unsigned G = gridDim.x * gridDim.y * gridDim.z;
    unsigned sum, cnt, mine, sp = 0u;
    for (;;) {
        sum = 0u; cnt = 0u; mine = 0u;
#pragma unroll
        for (unsigned j = 0; j < 16; ++j) { const unsigned c = xb_ld(&bar[XB_XCNT(j)]); sum += c; cnt += (c > 0u) ? 1u : 0u; mine = (j == x) ? c : mine; }
        if (sum == G) break;
        __builtin_amdgcn_s_sleep(1);
        if ((++sp & 255u) == 0u) { if (xb_ld(&bar[XB_TMO])) break; if (sp > XB_SPIN_CAP) { atomicAdd(&bar[XB_TMO], 1u); break; } }
    }
    nloc = mine > 0u ? mine : 1u; nx = cnt > 0u ? cnt : 1u;
}
__device__ __forceinline__ void xcd_barrier(const XcdBarrier& b) {
    asm volatile("s_waitcnt vmcnt(0)" ::: "memory");
    __syncthreads();
    if (threadIdx.x == 0) {
        unsigned* bar = b.bar;
        __builtin_amdgcn_s_waitcnt(0);
        unsigned nloc = b.st[0], nx = b.st[1];
        if (nloc == 0u) { xcd_barrier_complete(bar, b.x, nloc, nx); b.st[0] = nloc; b.st[1] = nx; }
        const unsigned old = xb_add(&bar[XB_XSUB(b.x)], 1u);
        const unsigned gen = old / nloc;
        if (old + 1u == (gen + 1u) * nloc) {
            __builtin_amdgcn_fence(__ATOMIC_RELEASE, "agent");
            asm volatile("s_waitcnt vmcnt(0)" ::: "memory");
            const unsigned og = xb_add(&bar[XB_TOP], 1u);
            const unsigned tg = og / nx;
            if (og + 1u == (tg + 1u) * nx) xb_add(&bar[XB_TOPGEN], 1u);
            else XB_SPIN(xb_ld(&bar[XB_TOPGEN]) == tg, bar);
            __builtin_amdgcn_fence(__ATOMIC_ACQUIRE, "agent");
            xb_add(&bar[XB_XGEN(b.x)], 1u);
            asm volatile("s_waitcnt vmcnt(0)" ::: "memory");
        } else {
            XB_SPIN(xb_ld(&bar[XB_XGEN(b.x)]) == gen, bar);
            __builtin_amdgcn_fence(__ATOMIC_ACQUIRE, "agent");
            asm volatile("s_waitcnt vmcnt(0)" ::: "memory");
        }
    }
    __syncthreads();
}

struct Frame {
    LAS unsigned char* lds;
    int tid, lane, wave, vcu, G;
};
__device__ __forceinline__ float wave_sum(float v) {
#pragma unroll
    for (int o = 1; o < 64; o <<= 1) v += __shfl_xor(v, o);
    return v;
}

__device__ __forceinline__ void p0_tr_item(const float* W, int K, int N, bf16* WT, int mode, int sel, int row_off, const float* kgain, const float* nscale, LAS float* scr, int item, int lane) {
    const int nblk = N / 32, kb = item / nblk, nb = item % nblk, k0 = 64 * kb, n0 = 32 * nb;
    const float ns = nscale ? nscale[n0 + (lane & 31)] : 1.0f;
#pragma unroll 8
    for (int i = 0; i < 32; ++i) { const int kk = 2 * i + (lane >> 5); float v = W[(size_t)(k0 + kk) * N + n0 + (lane & 31)] * ns; if (kgain) v *= kgain[k0 + kk]; scr[kk * 33 + (lane & 31)] = v; }
    LDS_WAIT(); asm volatile("" ::: "memory");
    int rb;
    if (mode == 0) rb = row_off + n0;
    else if (mode == 1) rb = 256 * (n0 >> 7) + 128 * sel + (n0 & 127);
    else { const int pn = n0 >> 8, w = n0 & 255, wc = w >> 6, bj = (w & 63) >> 5; rb = 256 * pn + 128 * bj + 32 * wc; }
    const int c = lane & 7;
#pragma unroll
    for (int j = 0; j < 4; ++j) { const int n = (lane >> 3) + 8 * j; const LAS float* s = scr + (8 * c) * 33 + n;
        v4u o; o.x = pk2(s[0 * 33], s[1 * 33]); o.y = pk2(s[2 * 33], s[3 * 33]); o.z = pk2(s[4 * 33], s[5 * 33]); o.w = pk2(s[6 * 33], s[7 * 33]);
        *(GAS v4u*)(WT + (size_t)(rb + n) * K + k0 + 8 * c) = o; }
    LDS_WAIT(); asm volatile("" ::: "memory");
}

struct Args { const float* in[13]; float* out; unsigned char* ws; int ph_lo, ph_hi; };

__device__ __forceinline__ void sincos_acc(float angf, float& c, float& s) {
    const double x = (double)angf; const double k = __builtin_rint(x * 0.15915494309189535);
    double y = (x - k * 6.283185307179586) * 0.25;
    const double y2 = y * y;
    double sn = y * (1.0 + y2 * (-1.0 / 6 + y2 * (1.0 / 120 + y2 * (-1.0 / 5040 + y2 * (1.0 / 362880 + y2 * (-1.0 / 39916800 + y2 * (1.0 / 6227020800.0)))))));
    double cs = 1.0 + y2 * (-0.5 + y2 * (1.0 / 24 + y2 * (-1.0 / 720 + y2 * (1.0 / 40320 + y2 * (-1.0 / 3628800 + y2 * (1.0 / 479001600.0 + y2 * (-1.0 / 87178291200.0)))))));
#pragma unroll
    for (int i = 0; i < 2; ++i) { const double s2 = 2.0 * sn * cs, c2 = 1.0 - 2.0 * sn * sn; sn = s2; cs = c2; }
    c = (float)cs; s = (float)sn;
}

__device__ __forceinline__ void p0_prologue(Frame& F, const Args& a) {
    unsigned char* ws = a.ws;
    LAS float* scr = (LAS float*)(F.lds + F.wave * 16384);
    const int gw = F.vcu * NWAVES + F.wave, NGW = F.G * NWAVES;
    constexpr int I_SQ = 16 * 32, I_WG = 4 * 8, I_GU = 16 * 88, I_DN = 44 * 32, I_QKV = 16 * 96;
    constexpr int NITEMS = I_SQ + 4 * I_WG + I_SQ + 3 * I_GU + I_QKV + I_SQ + 3 * I_GU;
    static_assert(I_GU == I_DN, "items");
    const float* norm_mix = a.in[1]; const float* norm_ffn = a.in[2];
    for (int it = gw; it < NITEMS; it += NGW) {
        int r = it;
        if (r < I_SQ) { p0_tr_item(a.in[4], D, D, (bf16*)(ws + WS_WIN), 0, 0, 0, nullptr, nullptr, scr, r, F.lane); continue; } r -= I_SQ;
        if (r < 4 * I_WG) { const int g = r / I_WG; p0_tr_item(a.in[5] + (size_t)g * 256 * 256, 256, 256, (bf16*)(ws + WS_WG), 0, 0, g * 256, nullptr, a.in[6] + g * 256, scr, r % I_WG, F.lane); continue; } r -= 4 * I_WG;
        if (r < I_SQ) { p0_tr_item(a.in[7], D, D, (bf16*)(ws + WS_WPO), 0, 0, 0, nullptr, nullptr, scr, r, F.lane); continue; } r -= I_SQ;
        if (r < I_GU) { p0_tr_item(a.in[10], D, FF, (bf16*)(ws + WS_WGU0), 1, 0, 0, norm_ffn, nullptr, scr, r, F.lane); continue; } r -= I_GU;
        if (r < I_GU) { p0_tr_item(a.in[11], D, FF, (bf16*)(ws + WS_WGU0), 1, 1, 0, norm_ffn, nullptr, scr, r, F.lane); continue; } r -= I_GU;
        if (r < I_DN) { p0_tr_item(a.in[12], FF, D, (bf16*)(ws + WS_WD0), 0, 0, 0, nullptr, nullptr, scr, r, F.lane); continue; } r -= I_DN;
        if (r < I_QKV) { p0_tr_item(a.in[8], D, 3 * D, (bf16*)(ws + WS_WQKV), 2, 0, 0, norm_mix + D, nullptr, scr, r, F.lane); continue; } r -= I_QKV;
        if (r < I_SQ) { p0_tr_item(a.in[9], D, D, (bf16*)(ws + WS_WAO), 0, 0, 0, nullptr, nullptr, scr, r, F.lane); continue; } r -= I_SQ;
        if (r < I_GU) { p0_tr_item(a.in[10] + (size_t)D * FF, D, FF, (bf16*)(ws + WS_WGU1), 1, 0, 0, norm_ffn + D, nullptr, scr, r, F.lane); continue; } r -= I_GU;
        if (r < I_GU) { p0_tr_item(a.in[11] + (size_t)D * FF, D, FF, (bf16*)(ws + WS_WGU1), 1, 1, 0, norm_ffn + D, nullptr, scr, r, F.lane); continue; } r -= I_GU;
        p0_tr_item(a.in[12] + (size_t)D * FF, FF, D, (bf16*)(ws + WS_WD1), 0, 0, 0, nullptr, nullptr, scr, r, F.lane);
    }
    {
        float* rope = (float*)(ws + WS_ROPE);
        for (int e = (F.vcu * NWAVES * 64 + F.tid); e < SEQ * 32; e += F.G * NWAVES * 64) {
            const int t = e >> 5, j = e & 31;
            const float invf = (float)(1.0 / (double)(float)exp2(13.287712379549449 * (double)j / 32.0));
            const float ang = (float)t * invf; float c, s; sincos_acc(ang, c, s);
            rope[(size_t)t * 64 + j] = c; rope[(size_t)t * 64 + 32 + j] = s;
        }
    }
    __syncthreads();
    {
        const float* x = a.in[0]; const float* g0 = norm_mix;
        bf16* hp = (bf16*)(ws + WS_BIG);
        LAS float* rs = (LAS float*)(F.lds + 131072);
        const int half = F.tid >> 8, c4 = F.tid & 255, wq = F.wave & 3;
        const f32x4 gv = *(const f32x4*)(g0 + 4 * c4);
        for (int blk = F.vcu; blk < M / 64; blk += F.G) {
            const int R0 = blk * 64 + half * 32;
            const bool bstart = (R0 & (SEQ - 1)) == 0;
            for (int k = wq; k < 48; k += 4) {
                const int row = R0 - 16 + k; float r = 0.f;
                if (!(bstart && k < 16)) {
                    const GAS f32x4* xr = (const GAS f32x4*)(x + (size_t)row * D) + F.lane; float s = 0.f;
#pragma unroll
                    for (int j = 0; j < 4; ++j) { const f32x4 v = xr[64 * j]; s += (v[0] * v[0] + v[1] * v[1]) + (v[2] * v[2] + v[3] * v[3]); }
                    r = rsqrtf(wave_sum(s) * (1.0f / D) + 1e-6f);
                }
                if (F.lane == 0) rs[half * 48 + k] = r;
            }
            LDS_WAIT(); __syncthreads();
            f32x4 ring[16];
#pragma unroll
            for (int j = 0; j < 16; ++j) ring[j] = (f32x4){0.f, 0.f, 0.f, 0.f};
            f32x4 S2 = ring[0], S4 = ring[0], S8 = ring[0], S16 = ring[0];
            for (int kk = 0; kk < 3; ++kk) {
#pragma unroll
                for (int j = 0; j < 16; ++j) {
                    const int k = kk * 16 + j, row = R0 - 16 + k;
                    f32x4 hv = (f32x4){0.f, 0.f, 0.f, 0.f};
                    if (!(bstart && kk == 0)) { const f32x4 xv = *(const GAS f32x4*)(x + (size_t)row * D + 4 * c4); hv = xv * rs[half * 48 + k] * gv; }
                    S2 = S2 + hv - ring[(j + 14) & 15]; S4 = S4 + hv - ring[(j + 12) & 15]; S8 = S8 + hv - ring[(j + 8) & 15]; S16 = S16 + hv - ring[j];
                    ring[j] = hv;
                    if (kk > 0) {
                        const int t = row & (SEQ - 1);
                        const float i2 = t >= 1 ? 0.5f : 1.0f, i4 = t >= 3 ? 0.25f : 1.0f / (float)(t + 1), i8 = t >= 7 ? 0.125f : 1.0f / (float)(t + 1), i16 = t >= 15 ? 0.0625f : 1.0f / (float)(t + 1);
                        const f32x4 o2 = S2 * i2 - hv, o4 = S4 * i4 - hv, o8 = S8 * i8 - hv, o16 = S16 * i16 - hv;
                        const size_t off = (size_t)row * D + 4 * c4;
                        *(GAS v2u*)(hp + off) = (v2u){pk2(o2[0], o2[1]), pk2(o2[2], o2[3])};
                        *(GAS v2u*)(hp + (size_t)M * D + off) = (v2u){pk2(o4[0], o4[1]), pk2(o4[2], o4[3])};
                        *(GAS v2u*)(hp + 2 * (size_t)M * D + off) = (v2u){pk2(o8[0], o8[1]), pk2(o8[2], o8[3])};
                        *(GAS v2u*)(hp + 3 * (size_t)M * D + off) = (v2u){pk2(o16[0], o16[1]), pk2(o16[2], o16[3])};
                    }
                }
            }
            __syncthreads();
        }
    }
}

namespace att {
typedef short bf16x8 __attribute__((ext_vector_type(8)));
typedef short s16x4 __attribute__((ext_vector_type(4)));
typedef float f32x16 __attribute__((ext_vector_type(16)));
typedef unsigned u32x4 __attribute__((ext_vector_type(4)));
constexpr int KCH = 6160;
constexpr int LDS_K = 0, LDS_V = 8 * KCH, VDH = 24 * 1024 + 64, LDS_OST = LDS_V + 2 * VDH, LDS_TOTAL = LDS_OST + 8 * 4096;
static_assert(LDS_TOTAL <= LDS_BYTES, "attention LDS");
__device__ __forceinline__ int crow(int r, int hi) { return (r & 3) + 8 * (r >> 2) + 4 * hi; }
__device__ __forceinline__ s16x4 vtr(const LAS unsigned char* p) { return __builtin_bit_cast(s16x4, __builtin_amdgcn_ds_read_tr16_b64_v4i16((LAS s16x4*)p)); }
__device__ __forceinline__ void attn_item(int bh, int j, const bf16* Qp, const bf16* Kp, const bf16* Vp, bf16* O, float* lse, LAS unsigned char* shm) {
    int tid = threadIdx.x; asm volatile("" : "+v"(tid));
    const int lane = tid & 63, r32 = lane & 31, hi = lane >> 5; const int wid = __builtin_amdgcn_readfirstlane(tid >> 6);
    const int b = bh >> 4, h = bh & 15;
    const int dsh = h < 6 ? 0 : (h < 11 ? 2 : 4);
    const int nqb = 32 >> dsh, r = j >> (5 - dsh), qb = j & (nqb - 1);
    const bool first = (qb == 0);
    const size_t hb = (size_t)bh * (SEQ * 64);
    const int pos0 = j * 256;
#pragma unroll
    for (int it = 0; it < 6; ++it) {
        const int p = tid + 512 * it, key = p >> 3, c = p & 7;
        u32x4 kv = (u32x4){0u, 0u, 0u, 0u}, vv = (u32x4){0u, 0u, 0u, 0u};
        if (!(first && key < 128)) { const size_t go = hb + (size_t)(pos0 - 128 + key) * 64 + c * 8; kv = *(const GAS u32x4*)(Kp + go); vv = *(const GAS u32x4*)(Vp + go); }
        *(LAS u32x4*)(shm + LDS_K + c * KCH + key * 16) = kv;
        *(LAS u32x4*)(shm + LDS_V + (c >> 2) * VDH + (key >> 4) * 1024 + (key & 15) * 64 + (c & 3) * 16) = vv;
    }
    bf16x8 qr[4];
#pragma unroll
    for (int d0 = 0; d0 < 4; ++d0) qr[d0] = *(const GAS bf16x8*)(Qp + hb + (size_t)(pos0 + 32 * wid + r32) * 64 + d0 * 16 + hi * 8);
    LDS_WAIT(); __syncthreads();
    f32x16 P[5];
    const LAS unsigned char* kbase = shm + LDS_K + hi * KCH + (32 * wid + r32) * 16;
#pragma unroll
    for (int kt = 0; kt < 5; ++kt) {
        f32x16 acc = {0.f, 0.f, 0.f, 0.f, 0.f, 0.f, 0.f, 0.f, 0.f, 0.f, 0.f, 0.f, 0.f, 0.f, 0.f, 0.f};
#pragma unroll
        for (int d0 = 0; d0 < 4; ++d0) { const bf16x8 kf = *(const LAS bf16x8*)(kbase + (2 * d0) * KCH + kt * 512); acc = __builtin_amdgcn_mfma_f32_32x32x16_bf16(kf, qr[d0], acc, 0, 0, 0); }
        P[kt] = acc;
    }
    const float NEG = -INFINITY;
    const int lowlim = first ? (128 - 32 * wid) : 0;
    const int lo0 = r32 > lowlim ? r32 : lowlim;
#pragma unroll
    for (int rr = 0; rr < 16; ++rr) { const int cr = crow(rr, hi); if (cr < lo0) P[0][rr] = NEG; if (cr > r32) P[4][rr] = NEG; }
    if (first) {
#pragma unroll
        for (int kt = 1; kt < 4; ++kt)
#pragma unroll
            for (int rr = 0; rr < 16; ++rr) if (32 * kt + crow(rr, hi) < lowlim) P[kt][rr] = NEG;
    }
    float mx = NEG;
#pragma unroll
    for (int kt = 0; kt < 5; ++kt)
#pragma unroll
        for (int rr = 0; rr < 16; ++rr) mx = fmaxf(mx, P[kt][rr]);
    mx = fmaxf(mx, __shfl_xor(mx, 32));
    float l = 0.f;
#pragma unroll
    for (int kt = 0; kt < 5; ++kt)
#pragma unroll
        for (int rr = 0; rr < 16; ++rr) { const float e = __builtin_amdgcn_exp2f(P[kt][rr] - mx); P[kt][rr] = e; l += e; }
    l += __shfl_xor(l, 32);
    const float inv = 1.0f / l;
    {
        const int i = qb * 256 + 32 * wid + r32, t = (i << dsh) + r;
        if (hi == 0) lse[((size_t)b * SEQ + t) * 16 + h] = (mx + log2f(l)) * 0.6931471805599453f;
    }
    f32x16 o[2];
    o[0] = (f32x16){0.f, 0.f, 0.f, 0.f, 0.f, 0.f, 0.f, 0.f, 0.f, 0.f, 0.f, 0.f, 0.f, 0.f, 0.f, 0.f}; o[1] = o[0];
    const LAS unsigned char* vb = shm + LDS_V + ((lane >> 4) & 1) * 32 + (lane & 3) * 8 + (4 * hi + ((lane & 15) >> 2)) * 64;
#pragma unroll
    for (int kt = 0; kt < 5; ++kt)
#pragma unroll
        for (int s = 0; s < 2; ++s) {
            u32x4 pw;
            pw.x = pg8::cvt_pk_bf16(P[kt][8 * s + 0] * inv, P[kt][8 * s + 1] * inv); pw.y = pg8::cvt_pk_bf16(P[kt][8 * s + 2] * inv, P[kt][8 * s + 3] * inv);
            pw.z = pg8::cvt_pk_bf16(P[kt][8 * s + 4] * inv, P[kt][8 * s + 5] * inv); pw.w = pg8::cvt_pk_bf16(P[kt][8 * s + 6] * inv, P[kt][8 * s + 7] * inv);
            const bf16x8 pa = __builtin_bit_cast(bf16x8, pw);
            const int kblk = 2 * wid + 2 * kt + s;
#pragma unroll
            for (int dh = 0; dh < 2; ++dh) {
                const s16x4 vlo = vtr(vb + dh * VDH + kblk * 1024), vhi = vtr(vb + dh * VDH + kblk * 1024 + 512);
                const bf16x8 vf = (bf16x8){vlo[0], vlo[1], vlo[2], vlo[3], vhi[0], vhi[1], vhi[2], vhi[3]};
                o[dh] = __builtin_amdgcn_mfma_f32_32x32x16_bf16(pa, vf, o[dh], 0, 0, 0);
            }
        }
    {
        LAS bf16* stg = (LAS bf16*)(shm + LDS_OST + wid * 4096);
#pragma unroll
        for (int rr = 0; rr < 16; ++rr) { const int orow = crow(rr, hi);
#pragma unroll
            for (int dh = 0; dh < 2; ++dh) stg[orow * 64 + dh * 32 + r32] = (bf16)f2bf(o[dh][rr]); }
        LDS_WAIT(); asm volatile("" ::: "memory");
#pragma unroll
        for (int i4 = 0; i4 < 4; ++i4) { const int row = i4 * 8 + (lane >> 3), ch = lane & 7; const u32x4 v = *(const LAS u32x4*)(stg + row * 64 + ch * 8);
            const int i = qb * 256 + 32 * wid + row, t = (i << dsh) + r;
            *(GAS u32x4*)(O + ((size_t)b * SEQ + t) * D + h * 64 + ch * 8) = v; }
    }
    LDS_WAIT(); __syncthreads();
}
}

__global__ void __launch_bounds__(NWAVES * 64, 2) fwd_megakernel(Args args) {
    extern __shared__ __attribute__((aligned(16))) unsigned char lds[];
    Frame F;
    F.lds = (LAS unsigned char*)lds;
    F.tid = threadIdx.x; F.lane = F.tid & 63; F.wave = __builtin_amdgcn_readfirstlane(F.tid >> 6);
    F.G = gridDim.x; { const int bx = blockIdx.x; F.vcu = (F.G % 8 == 0) ? (bx % 8) * (F.G / 8) + bx / 8 : bx; }
    unsigned char* ws = args.ws;
    const int lo = args.ph_lo, hi = args.ph_hi;
    const bool one_launch = (hi - lo) > 1;
    volatile LAS unsigned* bst = (volatile LAS unsigned*)(F.lds + 131072 + 1024);
    if (F.tid < 2) bst[F.tid] = 0u;
    __syncthreads();
    XcdBarrier bar; bar.bar = (unsigned*)(ws + WS_CTL) + CW_BAR; bar.x = 0; bar.st = bst;
    if (one_launch) bar = xcd_barrier_post((unsigned*)(ws + WS_CTL) + CW_BAR, bst);
#define IN(k) (lo <= (k) && (k) < hi)
#define SEAM(k) do { if (IN(k) && IN((k) + 1)) { if ((k) == 0) cg::this_grid().sync(); else xcd_barrier(bar); } } while (0)

    float* resid = args.out;
    float* ssb = (float*)(ws + WS_SS);
    bf16* xb = (bf16*)(ws + WS_XB);
    bf16* zo = (bf16*)(ws + WS_ZO);
    bf16* big = (bf16*)(ws + WS_BIG);

    if (IN(0)) { p0_prologue(F, args); }
    SEAM(0);
    if (IN(1)) {
        pg8::Gemm g{big, (const bf16*)(ws + WS_WIN), M, D, D, D, D, (size_t)M * D * 2};
        pg8::StaticOrder S; S.init(M, D, F.G, (int)blockIdx.x);
        pg8::EpiBf16 E{xb, D};
        pg8::gemm_phase<pg8::EpiBf16, pg8::StaticOrder, true>(F.lds, g, S, E);
    }
    SEAM(1);
    if (IN(2)) {
        pg8::Gemm g{xb, (const bf16*)(ws + WS_WG), M, D, 256, D, 256, (size_t)256 * 2};
        pg8::StaticOrder S; S.init(M, D, F.G, (int)blockIdx.x);
        pg8::EpiBf16 E{zo, D};
        pg8::gemm_phase<pg8::EpiBf16, pg8::StaticOrder, true>(F.lds, g, S, E);
    }
    SEAM(2);
    if (IN(3)) {
        pg8::Gemm g{zo, (const bf16*)(ws + WS_WPO), M, D, D, D, D, 0};
        pg8::StaticOrder S; S.init(M, D, F.G, (int)blockIdx.x);
        pg8::EpiRes E{args.in[0], resid, xb, ssb};
        pg8::gemm_phase<pg8::EpiRes, pg8::StaticOrder, true>(F.lds, g, S, E);
    }
    SEAM(3);
#pragma unroll 1
    for (int layer = 0; layer < 2; ++layer) {
        const int pb = layer == 0 ? 4 : 10;
        if (IN(pb)) {
            pg8::Gemm g{xb, (const bf16*)(ws + (layer == 0 ? WS_WGU0 : WS_WGU1)), M, 2 * FF, D, D, D, 0};
            pg8::StaticOrder S; S.init(M, 2 * FF, F.G, (int)blockIdx.x);
            pg8::EpiSwiGLU E{big, ssb, FF};
            pg8::gemm_phase<pg8::EpiSwiGLU, pg8::StaticOrder, true>(F.lds, g, S, E);
        }
        SEAM(pb);
        if (IN(pb + 1)) {
            pg8::Gemm g{big, (const bf16*)(ws + (layer == 0 ? WS_WD0 : WS_WD1)), M, D, FF, FF, FF, 0};
            pg8::StaticOrder S; S.init(M, D, F.G, (int)blockIdx.x);
            pg8::EpiRes E{resid, resid, xb, ssb};
            pg8::gemm_phase<pg8::EpiRes, pg8::StaticOrder, true>(F.lds, g, S, E);
        }
        SEAM(pb + 1);
        if (layer == 0) {
            bf16* qb_ = big; bf16* kb_ = big + (size_t)M * D; bf16* vb_ = big + 2 * (size_t)M * D;
            if (IN(6)) {
                pg8::Gemm g{xb, (const bf16*)(ws + WS_WQKV), M, 3 * D, D, D, D, 0};
                pg8::StaticOrder S; S.init(M, 3 * D, F.G, (int)blockIdx.x);
                pg8::EpiQKV E{qb_, ssb, (const float*)(ws + WS_ROPE)};
                pg8::gemm_phase<pg8::EpiQKV, pg8::StaticOrder, true>(F.lds, g, S, E);
            }
            SEAM(6);
            if (IN(7)) {
                const int ipw = (1024 + F.G - 1) / F.G;
                for (int i = 0; i < ipw; ++i) { const int item = F.vcu * ipw + i; if (item < 1024) att::attn_item(item >> 5, item & 31, qb_, kb_, vb_, zo, (float*)(ws + WS_LSE), F.lds); }
            }
            SEAM(7);
            if (IN(8)) {
                const float* lse = (const float*)(ws + WS_LSE);
                for (int m = F.vcu * NWAVES + F.wave; m < M; m += F.G * NWAVES) {
                    float L[16];
#pragma unroll
                    for (int q4 = 0; q4 < 4; ++q4) { const f32x4 v = *(const GAS f32x4*)(lse + (size_t)m * 16 + 4 * q4); L[4 * q4] = v[0]; L[4 * q4 + 1] = v[1]; L[4 * q4 + 2] = v[2]; L[4 * q4 + 3] = v[3]; }
                    float lg[3];
                    { float mx = L[0];
_Pragma("unroll") for (int i = 1; i < 6; ++i) mx = fmaxf(mx, L[i]); float s = 0.f;
_Pragma("unroll") for (int i = 0; i < 6; ++i) s += __expf(L[i] - mx); lg[0] = mx + __logf(s) - 1.791759469228055f; }
                    { float mx = L[6];
_Pragma("unroll") for (int i = 7; i < 11; ++i) mx = fmaxf(mx, L[i]); float s = 0.f;
_Pragma("unroll") for (int i = 6; i < 11; ++i) s += __expf(L[i] - mx); lg[1] = mx + __logf(s) - 1.6094379124341003f; }
                    { float mx = L[11];
_Pragma("unroll") for (int i = 12; i < 16; ++i) mx = fmaxf(mx, L[i]); float s = 0.f;
_Pragma("unroll") for (int i = 11; i < 16; ++i) s += __expf(L[i] - mx); lg[2] = mx + __logf(s) - 1.6094379124341003f; }
                    const float mx = fmaxf(lg[0], fmaxf(lg[1], lg[2]));
                    const float e0 = __expf(lg[0] - mx), e1 = __expf(lg[1] - mx), e2 = __expf(lg[2] - mx); const float is = 3.0f / (e0 + e1 + e2);
                    const int head = F.lane >> 2; const float sc = (head < 6 ? e0 : (head < 11 ? e1 : e2)) * is;
                    GAS v4u* p = (GAS v4u*)(zo + (size_t)m * D + 16 * F.lane);
#pragma unroll
                    for (int q2 = 0; q2 < 2; ++q2) { v4u w = p[q2];
                        w.x = pk2(bflo(w.x) * sc, bfhi(w.x) * sc); w.y = pk2(bflo(w.y) * sc, bfhi(w.y) * sc); w.z = pk2(bflo(w.z) * sc, bfhi(w.z) * sc); w.w = pk2(bflo(w.w) * sc, bfhi(w.w) * sc);
                        p[q2] = w; }
                }
            }
            SEAM(8);
            if (IN(9)) {
                pg8::Gemm g{zo, (const bf16*)(ws + WS_WAO), M, D, D, D, D, 0};
                pg8::StaticOrder S; S.init(M, D, F.G, (int)blockIdx.x);
                pg8::EpiRes E{resid, resid, xb, ssb};
                pg8::gemm_phase<pg8::EpiRes, pg8::StaticOrder, true>(F.lds, g, S, E);
            }
            SEAM(9);
        }
    }
    if (IN(12)) {
        const float* gf = args.in[3];
        for (int m = F.vcu * NWAVES + F.wave; m < M; m += F.G * NWAVES) {
            float s = 0.f;
#pragma unroll
            for (int q4 = 0; q4 < 4; ++q4) { const f32x4 v = *(const GAS f32x4*)(ssb + (size_t)m * 16 + 4 * q4); s += (v[0] + v[1]) + (v[2] + v[3]); }
            const float rstd = rsqrtf(s * (1.0f / D) + 1e-6f);
            GAS f32x4* xr = (GAS f32x4*)(resid + (size_t)m * D) + F.lane;
#pragma unroll
            for (int j = 0; j < 4; ++j) { const f32x4 gq = *(const GAS f32x4*)(gf + 4 * F.lane + 256 * j); xr[64 * j] = xr[64 * j] * rstd * gq; }
        }
    }
#undef IN
#undef SEAM
}

extern "C" void kernel_launch(void* const* d_in, const int* in_sizes, int n_in, void* d_out, int out_size, void* d_ws, size_t ws_size, hipStream_t stream) {
    static int grid = 0;
    if (grid == 0) {
        if (n_in != 13 || in_sizes[0] != M * D || out_size != M * D || ws_size < WS_END) { fprintf(stderr, "kernel_launch: unexpected shapes (n_in %d, in0 %d, out %d, ws %zu); nothing launched\n", n_in, n_in > 0 ? in_sizes[0] : -1, out_size, ws_size); grid = -1; return; }
        int dev = 0, cus = 0, per_cu = 0;
        if (hipGetDevice(&dev) != hipSuccess || hipDeviceGetAttribute(&cus, hipDeviceAttributeMultiprocessorCount, dev) != hipSuccess) { grid = -1; return; }
        if (hipFuncSetAttribute((const void*)fwd_megakernel, hipFuncAttributeMaxDynamicSharedMemorySize, LDS_BYTES) != hipSuccess) { fprintf(stderr, "kernel_launch: hipFuncSetAttribute failed\n"); grid = -1; return; }
        if (hipOccupancyMaxActiveBlocksPerMultiprocessor(&per_cu, (const void*)fwd_megakernel, NWAVES * 64, LDS_BYTES) != hipSuccess || per_cu < 1) { fprintf(stderr, "kernel_launch: occupancy query says %d blocks per CU\n", per_cu); per_cu = 1; }
        (void)hipGetLastError();
        grid = cus;
    }
    if (grid < 0) return;
    if (hipMemsetAsync((char*)d_ws + WS_CTL, 0, CTL_ZERO_BYTES, stream) != hipSuccess) { fprintf(stderr, "kernel_launch: memset failed\n"); return; }
    Args a{};
    for (int i = 0; i < 13; ++i) a.in[i] = (const float*)d_in[i];
    a.out = (float*)d_out; a.ws = (unsigned char*)d_ws;
#if MK_N_LAUNCHES == 1
    a.ph_lo = 0; a.ph_hi = 13;
    void* kargs[] = {&a};
    hipError_t e = hipLaunchCooperativeKernel((const void*)fwd_megakernel, dim3(grid), dim3(NWAVES * 64), kargs, LDS_BYTES, stream);
    if (e != hipSuccess) fprintf(stderr, "kernel_launch: cooperative launch failed: %s (grid %d)\n", hipGetErrorString(e), grid);
#else
    for (int p = 0; p < 13; ++p) { a.ph_lo = p; a.ph_hi = p + 1; hipLaunchKernelGGL(fwd_megakernel, dim3(grid), dim3(NWAVES * 64), LDS_BYTES, stream, a); }
#endif
}
```

```cpp
#include <hip/hip_runtime.h>
#include <hip/hip_cooperative_groups.h>
#include <cstdio>
#include <cstdint>
namespace cg = cooperative_groups;

#ifndef MK_N_LAUNCHES
#define MK_N_LAUNCHES 1
#endif

namespace pg8 {
#define PG8_LAS __attribute__((address_space(3)))
typedef unsigned short bf16_t;
typedef short bf16x8 __attribute__((ext_vector_type(8)));
typedef float f32x4 __attribute__((ext_vector_type(4)));
typedef unsigned u32x4 __attribute__((ext_vector_type(4)));
constexpr int BM = 256, BK = 64, HALF = 128, HTB = HALF * BK * 2, STAGE_BYTES = 8 * HTB, NXCD = 8, WGM = 8;

__host__ __device__ __forceinline__ int lds_byte(int r, int c) { const int st = (r >> 4) * 2 + (c >> 5), rr = r & 15, cc = c & 31, ob = rr * 64 + cc * 2; return st * 1024 + (ob ^ (((ob >> 9) & 1) << 5)); }
__host__ __device__ __forceinline__ void stage_rc(int b, int& R, int& C) { const int st = b / 1024, sb = b % 1024, swz = sb ^ (((sb >> 9) & 1) << 5); R = (st >> 1) * 16 + swz / 64; C = (st & 1) * 32 + (swz % 64) / 2; }
__host__ __device__ __forceinline__ int perm32(int rho) { const int n = rho >> 4, i = rho & 15; return 8 * (i >> 2) + 4 * n + (i & 3); }

struct Unit { int pm, pn; };
struct Gemm { const bf16_t* A; const bf16_t* Bt; int M, N, K, lda, ldb; size_t a_pn_bytes; };

struct StaticOrder {
    int nM, nN, nwg, G, c;
    __host__ __device__ void init(int M, int N, int G_, int c_) { nM = M / BM; nN = N / BM; nwg = nM * nN; G = G_; c = c_; }
    __host__ __device__ bool next(int i, Unit& u) const {
        const long L = (long)i * G + c; if (L >= nwg) return false;
        int wgid = (int)L; { const int q = nwg / NXCD, r = nwg % NXCD, xcd = wgid % NXCD, off = wgid / NXCD; wgid = (xcd < r ? xcd * (q + 1) : r * (q + 1) + (xcd - r) * q) + off; }
        const int nig = WGM * nN, gid = wgid / nig, fm = gid * WGM, gsz = (nM - fm) < WGM ? (nM - fm) : WGM;
        u.pm = fm + ((wgid % nig) % gsz); u.pn = (wgid % nig) / gsz; return true;
    }
};

__device__ __forceinline__ unsigned cvt_pk_bf16(float lo, float hi) { unsigned r; asm volatile("v_cvt_pk_bf16_f32 %0, %1, %2" : "=v"(r) : "v"(lo), "v"(hi)); return r; }

constexpr float RMS_EPS = 1e-6f;

struct EpiBf16 {
    bf16_t* O; int ldc;
    __device__ __forceinline__ void operator()(const f32x4 (&acc)[2][2][4][2], const Unit& u, int wr, int wc, int fr, int fq) const {
        const int row0 = u.pm * BM + wr * 64 + fr, col0 = u.pn * BM + wc * 32 + 8 * fq;
#pragma unroll
        for (int ai = 0; ai < 2; ++ai)
#pragma unroll
            for (int m = 0; m < 4; ++m) { bf16_t* rowp = O + (size_t)(row0 + ai * HALF + m * 16) * ldc + col0;
#pragma unroll
                for (int bj = 0; bj < 2; ++bj) { const f32x4 v0 = acc[ai][bj][m][0], v1 = acc[ai][bj][m][1];
                    u32x4 w; w.x = cvt_pk_bf16(v0[0], v0[1]); w.y = cvt_pk_bf16(v0[2], v0[3]); w.z = cvt_pk_bf16(v1[0], v1[1]); w.w = cvt_pk_bf16(v1[2], v1[3]);
                    *(u32x4*)(rowp + bj * HALF) = w; } }
    }
};
struct EpiRes {
    const float* base; float* out; bf16_t* xb; float* ss;
    __device__ __forceinline__ void operator()(const f32x4 (&acc)[2][2][4][2], const Unit& u, int wr, int wc, int fr, int fq) const {
        const int row0 = u.pm * BM + wr * 64 + fr, col0 = u.pn * BM + wc * 32 + 8 * fq;
#pragma unroll
        for (int ai = 0; ai < 2; ++ai)
#pragma unroll
            for (int m = 0; m < 4; ++m) { const size_t row = (size_t)(row0 + ai * HALF + m * 16); const size_t off = row * 1024 + col0; float s = 0.f;
#pragma unroll
                for (int bj = 0; bj < 2; ++bj) {
                    const f32x4 b0 = *(const f32x4*)(base + off + bj * HALF), b1 = *(const f32x4*)(base + off + bj * HALF + 4);
                    const f32x4 v0 = acc[ai][bj][m][0] + b0, v1 = acc[ai][bj][m][1] + b1;
                    *(f32x4*)(out + off + bj * HALF) = v0; *(f32x4*)(out + off + bj * HALF + 4) = v1;
                    s += (v0[0] * v0[0] + v0[1] * v0[1]) + (v0[2] * v0[2] + v0[3] * v0[3]) + (v1[0] * v1[0] + v1[1] * v1[1]) + (v1[2] * v1[2] + v1[3] * v1[3]);
                    u32x4 w; w.x = cvt_pk_bf16(v0[0], v0[1]); w.y = cvt_pk_bf16(v0[2], v0[3]); w.z = cvt_pk_bf16(v1[0], v1[1]); w.w = cvt_pk_bf16(v1[2], v1[3]);
                    *(u32x4*)(xb + off + bj * HALF) = w; }
                s += __shfl_xor(s, 16); s += __shfl_xor(s, 32);
                if (fq == 0) ss[row * 16 + u.pn * 4 + wc] = s; }
    }
};
__device__ __forceinline__ float row_rstd(const float* ss, size_t row, int fq) {
    const f32x4 p = *(const f32x4*)(ss + row * 16 + 4 * fq); float s = (p[0] + p[1]) + (p[2] + p[3]);
    s += __shfl_xor(s, 16); s += __shfl_xor(s, 32);
    return rsqrtf(s * (1.0f / 1024.0f) + RMS_EPS);
}
struct EpiSwiGLU {
    bf16_t* act; const float* ss; int ldc;
    __device__ __forceinline__ void operator()(const f32x4 (&acc)[2][2][4][2], const Unit& u, int wr, int wc, int fr, int fq) const {
        const int row0 = u.pm * BM + wr * 64 + fr, col0 = u.pn * HALF + wc * 32 + 8 * fq;
#pragma unroll
        for (int ai = 0; ai < 2; ++ai)
#pragma unroll
            for (int m = 0; m < 4; ++m) { const size_t row = (size_t)(row0 + ai * HALF + m * 16); const float rstd = row_rstd(ss, row, fq);
                float a[8];
#pragma unroll
                for (int n = 0; n < 2; ++n)
#pragma unroll
                    for (int i = 0; i < 4; ++i) { const float g = acc[ai][0][m][n][i] * rstd, up = acc[ai][1][m][n][i] * rstd;
                        a[n * 4 + i] = g * up * __builtin_amdgcn_rcpf(1.0f + __builtin_amdgcn_exp2f(-1.4426950408889634f * g)); }
                u32x4 w; w.x = cvt_pk_bf16(a[0], a[1]); w.y = cvt_pk_bf16(a[2], a[3]); w.z = cvt_pk_bf16(a[4], a[5]); w.w = cvt_pk_bf16(a[6], a[7]);
                *(u32x4*)(act + row * ldc + col0) = w; }
    }
};
struct EpiQKV {
    bf16_t* qkv; const float* ss; const float* rope;
    __device__ __forceinline__ void operator()(const f32x4 (&acc)[2][2][4][2], const Unit& u, int wr, int wc, int fr, int fq) const {
        const int row0 = u.pm * BM + wr * 64 + fr; const int sect = u.pn >> 2, head = (u.pn & 3) * 4 + wc;
        const int dsh = head < 6 ? 0 : (head < 11 ? 2 : 4);
        bf16_t* dst = qkv + (size_t)sect * ((size_t)16384 * 1024);
        const float qs = sect == 0 ? 0.125f * 1.4426950408889634f : 1.0f;
#pragma unroll
        for (int ai = 0; ai < 2; ++ai)
#pragma unroll
            for (int m = 0; m < 4; ++m) { const int row = row0 + ai * HALF + m * 16; const float rstd = row_rstd(ss, (size_t)row, fq) * qs;
                const int b = row >> 13, t = row & 8191; const int pos = ((t & ((1 << dsh) - 1)) << (13 - dsh)) + (t >> dsh);
                bf16_t* o = dst + ((size_t)(b * 16 + head) * 8192 + pos) * 64 + 8 * fq;
                float lo[8], hi[8];
#pragma unroll
                for (int n = 0; n < 2; ++n)
#pragma unroll
                    for (int i = 0; i < 4; ++i) { lo[n * 4 + i] = acc[ai][0][m][n][i] * rstd; hi[n * 4 + i] = acc[ai][1][m][n][i] * rstd; }
                if (sect < 2) {
                    const float* rp = rope + (size_t)t * 64 + 8 * fq;
                    const f32x4 c0 = *(const f32x4*)(rp), c1 = *(const f32x4*)(rp + 4), s0 = *(const f32x4*)(rp + 32), s1 = *(const f32x4*)(rp + 36);
#pragma unroll
                    for (int i = 0; i < 8; ++i) { const float cs = i < 4 ? c0[i & 3] : c1[i & 3], sn = i < 4 ? s0[i & 3] : s1[i & 3];
                        const float l = lo[i], h = hi[i]; lo[i] = l * cs - h * sn; hi[i] = h * cs + l * sn; }
                }
                u32x4 w; w.x = cvt_pk_bf16(lo[0], lo[1]); w.y = cvt_pk_bf16(lo[2], lo[3]); w.z = cvt_pk_bf16(lo[4], lo[5]); w.w = cvt_pk_bf16(lo[6], lo[7]);
                *(u32x4*)(o) = w;
                w.x = cvt_pk_bf16(hi[0], hi[1]); w.y = cvt_pk_bf16(hi[2], hi[3]); w.z = cvt_pk_bf16(hi[4], hi[5]); w.w = cvt_pk_bf16(hi[6], hi[7]);
                *(u32x4*)(o + 32) = w; }
    }
};

template <class Epi, class Sched, bool ALIGN_EPI>
__device__ __forceinline__ void gemm_phase(PG8_LAS unsigned char* lds, const Gemm g, const Sched& S, const Epi& E) {
    int tid = threadIdx.x; asm volatile("" : "+v"(tid));
    const int wid = __builtin_amdgcn_readfirstlane(tid >> 6), lane = tid & 63, wr = wid >> 2, wc = wid & 3, fr = lane & 15, fq = lane >> 4;
    const int K = g.K, nt = K / BK;
    unsigned voffA[2], voffB[2];
#pragma unroll
    for (int i = 0; i < 2; ++i) { int R, C; stage_rc(tid * 16 + i * 8192, R, C); const int Rb = (R & ~31) + perm32(R & 31);
        voffA[i] = (unsigned)(R * g.lda + C) * 2u; voffB[i] = (unsigned)(Rb * g.ldb + C) * 2u; }
    const size_t kstep = (size_t)(BK * 2);
    const size_t hstepA = (size_t)HALF * g.lda * 2, hstepB = (size_t)HALF * g.ldb * 2;
    const size_t tstepA = 2 * hstepA, tstepB = 2 * hstepB;
    const unsigned ldsw = (unsigned)wid * 1024u;
    const int aoff = lds_byte(wr * 64 + fr, fq * 8), boff = lds_byte(wc * 32 + fr, fq * 8);
#define PG8_SA(b, h) (((b) * 2 + (h)) * HTB)
#define PG8_SB(b, h) ((4 + (b) * 2 + (h)) * HTB)
#define PG8_STAGE(bufoff, gbase, voff) do { _Pragma("unroll") for (int _i = 0; _i < 2; ++_i) \
        __builtin_amdgcn_global_load_lds((const unsigned*)((const char*)(gbase) + (voff)[_i]), (PG8_LAS unsigned*)(lds + (bufoff) + ldsw + _i * 8192), 16, 0, 0); } while (0)
#define PG8_LDA(dst, b, h) do { _Pragma("unroll") for (int m = 0; m < 4; ++m) _Pragma("unroll") for (int k = 0; k < 2; ++k) dst[m][k] = *(const PG8_LAS bf16x8*)(lds + PG8_SA(b, h) + aoff + m * 2048 + k * 1024); } while (0)
#define PG8_LDB(dst, b, h) do { _Pragma("unroll") for (int n = 0; n < 2; ++n) _Pragma("unroll") for (int k = 0; k < 2; ++k) dst[n][k] = *(const PG8_LAS bf16x8*)(lds + PG8_SB(b, h) + boff + n * 2048 + k * 1024); } while (0)
#define PG8_MMA(ai, bj, At, Bt) do { __builtin_amdgcn_s_setprio(1); _Pragma("unroll") for (int m = 0; m < 4; ++m) _Pragma("unroll") for (int n = 0; n < 2; ++n) _Pragma("unroll") for (int k = 0; k < 2; ++k) \
        acc[ai][bj][m][n] = __builtin_amdgcn_mfma_f32_16x16x32_bf16(Bt[n][k], At[m][k], acc[ai][bj][m][n], 0, 0, 0); __builtin_amdgcn_s_setprio(0); } while (0)
#define PG8_WAIT_V(n) asm volatile("s_waitcnt vmcnt(" #n ")" ::: "memory")
#define PG8_WAIT_L(n) asm volatile("s_waitcnt lgkmcnt(" #n ")" ::: "memory")
#define PG8_BAR __builtin_amdgcn_s_barrier()
#define PG8_SCHED __builtin_amdgcn_sched_barrier(0)
    Unit cur, nxt; int ui = 0;
    if (!S.next(0, cur)) return;
    f32x4 acc[2][2][4][2];
#pragma unroll
    for (int a = 0; a < 2; ++a)
#pragma unroll
        for (int b = 0; b < 2; ++b)
#pragma unroll
            for (int m = 0; m < 4; ++m)
#pragma unroll
                for (int n = 0; n < 2; ++n) acc[a][b][m][n] = (f32x4){0.f, 0.f, 0.f, 0.f};
    bf16x8 At[4][2], B0[2][2], B1[2][2];
    const char* cA = (const char*)g.A + (size_t)cur.pm * tstepA + (size_t)cur.pn * g.a_pn_bytes; const char* cB = (const char*)g.Bt + (size_t)cur.pn * tstepB;
    PG8_STAGE(PG8_SB(0, 0), cB, voffB); PG8_STAGE(PG8_SB(0, 1), cB + hstepB, voffB); PG8_STAGE(PG8_SA(0, 0), cA, voffA); PG8_STAGE(PG8_SA(0, 1), cA + hstepA, voffA);
    if (wr == 1) PG8_BAR;
    PG8_WAIT_V(2); PG8_BAR;
    PG8_STAGE(PG8_SB(1, 0), cB + kstep, voffB); PG8_STAGE(PG8_SA(1, 0), cA + kstep, voffA); PG8_STAGE(PG8_SB(1, 1), cB + hstepB + kstep, voffB);
    PG8_WAIT_V(6); PG8_BAR;
    for (;;) {
        const bool has_next = S.next(ui + 1, nxt);
        const char* nA = has_next ? (const char*)g.A + (size_t)nxt.pm * tstepA + (size_t)nxt.pn * g.a_pn_bytes : cA; const char* nB = has_next ? (const char*)g.Bt + (size_t)nxt.pn * tstepB : cB;
        for (int t = 0; t < nt; t += 2) {
            const bool last = (t == nt - 2);
            const char* a1 = cA + (size_t)(t + 1) * kstep;
            const char* a2 = last ? nA : cA + (size_t)(t + 2) * kstep; const char* b2 = last ? nB : cB + (size_t)(t + 2) * kstep;
            const char* a3 = a2 + kstep; const char* b3 = b2 + kstep;
            PG8_LDB(B0, 0, 0); PG8_LDB(B1, 0, 1); PG8_SCHED; PG8_LDA(At, 0, 0); PG8_STAGE(PG8_SA(1, 1), a1 + hstepA, voffA);
            PG8_WAIT_V(8); PG8_WAIT_L(0); PG8_BAR; PG8_MMA(0, 0, At, B0); PG8_MMA(0, 1, At, B1); PG8_BAR; PG8_SCHED;
            PG8_LDA(At, 0, 1); PG8_STAGE(PG8_SB(0, 0), b2, voffB); PG8_STAGE(PG8_SB(0, 1), b2 + hstepB, voffB); PG8_STAGE(PG8_SA(0, 0), a2, voffA);
            PG8_WAIT_V(8); PG8_WAIT_L(0); PG8_BAR; PG8_MMA(1, 0, At, B0); PG8_MMA(1, 1, At, B1); PG8_BAR; PG8_SCHED;
            PG8_LDB(B0, 1, 0); PG8_LDB(B1, 1, 1); PG8_SCHED; PG8_LDA(At, 1, 0); PG8_STAGE(PG8_SA(0, 1), a2 + hstepA, voffA);
            PG8_WAIT_V(8); PG8_WAIT_L(0); PG8_BAR; PG8_MMA(0, 0, At, B0); PG8_MMA(0, 1, At, B1); PG8_BAR; PG8_SCHED;
            PG8_LDA(At, 1, 1); PG8_STAGE(PG8_SB(1, 0), b3, voffB); PG8_STAGE(PG8_SB(1, 1), b3 + hstepB, voffB); PG8_STAGE(PG8_SA(1, 0), a3, voffA);
            PG8_WAIT_V(8); PG8_WAIT_L(0); PG8_BAR; PG8_MMA(1, 0, At, B0); PG8_MMA(1, 1, At, B1); PG8_BAR; PG8_SCHED;
        }
        if constexpr (ALIGN_EPI) { if (wr == 0) PG8_BAR; }
        E(acc, cur, wr, wc, fr, fq);
        if (!has_next) break;
#pragma unroll
        for (int a = 0; a < 2; ++a)
#pragma unroll
            for (int b = 0; b < 2; ++b)
#pragma unroll
                for (int m = 0; m < 4; ++m)
#pragma unroll
                    for (int n = 0; n < 2; ++n) acc[a][b][m][n] = (f32x4){0.f, 0.f, 0.f, 0.f};
        cur = nxt; cA = nA; cB = nB; ++ui;
        if constexpr (ALIGN_EPI) { if (wr == 1) PG8_BAR; }
    }
    PG8_WAIT_V(0);
    if constexpr (!ALIGN_EPI) { if (wr == 0) PG8_BAR; }
    PG8_BAR;
#undef PG8_SA
#undef PG8_SB
#undef PG8_STAGE
#undef PG8_LDA
#undef PG8_LDB
#undef PG8_MMA
#undef PG8_WAIT_V
#undef PG8_WAIT_L
#undef PG8_BAR
#undef PG8_SCHED
}
}

constexpr int NWAVES = 8;
constexpr int BATCH = 2, SEQ = 8192, D = 1024, H = 16, HD = 64, FF = 2816;
constexpr int M = BATCH * SEQ;
constexpr size_t MiB = 1u << 20;
constexpr size_t WS_CTL = 0, CTL_ZERO_BYTES = 64 * 1024;
constexpr size_t WS_ROPE = 1 * MiB;
constexpr size_t WS_SS = 3 * MiB;
constexpr size_t WS_LSE = 4 * MiB;
constexpr size_t WS_WIN = 6 * MiB;
constexpr size_t WS_WG = 8 * MiB;
constexpr size_t WS_WPO = 9 * MiB;
constexpr size_t WS_WGU0 = 11 * MiB;
constexpr size_t WS_WD0 = 22 * MiB;
constexpr size_t WS_WQKV = 28 * MiB;
constexpr size_t WS_WAO = 34 * MiB;
constexpr size_t WS_WGU1 = 36 * MiB;
constexpr size_t WS_WD1 = 47 * MiB;
constexpr size_t WS_BIG = 56 * MiB;
constexpr size_t WS_XB = 184 * MiB;
constexpr size_t WS_ZO = 216 * MiB;
constexpr size_t WS_END = 248 * MiB;
constexpr int CW_BAR = 1024;

constexpr int LDS_BYTES = 147456;

#define GAS __attribute__((address_space(1)))
#define LAS __attribute__((address_space(3)))
typedef unsigned short bf16;
typedef unsigned v4u __attribute__((ext_vector_type(4)));
typedef unsigned v2u __attribute__((ext_vector_type(2)));
typedef float f32x4 __attribute__((ext_vector_type(4)));
#define LDS_WAIT() asm volatile("s_waitcnt lgkmcnt(0)" ::: "memory")
__device__ __forceinline__ unsigned f2bf(float f) { unsigned u = __builtin_bit_cast(unsigned, f); return (u + 0x7fffu + ((u >> 16) & 1u)) >> 16; }
__device__ __forceinline__ unsigned pk2(float lo, float hi) { return f2bf(lo) | (f2bf(hi) << 16); }
__device__ __forceinline__ float bflo(unsigned w) { return __builtin_bit_cast(float, w << 16); }
__device__ __forceinline__ float bfhi(unsigned w) { return __builtin_bit_cast(float, w & 0xffff0000u); }

#define XB_TMO      128
#define XB_XCNT(j)  (256  + 64 * (j))
#define XB_XSUB(j)  (1280 + 64 * (j))
#define XB_XGEN(j)  (2304 + 64 * (j))
#define XB_TOP      3328
#define XB_TOPGEN   3392
#define XCD_BAR_WORDS 3456
#define XB_SPIN_CAP (1u << 22)
__device__ __forceinline__ unsigned xb_ld(unsigned* p)              { return __hip_atomic_load(p, __ATOMIC_RELAXED, __HIP_MEMORY_SCOPE_AGENT); }
__device__ __forceinline__ unsigned xb_add(unsigned* p, unsigned v) { return __hip_atomic_fetch_add(p, v, __ATOMIC_RELAXED, __HIP_MEMORY_SCOPE_AGENT); }
__device__ __forceinline__ unsigned xb_xcc_id() { return (unsigned)__builtin_amdgcn_s_getreg((3 << 11) | 20) & 0xFu; }
#define XB_SPIN(cond, bar) do { unsigned _sp = 0; while (cond) { __builtin_amdgcn_s_sleep(1); \
    if ((++_sp & 255u) == 0u) { if (xb_ld(&(bar)[XB_TMO])) break; if (_sp > XB_SPIN_CAP) { atomicAdd(&(bar)[XB_TMO], 1u); break; } } } } while (0)
struct XcdBarrier { unsigned* bar; unsigned x; volatile LAS unsigned* st; };
__device__ __forceinline__ XcdBarrier xcd_barrier_post(unsigned* bar, volatile LAS unsigned* st) {
    XcdBarrier b; b.bar = bar; b.x = xb_xcc_id(); b.st = st;
    if (threadIdx.x == 0) (void)xb_add(&bar[XB_XCNT(b.x)], 1u);
    return b;
}
__device__ __forceinline__ void xcd_barrier_complete(unsigned* bar, unsigned x, unsigned& nloc, unsigned& nx) {
    const unsigned G = gridDim.x * gridDim.y * gridDim.z;
    unsigned sum, cnt, mine, sp = 0u;
    for (;;) {
        sum = 0u; cnt = 0u; mine = 0u;
#pragma unroll
        for (unsigned j = 0; j < 16; ++j) { const unsigned c = xb_ld(&bar[XB_XCNT(j)]); sum += c; cnt += (c > 0u) ? 1u : 0u; mine = (j == x) ? c : mine; }
        if (sum == G) break;
        __builtin_amdgcn_s_sleep(1);
        if ((++sp & 255u) == 0u) { if (xb_ld(&bar[XB_TMO])) break; if (sp > XB_SPIN_CAP) { atomicAdd(&bar[XB_TMO], 1u); break; } }
    }
    nloc = mine > 0u ? mine : 1u; nx = cnt > 0u ? cnt : 1u;
}
__device__ __forceinline__ void xcd_barrier(const XcdBarrier& b) {
    asm volatile("s_waitcnt vmcnt(0)" ::: "memory");
    __syncthreads();
    if (threadIdx.x == 0) {
        unsigned* bar = b.bar;
        __builtin_amdgcn_s_waitcnt(0);
        unsigned nloc = b.st[0], nx = b.st[1];
        if (nloc == 0u) { xcd_barrier_complete(bar, b.x, nloc, nx); b.st[0] = nloc; b.st[1] = nx; }
        const unsigned old = xb_add(&bar[XB_XSUB(b.x)], 1u);
        const unsigned gen = old / nloc;
        if (old + 1u == (gen + 1u) * nloc) {
            __builtin_amdgcn_fence(__ATOMIC_RELEASE, "agent");
            asm volatile("s_waitcnt vmcnt(0)" ::: "memory");
            const unsigned og = xb_add(&bar[XB_TOP], 1u);
            const unsigned tg = og / nx;
            if (og + 1u == (tg + 1u) * nx) xb_add(&bar[XB_TOPGEN], 1u);
            else XB_SPIN(xb_ld(&bar[XB_TOPGEN]) == tg, bar);
            __builtin_amdgcn_fence(__ATOMIC_ACQUIRE, "agent");
            xb_add(&bar[XB_XGEN(b.x)], 1u);
            asm volatile("s_waitcnt vmcnt(0)" ::: "memory");
        } else {
            XB_SPIN(xb_ld(&bar[XB_XGEN(b.x)]) == gen, bar);
            __builtin_amdgcn_fence(__ATOMIC_ACQUIRE, "agent");
            asm volatile("s_waitcnt vmcnt(0)" ::: "memory");
        }
    }
    __syncthreads();
}

struct EpiFinal {
    const float* base; float* out; float* ss; const float* gf; XcdBarrier bar;
    __device__ __forceinline__ void operator()(pg8::f32x4 (&acc)[2][2][4][2], const pg8::Unit& u, int wr, int wc, int fr, int fq) const {
        using pg8::f32x4; using pg8::HALF; using pg8::BM;
        const int row0 = u.pm * BM + wr * 64 + fr, col0 = u.pn * BM + wc * 32 + 8 * fq;
#pragma unroll
        for (int ai = 0; ai < 2; ++ai)
#pragma unroll
            for (int m = 0; m < 4; ++m) { const size_t row = (size_t)(row0 + ai * HALF + m * 16); const size_t off = row * 1024 + col0; float s = 0.f;
#pragma unroll
                for (int bj = 0; bj < 2; ++bj) {
                    const f32x4 b0 = *(const f32x4*)(base + off + bj * HALF), b1 = *(const f32x4*)(base + off + bj * HALF + 4);
                    const f32x4 v0 = acc[ai][bj][m][0] + b0, v1 = acc[ai][bj][m][1] + b1;
                    acc[ai][bj][m][0] = v0; acc[ai][bj][m][1] = v1;
                    s += (v0[0] * v0[0] + v0[1] * v0[1]) + (v0[2] * v0[2] + v0[3] * v0[3]) + (v1[0] * v1[0] + v1[1] * v1[1]) + (v1[2] * v1[2] + v1[3] * v1[3]); }
                s += __shfl_xor(s, 16); s += __shfl_xor(s, 32);
                if (fq == 0) ss[row * 16 + u.pn * 4 + wc] = s; }
        xcd_barrier(bar);
        f32x4 gq[2][2];
#pragma unroll
        for (int bj = 0; bj < 2; ++bj)
#pragma unroll
            for (int n = 0; n < 2; ++n) gq[bj][n] = *(const f32x4*)(gf + col0 + bj * HALF + 4 * n);
#pragma unroll
        for (int ai = 0; ai < 2; ++ai)
#pragma unroll
            for (int m = 0; m < 4; ++m) { const size_t row = (size_t)(row0 + ai * HALF + m * 16); const size_t off = row * 1024 + col0; const float rstd = pg8::row_rstd(ss, row, fq);
#pragma unroll
                for (int bj = 0; bj < 2; ++bj) { *(f32x4*)(out + off + bj * HALF) = acc[ai][bj][m][0] * rstd * gq[bj][0]; *(f32x4*)(out + off + bj * HALF + 4) = acc[ai][bj][m][1] * rstd * gq[bj][1]; } }
    }
};

struct Frame {
    LAS unsigned char* lds;
    int tid, lane, wave, vcu, G;
};
__device__ __forceinline__ float wave_sum(float v) {
#pragma unroll
    for (int o = 1; o < 64; o <<= 1) v += __shfl_xor(v, o);
    return v;
}

__device__ __forceinline__ int p0_map_row(int mode, int sel, int row_off, int n) {
    if (mode == 0) return row_off + n;
    if (mode == 1) return 256 * (n >> 7) + 128 * sel + (n & 127);
    const int pn = n >> 8, w = n & 255, wc = w >> 6, d = w & 63; return 256 * pn + 128 * (d >> 5) + 32 * wc + (d & 31);
}
__device__ __forceinline__ void p0_tr_item(const float* W, int K, int N, bf16* WT, int mode, int sel, int row_off, const float* kgain, const float* nscale, LAS unsigned* scr, int item, int lane) {
    const int nblk = N / 64, kb = item / nblk, nb = item % nblk, k0 = 64 * kb, n0 = 64 * nb;
    const int kq = lane >> 4, n4 = (lane & 15) * 4;
    f32x4 ns = (f32x4){1.f, 1.f, 1.f, 1.f}; if (nscale) ns = *(const GAS f32x4*)(nscale + n0 + n4);
    f32x4 v[16];
#pragma unroll
    for (int i = 0; i < 16; ++i) { const int k = 8 * (i >> 1) + 2 * kq + (i & 1); v[i] = *(const GAS f32x4*)(W + (size_t)(k0 + k) * N + n0 + n4); }
    if (kgain) {
#pragma unroll
        for (int i = 0; i < 16; ++i) { const int k = 8 * (i >> 1) + 2 * kq + (i & 1); v[i] = v[i] * kgain[k0 + k]; }
    }
#pragma unroll
    for (int ip = 0; ip < 8; ++ip) { const f32x4 e = v[2 * ip] * ns, o = v[2 * ip + 1] * ns;
#pragma unroll
        for (int c = 0; c < 4; ++c) scr[(n4 + c) * 33 + 4 * ip + kq] = pk2(e[c], o[c]); }
    LDS_WAIT(); asm volatile("" ::: "memory");
    const int kc = lane & 7;
#pragma unroll
    for (int jj = 0; jj < 8; ++jj) { const int n = (lane >> 3) + 8 * jj; const LAS unsigned* sp = scr + n * 33 + 4 * kc;
        v4u o; o.x = sp[0]; o.y = sp[1]; o.z = sp[2]; o.w = sp[3];
        *(GAS v4u*)(WT + (size_t)p0_map_row(mode, sel, row_off, n0 + n) * K + k0 + 8 * kc) = o; }
    LDS_WAIT(); asm volatile("" ::: "memory");
}

struct Args { const float* in[13]; float* out; unsigned char* ws; int ph_lo, ph_hi; };

__device__ __forceinline__ void sincos_acc(float angf, float& c, float& s) {
    const double x = (double)angf; const double k = __builtin_rint(x * 0.15915494309189535);
    double y = (x - k * 6.283185307179586) * 0.25;
    const double y2 = y * y;
    double sn = y * (1.0 + y2 * (-1.0 / 6 + y2 * (1.0 / 120 + y2 * (-1.0 / 5040 + y2 * (1.0 / 362880 + y2 * (-1.0 / 39916800 + y2 * (1.0 / 6227020800.0)))))));
    double cs = 1.0 + y2 * (-0.5 + y2 * (1.0 / 24 + y2 * (-1.0 / 720 + y2 * (1.0 / 40320 + y2 * (-1.0 / 3628800 + y2 * (1.0 / 479001600.0 + y2 * (-1.0 / 87178291200.0)))))));
#pragma unroll
    for (int i = 0; i < 2; ++i) { const double s2 = 2.0 * sn * cs, c2 = 1.0 - 2.0 * sn * sn; sn = s2; cs = c2; }
    c = (float)cs; s = (float)sn;
}

template <int GI>
__device__ __forceinline__ void pool_group(f32x4 (&cur)[16], f32x4 (&prev)[16], f32x4& S2, f32x4& S4, f32x4& S8, f32x4& S16, const f32x4 gv, const float* x, bf16* hp,
                                           int R0, bool bstart, int c4, int hl, int lane, int wq, LAS float* part, LAS float* rs) {
    const bool zero = (GI == 0) && bstart;
#pragma unroll
    for (int j = 0; j < 16; ++j) { const f32x4 v = cur[j]; part[j * 256 + hl] = (v[0] * v[0] + v[1] * v[1]) + (v[2] * v[2] + v[3] * v[3]); }
    LDS_WAIT(); __syncthreads();
#pragma unroll
    for (int q = 0; q < 4; ++q) { const int j = 4 * wq + q; const f32x4 p = *(const LAS f32x4*)(part + j * 256 + 4 * lane);
        const float s = wave_sum((p[0] + p[1]) + (p[2] + p[3])); if (lane == 0) rs[j] = zero ? 0.f : rsqrtf(s * (1.0f / D) + 1e-6f); }
    LDS_WAIT(); __syncthreads();
#pragma unroll
    for (int j = 0; j < 16; ++j) {
        const int row = R0 - 16 + GI * 16 + j;
        const f32x4 hv = cur[j] * rs[j] * gv;
        const f32x4 h2 = j >= 2 ? cur[j >= 2 ? j - 2 : 0] : prev[(j + 14) & 15], h4 = j >= 4 ? cur[j >= 4 ? j - 4 : 0] : prev[(j + 12) & 15], h8 = j >= 8 ? cur[j >= 8 ? j - 8 : 0] : prev[(j + 8) & 15];
        S2 = S2 + hv - h2; S4 = S4 + hv - h4; S8 = S8 + hv - h8; S16 = S16 + hv - prev[j];
        cur[j] = hv;
        if (GI < 2) prev[j] = *(const GAS f32x4*)(x + (size_t)(row + 16) * D + 4 * c4);
        if (GI > 0) {
            const int t = row & (SEQ - 1);
            const float i2 = t >= 1 ? 0.5f : 1.0f, i4 = t >= 3 ? 0.25f : 1.0f / (float)(t + 1), i8 = t >= 7 ? 0.125f : 1.0f / (float)(t + 1), i16 = t >= 15 ? 0.0625f : 1.0f / (float)(t + 1);
            const f32x4 o2 = S2 * i2 - hv, o4 = S4 * i4 - hv, o8 = S8 * i8 - hv, o16 = S16 * i16 - hv;
            const size_t off = (size_t)row * D + 4 * c4;
            *(GAS v2u*)(hp + off) = (v2u){pk2(o2[0], o2[1]), pk2(o2[2], o2[3])};
            *(GAS v2u*)(hp + (size_t)M * D + off) = (v2u){pk2(o4[0], o4[1]), pk2(o4[2], o4[3])};
            *(GAS v2u*)(hp + 2 * (size_t)M * D + off) = (v2u){pk2(o8[0], o8[1]), pk2(o8[2], o8[3])};
            *(GAS v2u*)(hp + 3 * (size_t)M * D + off) = (v2u){pk2(o16[0], o16[1]), pk2(o16[2], o16[3])};
        }
    }
}

__device__ __forceinline__ void p0_prologue(Frame& F, const Args& a) {
    unsigned char* ws = a.ws;
    LAS unsigned* scr = (LAS unsigned*)(F.lds + F.wave * 16384);
    const int gw = F.vcu * NWAVES + F.wave, NGW = F.G * NWAVES;
    constexpr int I_SQ = 16 * 16, I_WG = 4 * 4, I_GU = 16 * 44, I_DN = 44 * 16, I_QKV = 16 * 48;
    constexpr int NITEMS = I_SQ + 4 * I_WG + I_SQ + 3 * I_GU + I_QKV + I_SQ + 3 * I_GU;
    static_assert(I_GU == I_DN, "items");
    const float* norm_mix = a.in[1]; const float* norm_ffn = a.in[2];
    for (int it = gw; it < NITEMS; it += NGW) {
        int r = it;
        if (r < I_SQ) { p0_tr_item(a.in[4], D, D, (bf16*)(ws + WS_WIN), 0, 0, 0, nullptr, nullptr, scr, r, F.lane); continue; } r -= I_SQ;
        if (r < 4 * I_WG) { const int g = r / I_WG; p0_tr_item(a.in[5] + (size_t)g * 256 * 256, 256, 256, (bf16*)(ws + WS_WG), 0, 0, g * 256, nullptr, a.in[6] + g * 256, scr, r % I_WG, F.lane); continue; } r -= 4 * I_WG;
        if (r < I_SQ) { p0_tr_item(a.in[7], D, D, (bf16*)(ws + WS_WPO), 0, 0, 0, nullptr, nullptr, scr, r, F.lane); continue; } r -= I_SQ;
        if (r < I_GU) { p0_tr_item(a.in[10], D, FF, (bf16*)(ws + WS_WGU0), 1, 0, 0, norm_ffn, nullptr, scr, r, F.lane); continue; } r -= I_GU;
        if (r < I_GU) { p0_tr_item(a.in[11], D, FF, (bf16*)(ws + WS_WGU0), 1, 1, 0, norm_ffn, nullptr, scr, r, F.lane); continue; } r -= I_GU;
        if (r < I_DN) { p0_tr_item(a.in[12], FF, D, (bf16*)(ws + WS_WD0), 0, 0, 0, nullptr, nullptr, scr, r, F.lane); continue; } r -= I_DN;
        if (r < I_QKV) { p0_tr_item(a.in[8], D, 3 * D, (bf16*)(ws + WS_WQKV), 2, 0, 0, norm_mix + D, nullptr, scr, r, F.lane); continue; } r -= I_QKV;
        if (r < I_SQ) { p0_tr_item(a.in[9], D, D, (bf16*)(ws + WS_WAO), 0, 0, 0, nullptr, nullptr, scr, r, F.lane); continue; } r -= I_SQ;
        if (r < I_GU) { p0_tr_item(a.in[10] + (size_t)D * FF, D, FF, (bf16*)(ws + WS_WGU1), 1, 0, 0, norm_ffn + D, nullptr, scr, r, F.lane); continue; } r -= I_GU;
        if (r < I_GU) { p0_tr_item(a.in[11] + (size_t)D * FF, D, FF, (bf16*)(ws + WS_WGU1), 1, 1, 0, norm_ffn + D, nullptr, scr, r, F.lane); continue; } r -= I_GU;
        p0_tr_item(a.in[12] + (size_t)D * FF, FF, D, (bf16*)(ws + WS_WD1), 0, 0, 0, nullptr, nullptr, scr, r, F.lane);
    }
    {
        float* rope = (float*)(ws + WS_ROPE);
        for (int e = (F.vcu * NWAVES * 64 + F.tid); e < SEQ * 32; e += F.G * NWAVES * 64) {
            const int t = e >> 5, j = e & 31;
            const float invf = (float)(1.0 / (double)(float)exp2(13.287712379549449 * (double)j / 32.0));
            const float ang = (float)t * invf; float c, s; sincos_acc(ang, c, s);
            rope[(size_t)t * 64 + j] = c; rope[(size_t)t * 64 + 32 + j] = s;
        }
    }
    __syncthreads();
    {
        const float* x = a.in[0]; const float* g0 = norm_mix;
        bf16* hp = (bf16*)(ws + WS_BIG);
        const int half = F.tid >> 8, c4 = F.tid & 255, hl = c4, wq = F.wave & 3;
        LAS float* part = (LAS float*)(F.lds) + half * (16 * 256);
        LAS float* rs = (LAS float*)(F.lds + 32768) + half * 16;
        const f32x4 gv = *(const GAS f32x4*)(g0 + 4 * c4);
        for (int blk = F.vcu; blk < M / 64; blk += F.G) {
            const int R0 = blk * 64 + half * 32;
            const bool bstart = (R0 & (SEQ - 1)) == 0;
            f32x4 A[16], B[16];
#pragma unroll
            for (int j = 0; j < 16; ++j) { B[j] = (f32x4){0.f, 0.f, 0.f, 0.f}; A[j] = B[j]; if (!bstart) A[j] = *(const GAS f32x4*)(x + (size_t)(R0 - 16 + j) * D + 4 * c4); }
            f32x4 S2 = B[0], S4 = B[0], S8 = B[0], S16 = B[0];
            pool_group<0>(A, B, S2, S4, S8, S16, gv, x, hp, R0, bstart, c4, hl, F.lane, wq, part, rs);
            pool_group<1>(B, A, S2, S4, S8, S16, gv, x, hp, R0, bstart, c4, hl, F.lane, wq, part, rs);
            pool_group<2>(A, B, S2, S4, S8, S16, gv, x, hp, R0, bstart, c4, hl, F.lane, wq, part, rs);
            __syncthreads();
        }
    }
}

namespace att {
typedef short bf16x8 __attribute__((ext_vector_type(8)));
typedef short s16x4 __attribute__((ext_vector_type(4)));
typedef float f32x16 __attribute__((ext_vector_type(16)));
typedef unsigned u32x4 __attribute__((ext_vector_type(4)));
constexpr int KCH = 6160;
constexpr int LDS_K = 0, LDS_V = 8 * KCH, VDH = 24 * 1024 + 64, LDS_OST = LDS_V + 2 * VDH, LDS_TOTAL = LDS_OST + 8 * 4096;
static_assert(LDS_TOTAL <= LDS_BYTES, "attention LDS");
__device__ __forceinline__ int crow(int r, int hi) { return (r & 3) + 8 * (r >> 2) + 4 * hi; }
__device__ __forceinline__ s16x4 vtr(const LAS unsigned char* p) { return __builtin_bit_cast(s16x4, __builtin_amdgcn_ds_read_tr16_b64_v4i16((LAS s16x4*)p)); }
__device__ __forceinline__ void attn_item(int bh, int j, const bf16* Qp, const bf16* Kp, const bf16* Vp, bf16* O, float* lse, LAS unsigned char* shm) {
    int tid = threadIdx.x; asm volatile("" : "+v"(tid));
    const int lane = tid & 63, r32 = lane & 31, hi = lane >> 5; const int wid = __builtin_amdgcn_readfirstlane(tid >> 6);
    const int b = bh >> 4, h = bh & 15;
    const int dsh = h < 6 ? 0 : (h < 11 ? 2 : 4);
    const int nqb = 32 >> dsh, r = j >> (5 - dsh), qb = j & (nqb - 1);
    const bool first = (qb == 0);
    const size_t hb = (size_t)bh * (SEQ * 64);
    const int pos0 = j * 256;
#pragma unroll
    for (int it = 0; it < 6; ++it) {
        const int p = tid + 512 * it, key = p >> 3, c = p & 7;
        u32x4 kv = (u32x4){0u, 0u, 0u, 0u}, vv = (u32x4){0u, 0u, 0u, 0u};
        if (!(first && key < 128)) { const size_t go = hb + (size_t)(pos0 - 128 + key) * 64 + c * 8; kv = *(const GAS u32x4*)(Kp + go); vv = *(const GAS u32x4*)(Vp + go); }
        *(LAS u32x4*)(shm + LDS_K + c * KCH + key * 16) = kv;
        *(LAS u32x4*)(shm + LDS_V + (c >> 2) * VDH + (key >> 4) * 1024 + (key & 15) * 64 + (c & 3) * 16) = vv;
    }
    bf16x8 qr[4];
#pragma unroll
    for (int d0 = 0; d0 < 4; ++d0) qr[d0] = *(const GAS bf16x8*)(Qp + hb + (size_t)(pos0 + 32 * wid + r32) * 64 + d0 * 16 + hi * 8);
    LDS_WAIT(); __syncthreads();
    f32x16 P[5];
    const LAS unsigned char* kbase = shm + LDS_K + hi * KCH + (32 * wid + r32) * 16;
#pragma unroll
    for (int kt = 0; kt < 5; ++kt) {
        f32x16 acc = {0.f, 0.f, 0.f, 0.f, 0.f, 0.f, 0.f, 0.f, 0.f, 0.f, 0.f, 0.f, 0.f, 0.f, 0.f, 0.f};
#pragma unroll
        for (int d0 = 0; d0 < 4; ++d0) { const bf16x8 kf = *(const LAS bf16x8*)(kbase + (2 * d0) * KCH + kt * 512); acc = __builtin_amdgcn_mfma_f32_32x32x16_bf16(kf, qr[d0], acc, 0, 0, 0); }
        P[kt] = acc;
    }
    const float NEG = -INFINITY;
    const int lowlim = first ? (128 - 32 * wid) : 0;
    const int lo0 = r32 > lowlim ? r32 : lowlim;
#pragma unroll
    for (int rr = 0; rr < 16; ++rr) { const int cr = crow(rr, hi); if (cr < lo0) P[0][rr] = NEG; if (cr > r32) P[4][rr] = NEG; }
    if (first) {
#pragma unroll
        for (int kt = 1; kt < 4; ++kt)
#pragma unroll
            for (int rr = 0; rr < 16; ++rr) if (32 * kt + crow(rr, hi) < lowlim) P[kt][rr] = NEG;
    }
    float mx = NEG;
#pragma unroll
    for (int kt = 0; kt < 5; ++kt)
#pragma unroll
        for (int rr = 0; rr < 16; ++rr) mx = fmaxf(mx, P[kt][rr]);
    mx = fmaxf(mx, __shfl_xor(mx, 32));
    float l = 0.f;
#pragma unroll
    for (int kt = 0; kt < 5; ++kt)
#pragma unroll
        for (int rr = 0; rr < 16; ++rr) { const float e = __builtin_amdgcn_exp2f(P[kt][rr] - mx); P[kt][rr] = e; l += e; }
    l += __shfl_xor(l, 32);
    const float inv = 1.0f / l;
    {
        const int i = qb * 256 + 32 * wid + r32, t = (i << dsh) + r;
        if (hi == 0) lse[((size_t)b * SEQ + t) * 16 + h] = (mx + log2f(l)) * 0.6931471805599453f;
    }
    f32x16 o[2];
    o[0] = (f32x16){0.f, 0.f, 0.f, 0.f, 0.f, 0.f, 0.f, 0.f, 0.f, 0.f, 0.f, 0.f, 0.f, 0.f, 0.f, 0.f}; o[1] = o[0];
    const LAS unsigned char* vb = shm + LDS_V + ((lane >> 4) & 1) * 32 + (lane & 3) * 8 + (4 * hi + ((lane & 15) >> 2)) * 64;
#pragma unroll
    for (int kt = 0; kt < 5; ++kt)
#pragma unroll
        for (int s = 0; s < 2; ++s) {
            u32x4 pw;
            pw.x = pg8::cvt_pk_bf16(P[kt][8 * s + 0] * inv, P[kt][8 * s + 1] * inv); pw.y = pg8::cvt_pk_bf16(P[kt][8 * s + 2] * inv, P[kt][8 * s + 3] * inv);
            pw.z = pg8::cvt_pk_bf16(P[kt][8 * s + 4] * inv, P[kt][8 * s + 5] * inv); pw.w = pg8::cvt_pk_bf16(P[kt][8 * s + 6] * inv, P[kt][8 * s + 7] * inv);
            const bf16x8 pa = __builtin_bit_cast(bf16x8, pw);
            const int kblk = 2 * wid + 2 * kt + s;
#pragma unroll
            for (int dh = 0; dh < 2; ++dh) {
                const s16x4 vlo = vtr(vb + dh * VDH + kblk * 1024), vhi = vtr(vb + dh * VDH + kblk * 1024 + 512);
                const bf16x8 vf = (bf16x8){vlo[0], vlo[1], vlo[2], vlo[3], vhi[0], vhi[1], vhi[2], vhi[3]};
                o[dh] = __builtin_amdgcn_mfma_f32_32x32x16_bf16(pa, vf, o[dh], 0, 0, 0);
            }
        }
    {
        LAS bf16* stg = (LAS bf16*)(shm + LDS_OST + wid * 4096);
#pragma unroll
        for (int rr = 0; rr < 16; ++rr) { const int orow = crow(rr, hi);
#pragma unroll
            for (int dh = 0; dh < 2; ++dh) stg[orow * 64 + dh * 32 + r32] = (bf16)f2bf(o[dh][rr]); }
        LDS_WAIT(); asm volatile("" ::: "memory");
#pragma unroll
        for (int i4 = 0; i4 < 4; ++i4) { const int row = i4 * 8 + (lane >> 3), ch = lane & 7; const u32x4 v = *(const LAS u32x4*)(stg + row * 64 + ch * 8);
            const int i = qb * 256 + 32 * wid + row, t = (i << dsh) + r;
            *(GAS u32x4*)(O + ((size_t)b * SEQ + t) * D + h * 64 + ch * 8) = v; }
    }
    LDS_WAIT(); __syncthreads();
}
}

__global__ void __launch_bounds__(NWAVES * 64, 2) fwd_megakernel(Args args) {
    extern __shared__ __attribute__((aligned(16))) unsigned char lds[];
    Frame F;
    F.lds = (LAS unsigned char*)lds;
    F.tid = threadIdx.x; F.lane = F.tid & 63; F.wave = __builtin_amdgcn_readfirstlane(F.tid >> 6);
    F.G = gridDim.x; { const int bx = blockIdx.x; F.vcu = (F.G % 8 == 0) ? (bx % 8) * (F.G / 8) + bx / 8 : bx; }
    unsigned char* ws = args.ws;
    const int lo = args.ph_lo, hi = args.ph_hi;
    const bool one_launch = (hi - lo) > 1;
    volatile LAS unsigned* bst = (volatile LAS unsigned*)(F.lds + 131072 + 1024);
    if (F.tid < 2) bst[F.tid] = 0u;
    __syncthreads();
    XcdBarrier bar; bar.bar = (unsigned*)(ws + WS_CTL) + CW_BAR; bar.x = 0; bar.st = bst;
    if (one_launch) bar = xcd_barrier_post((unsigned*)(ws + WS_CTL) + CW_BAR, bst);
#ifndef DUP_MASK
#define DUP_MASK 0
#endif
#define IN(k) (lo <= (k) && (k) < hi)
#define REP(k) for (int rep_ = 0; rep_ < (((DUP_MASK >> (k)) & 1) ? 2 : 1); ++rep_)
#define SEAM(k) do { if (IN(k) && IN((k) + 1)) { xcd_barrier(bar); } } while (0)

    if (lo < 0) cg::this_grid().sync();
    float* resid = args.out;
    float* ssb = (float*)(ws + WS_SS);
    bf16* xb = (bf16*)(ws + WS_XB);
    bf16* zo = (bf16*)(ws + WS_ZO);
    bf16* big = (bf16*)(ws + WS_BIG);

    if (IN(0)) REP(0) { p0_prologue(F, args); }
    SEAM(0);
    if (IN(1)) REP(1) {
        pg8::Gemm g{big, (const bf16*)(ws + WS_WIN), M, D, D, D, D, (size_t)M * D * 2};
        pg8::StaticOrder S; S.init(M, D, F.G, (int)blockIdx.x);
        pg8::EpiBf16 E{xb, D};
        pg8::gemm_phase<pg8::EpiBf16, pg8::StaticOrder, true>(F.lds, g, S, E);
    }
    if (IN(1) && IN(2)) {
        asm volatile("s_waitcnt vmcnt(0)" ::: "memory"); __syncthreads();
        __builtin_amdgcn_fence(__ATOMIC_ACQUIRE, "agent"); asm volatile("s_waitcnt vmcnt(0)" ::: "memory"); __syncthreads();
    }
    if (IN(2)) REP(2) {
        pg8::Gemm g{xb, (const bf16*)(ws + WS_WG), M, D, 256, D, 256, (size_t)256 * 2};
        pg8::StaticOrder S; S.init(M, D, F.G, (int)blockIdx.x);
        pg8::EpiBf16 E{zo, D};
        pg8::gemm_phase<pg8::EpiBf16, pg8::StaticOrder, true>(F.lds, g, S, E);
    }
    SEAM(2);
    if (IN(3)) REP(3) {
        pg8::Gemm g{zo, (const bf16*)(ws + WS_WPO), M, D, D, D, D, 0};
        pg8::StaticOrder S; S.init(M, D, F.G, (int)blockIdx.x);
        pg8::EpiRes E{args.in[0], resid, xb, ssb};
        pg8::gemm_phase<pg8::EpiRes, pg8::StaticOrder, true>(F.lds, g, S, E);
    }
    SEAM(3);
#pragma unroll 1
    for (int layer = 0; layer < 2; ++layer) {
        const int pb = layer == 0 ? 4 : 10;
        if (IN(pb)) REP(4) {
            pg8::Gemm g{xb, (const bf16*)(ws + (layer == 0 ? WS_WGU0 : WS_WGU1)), M, 2 * FF, D, D, D, 0};
            pg8::StaticOrder S; S.init(M, 2 * FF, F.G, (int)blockIdx.x);
            pg8::EpiSwiGLU E{big, ssb, FF};
            pg8::gemm_phase<pg8::EpiSwiGLU, pg8::StaticOrder, true>(F.lds, g, S, E);
        }
        SEAM(pb);
        if (IN(pb + 1) && ((DUP_MASK >> 5) & 1)) {
            pg8::Gemm g{big, (const bf16*)(ws + (layer == 0 ? WS_WD0 : WS_WD1)), M, D, FF, FF, FF, 0};
            pg8::StaticOrder S; S.init(M, D, F.G, (int)blockIdx.x);
            pg8::EpiBf16 E{xb, D};
            pg8::gemm_phase<pg8::EpiBf16, pg8::StaticOrder, true>(F.lds, g, S, E);
        }
        const bool fuse_final = (layer == 1) && one_launch && IN(12) && (F.G == (M / 256) * (D / 256));
        if (IN(pb + 1)) {
            pg8::Gemm g{big, (const bf16*)(ws + (layer == 0 ? WS_WD0 : WS_WD1)), M, D, FF, FF, FF, 0};
            pg8::StaticOrder S; S.init(M, D, F.G, (int)blockIdx.x);
            if (fuse_final) { EpiFinal E{resid, resid, ssb, args.in[3], bar}; pg8::gemm_phase<EpiFinal, pg8::StaticOrder, true>(F.lds, g, S, E); }
            else { pg8::EpiRes E{resid, resid, xb, ssb}; pg8::gemm_phase<pg8::EpiRes, pg8::StaticOrder, true>(F.lds, g, S, E); }
        }
        if (fuse_final) return;
        SEAM(pb + 1);
        if (layer == 0) {
            bf16* qb_ = big; bf16* kb_ = big + (size_t)M * D; bf16* vb_ = big + 2 * (size_t)M * D;
            if (IN(6)) REP(6) {
                pg8::Gemm g{xb, (const bf16*)(ws + WS_WQKV), M, 3 * D, D, D, D, 0};
                pg8::StaticOrder S; S.init(M, 3 * D, F.G, (int)blockIdx.x);
                pg8::EpiQKV E{qb_, ssb, (const float*)(ws + WS_ROPE)};
                pg8::gemm_phase<pg8::EpiQKV, pg8::StaticOrder, true>(F.lds, g, S, E);
            }
            SEAM(6);
            if (IN(7)) REP(7) {
                const int ipw = (1024 + F.G - 1) / F.G;
                for (int i = 0; i < ipw; ++i) { const int item = F.vcu * ipw + i; if (item < 1024) att::attn_item(item >> 5, item & 31, qb_, kb_, vb_, zo, (float*)(ws + WS_LSE), F.lds); }
            }
            SEAM(7);
            if (IN(8)) for (int rep_ = (((DUP_MASK >> 8) & 1) ? 0 : 1); rep_ < 2; ++rep_) {
                const float* lse = (const float*)(ws + WS_LSE);
                for (int m = F.vcu * NWAVES + F.wave; m < M; m += F.G * NWAVES) {
                    float L[16];
#pragma unroll
                    for (int q4 = 0; q4 < 4; ++q4) { const f32x4 v = *(const GAS f32x4*)(lse + (size_t)m * 16 + 4 * q4); L[4 * q4] = v[0]; L[4 * q4 + 1] = v[1]; L[4 * q4 + 2] = v[2]; L[4 * q4 + 3] = v[3]; }
                    float lg[3];
                    { float mx = L[0];
_Pragma("unroll") for (int i = 1; i < 6; ++i) mx = fmaxf(mx, L[i]); float s = 0.f;
_Pragma("unroll") for (int i = 0; i < 6; ++i) s += __expf(L[i] - mx); lg[0] = mx + __logf(s) - 1.791759469228055f; }
                    { float mx = L[6];
_Pragma("unroll") for (int i = 7; i < 11; ++i) mx = fmaxf(mx, L[i]); float s = 0.f;
_Pragma("unroll") for (int i = 6; i < 11; ++i) s += __expf(L[i] - mx); lg[1] = mx + __logf(s) - 1.6094379124341003f; }
                    { float mx = L[11];
_Pragma("unroll") for (int i = 12; i < 16; ++i) mx = fmaxf(mx, L[i]); float s = 0.f;
_Pragma("unroll") for (int i = 11; i < 16; ++i) s += __expf(L[i] - mx); lg[2] = mx + __logf(s) - 1.6094379124341003f; }
                    const float mx = fmaxf(lg[0], fmaxf(lg[1], lg[2]));
                    const float e0 = __expf(lg[0] - mx), e1 = __expf(lg[1] - mx), e2 = __expf(lg[2] - mx); const float is = 3.0f / (e0 + e1 + e2);
                    const int head = F.lane >> 2; const float sc = (head < 6 ? e0 : (head < 11 ? e1 : e2)) * is;
                    GAS v4u* p = (GAS v4u*)(zo + (size_t)m * D + 16 * F.lane);
#pragma unroll
                    for (int q2 = 0; q2 < 2; ++q2) { v4u w = p[q2];
                        w.x = pk2(bflo(w.x) * sc, bfhi(w.x) * sc); w.y = pk2(bflo(w.y) * sc, bfhi(w.y) * sc); w.z = pk2(bflo(w.z) * sc, bfhi(w.z) * sc); w.w = pk2(bflo(w.w) * sc, bfhi(w.w) * sc);
                        if (rep_ == 0) ((GAS v4u*)(xb + (size_t)m * D + 16 * F.lane))[q2] = w; else p[q2] = w; }
                }
            }
            SEAM(8);
            if (IN(9)) {
                pg8::Gemm g{zo, (const bf16*)(ws + WS_WAO), M, D, D, D, D, 0};
                pg8::StaticOrder S; S.init(M, D, F.G, (int)blockIdx.x);
                pg8::EpiRes E{resid, resid, xb, ssb};
                pg8::gemm_phase<pg8::EpiRes, pg8::StaticOrder, true>(F.lds, g, S, E);
            }
            SEAM(9);
        }
    }
    if (IN(12)) for (int rep_ = (((DUP_MASK >> 12) & 1) ? 0 : 1); rep_ < 2; ++rep_) {
        const float* gf = args.in[3];
        for (int m = F.vcu * NWAVES + F.wave; m < M; m += F.G * NWAVES) {
            float s = 0.f;
#pragma unroll
            for (int q4 = 0; q4 < 4; ++q4) { const f32x4 v = *(const GAS f32x4*)(ssb + (size_t)m * 16 + 4 * q4); s += (v[0] + v[1]) + (v[2] + v[3]); }
            const float rstd = rsqrtf(s * (1.0f / D) + 1e-6f);
            GAS f32x4* xr = (GAS f32x4*)(resid + (size_t)m * D) + F.lane;
#pragma unroll
            for (int j = 0; j < 4; ++j) { const f32x4 gq = *(const GAS f32x4*)(gf + 4 * F.lane + 256 * j); const f32x4 ov = xr[64 * j] * rstd * gq; if (rep_ == 0) ((GAS f32x4*)((float*)big + (size_t)m * D) + F.lane)[64 * j] = ov; else xr[64 * j] = ov; }
        }
    }
#undef IN
#undef SEAM
}

extern "C" void kernel_launch(void* const* d_in, const int* in_sizes, int n_in, void* d_out, int out_size, void* d_ws, size_t ws_size, hipStream_t stream) {
    static int grid = 0;
    if (grid == 0) {
        if (n_in != 13 || in_sizes[0] != M * D || out_size != M * D || ws_size < WS_END) { fprintf(stderr, "kernel_launch: unexpected shapes (n_in %d, in0 %d, out %d, ws %zu); nothing launched\n", n_in, n_in > 0 ? in_sizes[0] : -1, out_size, ws_size); grid = -1; return; }
        int dev = 0, cus = 0, per_cu = 0;
        if (hipGetDevice(&dev) != hipSuccess || hipDeviceGetAttribute(&cus, hipDeviceAttributeMultiprocessorCount, dev) != hipSuccess) { grid = -1; return; }
        if (hipFuncSetAttribute((const void*)fwd_megakernel, hipFuncAttributeMaxDynamicSharedMemorySize, LDS_BYTES) != hipSuccess) { fprintf(stderr, "kernel_launch: hipFuncSetAttribute failed\n"); grid = -1; return; }
        if (hipOccupancyMaxActiveBlocksPerMultiprocessor(&per_cu, (const void*)fwd_megakernel, NWAVES * 64, LDS_BYTES) != hipSuccess || per_cu < 1) { fprintf(stderr, "kernel_launch: occupancy query says %d blocks per CU\n", per_cu); per_cu = 1; }
        (void)hipGetLastError();
        grid = cus;
    }
    if (grid < 0) return;
    if (hipMemsetAsync((char*)d_ws + WS_CTL, 0, CTL_ZERO_BYTES, stream) != hipSuccess) { fprintf(stderr, "kernel_launch: memset failed\n"); return; }
    Args a{};
    for (int i = 0; i < 13; ++i) a.in[i] = (const float*)d_in[i];
    a.out = (float*)d_out; a.ws = (unsigned char*)d_ws;
#if MK_N_LAUNCHES == 1
    a.ph_lo = 0; a.ph_hi = 13;
    void* kargs[] = {&a};
    hipError_t e = hipLaunchCooperativeKernel((const void*)fwd_megakernel, dim3(grid), dim3(NWAVES * 64), kargs, LDS_BYTES, stream);
    if (e != hipSuccess) fprintf(stderr, "kernel_launch: cooperative launch failed: %s (grid %d)\n", hipGetErrorString(e), grid);
#else
    for (int p = 0; p < 13; ++p) { a.ph_lo = p; a.ph_hi = p + 1; hipLaunchKernelGGL(fwd_megakernel, dim3(grid), dim3(NWAVES * 64), LDS_BYTES, stream, a); }
#endif
}
```

```cpp
#include <hip/hip_runtime.h>
#include <hip/hip_cooperative_groups.h>
#include <cstdio>
#include <cstdint>
namespace cg = cooperative_groups;

#ifndef MK_N_LAUNCHES
#define MK_N_LAUNCHES 1
#endif

namespace pg8 {
#define PG8_LAS __attribute__((address_space(3)))
typedef unsigned short bf16_t;
typedef short bf16x8 __attribute__((ext_vector_type(8)));
typedef float f32x4 __attribute__((ext_vector_type(4)));
typedef unsigned u32x4 __attribute__((ext_vector_type(4)));
constexpr int BM = 256, BK = 64, HALF = 128, HTB = HALF * BK * 2, STAGE_BYTES = 8 * HTB, NXCD = 8, WGM = 8;

__host__ __device__ __forceinline__ int lds_byte(int r, int c) { const int st = (r >> 4) * 2 + (c >> 5), rr = r & 15, cc = c & 31, ob = rr * 64 + cc * 2; return st * 1024 + (ob ^ (((ob >> 9) & 1) << 5)); }
__host__ __device__ __forceinline__ void stage_rc(int b, int& R, int& C) { const int st = b / 1024, sb = b % 1024, swz = sb ^ (((sb >> 9) & 1) << 5); R = (st >> 1) * 16 + swz / 64; C = (st & 1) * 32 + (swz % 64) / 2; }
__host__ __device__ __forceinline__ int perm32(int rho) { const int n = rho >> 4, i = rho & 15; return 8 * (i >> 2) + 4 * n + (i & 3); }

struct Unit { int pm, pn; };
struct Gemm { const bf16_t* A; const bf16_t* Bt; int M, N, K, lda, ldb; size_t a_pn_bytes; };

struct StaticOrder {
    int nM, nN, nwg, G, c;
    __host__ __device__ void init(int M, int N, int G_, int c_) { nM = M / BM; nN = N / BM; nwg = nM * nN; G = G_; c = c_; }
    __host__ __device__ bool next(int i, Unit& u) const {
        const long L = (long)i * G + c; if (L >= nwg) return false;
        int wgid = (int)L; { const int q = nwg / NXCD, r = nwg % NXCD, xcd = wgid % NXCD, off = wgid / NXCD; wgid = (xcd < r ? xcd * (q + 1) : r * (q + 1) + (xcd - r) * q) + off; }
        const int nig = WGM * nN, gid = wgid / nig, fm = gid * WGM, gsz = (nM - fm) < WGM ? (nM - fm) : WGM;
        u.pm = fm + ((wgid % nig) % gsz); u.pn = (wgid % nig) / gsz; return true;
    }
};

__device__ __forceinline__ unsigned cvt_pk_bf16(float lo, float hi) { unsigned r; asm volatile("v_cvt_pk_bf16_f32 %0, %1, %2" : "=v"(r) : "v"(lo), "v"(hi)); return r; }

constexpr float RMS_EPS = 1e-6f;

struct EpiBf16 {
    bf16_t* O; int ldc;
    __device__ __forceinline__ void operator()(const f32x4 (&acc)[2][2][4][2], const Unit& u, int wr, int wc, int fr, int fq) const {
        const int row0 = u.pm * BM + wr * 64 + fr, col0 = u.pn * BM + wc * 32 + 8 * fq;
#pragma unroll
        for (int ai = 0; ai < 2; ++ai)
#pragma unroll
            for (int m = 0; m < 4; ++m) { bf16_t* rowp = O + (size_t)(row0 + ai * HALF + m * 16) * ldc + col0;
#pragma unroll
                for (int bj = 0; bj < 2; ++bj) { const f32x4 v0 = acc[ai][bj][m][0], v1 = acc[ai][bj][m][1];
                    u32x4 w; w.x = cvt_pk_bf16(v0[0], v0[1]); w.y = cvt_pk_bf16(v0[2], v0[3]); w.z = cvt_pk_bf16(v1[0], v1[1]); w.w = cvt_pk_bf16(v1[2], v1[3]);
                    *(u32x4*)(rowp + bj * HALF) = w; } }
    }
};
__device__ __forceinline__ float bf_lo(unsigned w) { return __builtin_bit_cast(float, w << 16); }
__device__ __forceinline__ float bf_hi(unsigned w) { return __builtin_bit_cast(float, w & 0xffff0000u); }
template <bool BASE_F32, bool SCALE = false> struct EpiRes {
    const float* basef; bf16_t* xb; float* ss; const PG8_LAS float* ctab;
    __device__ __forceinline__ void load_base(int row, int col0, f32x4 (&nb)[4]) const {
        if (BASE_F32) { const float* bp = basef + (size_t)row * 1024 + col0; nb[0] = *(const f32x4*)(bp); nb[1] = *(const f32x4*)(bp + 4); nb[2] = *(const f32x4*)(bp + HALF); nb[3] = *(const f32x4*)(bp + HALF + 4); }
        else { const bf16_t* bp = xb + (size_t)row * 1024 + col0; const u32x4 a = *(const u32x4*)(bp), c = *(const u32x4*)(bp + HALF);
            nb[0] = (f32x4){bf_lo(a.x), bf_hi(a.x), bf_lo(a.y), bf_hi(a.y)}; nb[1] = (f32x4){bf_lo(a.z), bf_hi(a.z), bf_lo(a.w), bf_hi(a.w)};
            nb[2] = (f32x4){bf_lo(c.x), bf_hi(c.x), bf_lo(c.y), bf_hi(c.y)}; nb[3] = (f32x4){bf_lo(c.z), bf_hi(c.z), bf_lo(c.w), bf_hi(c.w)}; }
    }
    __device__ __forceinline__ void operator()(const f32x4 (&acc)[2][2][4][2], const Unit& u, int wr, int wc, int fr, int fq) const {
        const int row0 = u.pm * BM + wr * 64 + fr, col0 = u.pn * BM + wc * 32 + 8 * fq;
        f32x4 nb[4];
        load_base(row0, col0, nb);
#pragma unroll
        for (int it = 0; it < 8; ++it) { const int ai = it >> 2, m = it & 3;
            const size_t row = (size_t)(row0 + ai * HALF + m * 16); const size_t off = row * 1024 + col0; float s = 0.f;
            const f32x4 b0 = nb[0], b1 = nb[1], b2 = nb[2], b3 = nb[3];
            if (it < 7) load_base(row0 + ((it + 1) >> 2) * HALF + ((it + 1) & 3) * 16, col0, nb);
            const float cs = SCALE ? ctab[wr * 64 + fr + ai * HALF + m * 16] : 1.0f;
#pragma unroll
            for (int bj = 0; bj < 2; ++bj) {
                const f32x4 v0 = acc[ai][bj][m][0] * cs + (bj == 0 ? b0 : b2), v1 = acc[ai][bj][m][1] * cs + (bj == 0 ? b1 : b3);
                s += (v0[0] * v0[0] + v0[1] * v0[1]) + (v0[2] * v0[2] + v0[3] * v0[3]) + (v1[0] * v1[0] + v1[1] * v1[1]) + (v1[2] * v1[2] + v1[3] * v1[3]);
                u32x4 w; w.x = cvt_pk_bf16(v0[0], v0[1]); w.y = cvt_pk_bf16(v0[2], v0[3]); w.z = cvt_pk_bf16(v1[0], v1[1]); w.w = cvt_pk_bf16(v1[2], v1[3]);
                *(u32x4*)(xb + off + bj * HALF) = w; }
            s += __shfl_xor(s, 16); s += __shfl_xor(s, 32);
            if (fq == 0) ss[row * 16 + u.pn * 4 + wc] = s; }
    }
};
struct RsTab { const PG8_LAS float* tab; int pm; };
__device__ __forceinline__ float row_rstd(const float* ss, size_t row, int fq) {
    const f32x4 p = *(const f32x4*)(ss + row * 16 + 4 * fq); float s = (p[0] + p[1]) + (p[2] + p[3]);
    s += __shfl_xor(s, 16); s += __shfl_xor(s, 32);
    return rsqrtf(s * (1.0f / 1024.0f) + RMS_EPS);
}
struct EpiSwiGLU {
    bf16_t* act; const float* ss; int ldc; RsTab rt;
    __device__ __forceinline__ void operator()(const f32x4 (&acc)[2][2][4][2], const Unit& u, int wr, int wc, int fr, int fq) const {
        const int row0 = u.pm * BM + wr * 64 + fr, col0 = u.pn * HALF + wc * 32 + 8 * fq;
        const bool use_tab = (u.pm == rt.pm);
#pragma unroll
        for (int ai = 0; ai < 2; ++ai)
#pragma unroll
            for (int m = 0; m < 4; ++m) { const size_t row = (size_t)(row0 + ai * HALF + m * 16); float rstd; if (__builtin_expect(use_tab, 1)) rstd = rt.tab[wr * 64 + fr + ai * HALF + m * 16]; else { asm volatile("; rstd from global (grid != 256)" ::: "memory"); rstd = row_rstd(ss, row, fq); }
                float a[8];
#pragma unroll
                for (int n = 0; n < 2; ++n)
#pragma unroll
                    for (int i = 0; i < 4; ++i) { const float g = acc[ai][0][m][n][i] * rstd, up = acc[ai][1][m][n][i] * rstd;
                        a[n * 4 + i] = g * up * __builtin_amdgcn_rcpf(1.0f + __builtin_amdgcn_exp2f(-1.4426950408889634f * g)); }
                u32x4 w; w.x = cvt_pk_bf16(a[0], a[1]); w.y = cvt_pk_bf16(a[2], a[3]); w.z = cvt_pk_bf16(a[4], a[5]); w.w = cvt_pk_bf16(a[6], a[7]);
                *(u32x4*)(act + row * ldc + col0) = w; }
    }
};
struct EpiQKV {
    bf16_t* qkv; const float* ss; const float* rope; RsTab rt;
    __device__ __forceinline__ void operator()(const f32x4 (&acc)[2][2][4][2], const Unit& u, int wr, int wc, int fr, int fq) const {
        const int row0 = u.pm * BM + wr * 64 + fr; const int sect = u.pn >> 2, head = (u.pn & 3) * 4 + wc;
        const int dsh = head < 6 ? 0 : (head < 11 ? 2 : 4);
        bf16_t* dst = qkv + (size_t)sect * ((size_t)16384 * 1024);
        const float qs = sect == 0 ? 0.125f * 1.4426950408889634f : 1.0f;
        const bool use_tab = (u.pm == rt.pm);
        const bool rot = sect < 2;
        f32x4 nr[4];
        if (rot) { const float* rp = rope + (size_t)(row0 & 8191) * 64 + 8 * fq; nr[0] = *(const f32x4*)(rp); nr[1] = *(const f32x4*)(rp + 4); nr[2] = *(const f32x4*)(rp + 32); nr[3] = *(const f32x4*)(rp + 36); }
#pragma unroll
        for (int it = 0; it < 8; ++it) { const int ai = it >> 2, m = it & 3;
            const int row = row0 + ai * HALF + m * 16; float rstd; if (__builtin_expect(use_tab, 1)) rstd = rt.tab[wr * 64 + fr + ai * HALF + m * 16]; else { asm volatile("; rstd from global (grid != 256)" ::: "memory"); rstd = row_rstd(ss, (size_t)row, fq); } rstd *= qs;
            const int b = row >> 13, t = row & 8191; const int pos = ((t & ((1 << dsh) - 1)) << (13 - dsh)) + (t >> dsh);
            bf16_t* o = dst + ((size_t)(b * 16 + head) * 8192 + pos) * 64 + 8 * fq;
            const f32x4 c0 = nr[0], c1 = nr[1], s0 = nr[2], s1 = nr[3];
            if (rot && it < 7) { const int row2 = row0 + ((it + 1) >> 2) * HALF + ((it + 1) & 3) * 16; const float* rp = rope + (size_t)(row2 & 8191) * 64 + 8 * fq;
                nr[0] = *(const f32x4*)(rp); nr[1] = *(const f32x4*)(rp + 4); nr[2] = *(const f32x4*)(rp + 32); nr[3] = *(const f32x4*)(rp + 36); }
            float lo[8], hi[8];
#pragma unroll
            for (int n = 0; n < 2; ++n)
#pragma unroll
                for (int i = 0; i < 4; ++i) { lo[n * 4 + i] = acc[ai][0][m][n][i] * rstd; hi[n * 4 + i] = acc[ai][1][m][n][i] * rstd; }
            if (rot) {
#pragma unroll
                for (int i = 0; i < 8; ++i) { const float cs = i < 4 ? c0[i & 3] : c1[i & 3], sn = i < 4 ? s0[i & 3] : s1[i & 3];
                    const float l = lo[i], h = hi[i]; lo[i] = l * cs - h * sn; hi[i] = h * cs + l * sn; }
            }
            u32x4 w; w.x = cvt_pk_bf16(lo[0], lo[1]); w.y = cvt_pk_bf16(lo[2], lo[3]); w.z = cvt_pk_bf16(lo[4], lo[5]); w.w = cvt_pk_bf16(lo[6], lo[7]);
            *(u32x4*)(o) = w;
            w.x = cvt_pk_bf16(hi[0], hi[1]); w.y = cvt_pk_bf16(hi[2], hi[3]); w.z = cvt_pk_bf16(hi[4], hi[5]); w.w = cvt_pk_bf16(hi[6], hi[7]);
            *(u32x4*)(o + 32) = w; }
    }
};

template <class Epi, class Sched, bool ALIGN_EPI, bool SEG = false>
__device__ __forceinline__ void gemm_phase(PG8_LAS unsigned char* lds, const Gemm g, const Sched& S, const Epi& E, const PG8_LAS float* segtab = nullptr) {
    int tid = threadIdx.x; asm volatile("" : "+v"(tid));
    const int wid = __builtin_amdgcn_readfirstlane(tid >> 6), lane = tid & 63, wr = wid >> 2, wc = wid & 3, fr = lane & 15, fq = lane >> 4;
    const int K = g.K, nt = K / BK;
    unsigned voffA[2], voffB[2];
#pragma unroll
    for (int i = 0; i < 2; ++i) { int R, C; stage_rc(tid * 16 + i * 8192, R, C); const int Rb = (R & ~31) + perm32(R & 31);
        voffA[i] = (unsigned)(R * g.lda + C) * 2u; voffB[i] = (unsigned)(Rb * g.ldb + C) * 2u; }
    const size_t kstep = (size_t)(BK * 2);
    const size_t hstepA = (size_t)HALF * g.lda * 2, hstepB = (size_t)HALF * g.ldb * 2;
    const size_t tstepA = 2 * hstepA, tstepB = 2 * hstepB;
    const unsigned ldsw = (unsigned)wid * 1024u;
    const int aoff = lds_byte(wr * 64 + fr, fq * 8), boff = lds_byte(wc * 32 + fr, fq * 8);
#define PG8_SA(b, h) (((b) * 2 + (h)) * HTB)
#define PG8_SB(b, h) ((4 + (b) * 2 + (h)) * HTB)
#define PG8_STAGE(bufoff, gbase, voff) do { _Pragma("unroll") for (int _i = 0; _i < 2; ++_i) \
        __builtin_amdgcn_global_load_lds((const unsigned*)((const char*)(gbase) + (voff)[_i]), (PG8_LAS unsigned*)(lds + (bufoff) + ldsw + _i * 8192), 16, 0, 0); } while (0)
#define PG8_LDA(dst, b, h) do { _Pragma("unroll") for (int m = 0; m < 4; ++m) _Pragma("unroll") for (int k = 0; k < 2; ++k) dst[m][k] = *(const PG8_LAS bf16x8*)(lds + PG8_SA(b, h) + aoff + m * 2048 + k * 1024); } while (0)
#define PG8_LDB(dst, b, h) do { _Pragma("unroll") for (int n = 0; n < 2; ++n) _Pragma("unroll") for (int k = 0; k < 2; ++k) dst[n][k] = *(const PG8_LAS bf16x8*)(lds + PG8_SB(b, h) + boff + n * 2048 + k * 1024); } while (0)
#define PG8_MMA(ai, bj, At, Bt) do { __builtin_amdgcn_s_setprio(1); _Pragma("unroll") for (int m = 0; m < 4; ++m) _Pragma("unroll") for (int n = 0; n < 2; ++n) _Pragma("unroll") for (int k = 0; k < 2; ++k) \
        acc[ai][bj][m][n] = __builtin_amdgcn_mfma_f32_16x16x32_bf16(Bt[n][k], At[m][k], acc[ai][bj][m][n], 0, 0, 0); __builtin_amdgcn_s_setprio(0); } while (0)
#define PG8_SEGSCALE(tb) do { _Pragma("unroll") for (int ai = 0; ai < 2; ++ai) _Pragma("unroll") for (int m = 0; m < 4; ++m) { const float f_ = (tb)[wr * 64 + fr + ai * HALF + m * 16]; \
        _Pragma("unroll") for (int bj = 0; bj < 2; ++bj) _Pragma("unroll") for (int n = 0; n < 2; ++n) acc[ai][bj][m][n] = acc[ai][bj][m][n] * f_; } } while (0)
#define PG8_WAIT_V(n) asm volatile("s_waitcnt vmcnt(" #n ")" ::: "memory")
#define PG8_WAIT_L(n) asm volatile("s_waitcnt lgkmcnt(" #n ")" ::: "memory")
#define PG8_BAR __builtin_amdgcn_s_barrier()
#define PG8_SCHED __builtin_amdgcn_sched_barrier(0)
    Unit cur, nxt; int ui = 0;
    if (!S.next(0, cur)) return;
    f32x4 acc[2][2][4][2];
#pragma unroll
    for (int a = 0; a < 2; ++a)
#pragma unroll
        for (int b = 0; b < 2; ++b)
#pragma unroll
            for (int m = 0; m < 4; ++m)
#pragma unroll
                for (int n = 0; n < 2; ++n) acc[a][b][m][n] = (f32x4){0.f, 0.f, 0.f, 0.f};
    bf16x8 At[4][2], B0[2][2], B1[2][2];
    const char* cA = (const char*)g.A + (size_t)cur.pm * tstepA + (size_t)cur.pn * g.a_pn_bytes; const char* cB = (const char*)g.Bt + (size_t)cur.pn * tstepB;
    PG8_STAGE(PG8_SB(0, 0), cB, voffB); PG8_STAGE(PG8_SB(0, 1), cB + hstepB, voffB); PG8_STAGE(PG8_SA(0, 0), cA, voffA); PG8_STAGE(PG8_SA(0, 1), cA + hstepA, voffA);
    if (wr == 1) PG8_BAR;
    PG8_WAIT_V(2); PG8_BAR;
    PG8_STAGE(PG8_SB(1, 0), cB + kstep, voffB); PG8_STAGE(PG8_SA(1, 0), cA + kstep, voffA); PG8_STAGE(PG8_SB(1, 1), cB + hstepB + kstep, voffB);
    PG8_WAIT_V(6); PG8_BAR;
    for (;;) {
        const bool has_next = S.next(ui + 1, nxt);
        const char* nA = has_next ? (const char*)g.A + (size_t)nxt.pm * tstepA + (size_t)nxt.pn * g.a_pn_bytes : cA; const char* nB = has_next ? (const char*)g.Bt + (size_t)nxt.pn * tstepB : cB;
        for (int t = 0; t < nt; t += 2) {
            const bool last = (t == nt - 2);
            const char* a1 = cA + (size_t)(t + 1) * kstep;
            const char* a2 = last ? nA : cA + (size_t)(t + 2) * kstep; const char* b2 = last ? nB : cB + (size_t)(t + 2) * kstep;
            const char* a3 = a2 + kstep; const char* b3 = b2 + kstep;
            if constexpr (SEG) { if (t == 6) PG8_SEGSCALE(segtab); }
            PG8_LDB(B0, 0, 0); PG8_LDB(B1, 0, 1); PG8_SCHED; PG8_LDA(At, 0, 0); PG8_STAGE(PG8_SA(1, 1), a1 + hstepA, voffA);
            PG8_WAIT_V(8); PG8_WAIT_L(0); PG8_BAR; PG8_MMA(0, 0, At, B0); PG8_MMA(0, 1, At, B1); PG8_BAR; PG8_SCHED;
            PG8_LDA(At, 0, 1); PG8_STAGE(PG8_SB(0, 0), b2, voffB); PG8_STAGE(PG8_SB(0, 1), b2 + hstepB, voffB); PG8_STAGE(PG8_SA(0, 0), a2, voffA);
            PG8_WAIT_V(8); PG8_WAIT_L(0); PG8_BAR; PG8_MMA(1, 0, At, B0); PG8_MMA(1, 1, At, B1); PG8_BAR; PG8_SCHED;
            if constexpr (SEG) { if (t == 10) PG8_SEGSCALE(segtab + 256); }
            PG8_LDB(B0, 1, 0); PG8_LDB(B1, 1, 1); PG8_SCHED; PG8_LDA(At, 1, 0); PG8_STAGE(PG8_SA(0, 1), a2 + hstepA, voffA);
            PG8_WAIT_V(8); PG8_WAIT_L(0); PG8_BAR; PG8_MMA(0, 0, At, B0); PG8_MMA(0, 1, At, B1); PG8_BAR; PG8_SCHED;
            PG8_LDA(At, 1, 1); PG8_STAGE(PG8_SB(1, 0), b3, voffB); PG8_STAGE(PG8_SB(1, 1), b3 + hstepB, voffB); PG8_STAGE(PG8_SA(1, 0), a3, voffA);
            PG8_WAIT_V(8); PG8_WAIT_L(0); PG8_BAR; PG8_MMA(1, 0, At, B0); PG8_MMA(1, 1, At, B1); PG8_BAR; PG8_SCHED;
        }
        if constexpr (ALIGN_EPI) { if (wr == 0) PG8_BAR; }
        E(acc, cur, wr, wc, fr, fq);
        if (!has_next) break;
#pragma unroll
        for (int a = 0; a < 2; ++a)
#pragma unroll
            for (int b = 0; b < 2; ++b)
#pragma unroll
                for (int m = 0; m < 4; ++m)
#pragma unroll
                    for (int n = 0; n < 2; ++n) acc[a][b][m][n] = (f32x4){0.f, 0.f, 0.f, 0.f};
        cur = nxt; cA = nA; cB = nB; ++ui;
        if constexpr (ALIGN_EPI) { if (wr == 1) PG8_BAR; }
    }
    PG8_WAIT_V(0);
    if constexpr (!ALIGN_EPI) { if (wr == 0) PG8_BAR; }
    PG8_BAR;
#undef PG8_SA
#undef PG8_SB
#undef PG8_STAGE
#undef PG8_LDA
#undef PG8_LDB
#undef PG8_MMA
#undef PG8_WAIT_V
#undef PG8_SEGSCALE
#undef PG8_WAIT_L
#undef PG8_BAR
#undef PG8_SCHED
}
}

constexpr int NWAVES = 8;
constexpr int BATCH = 2, SEQ = 8192, D = 1024, H = 16, HD = 64, FF = 2816;
constexpr int M = BATCH * SEQ;
constexpr size_t MiB = 1u << 20;
constexpr size_t WS_CTL = 0, CTL_ZERO_BYTES = 64 * 1024;
constexpr size_t WS_ROPE = 1 * MiB;
constexpr size_t WS_SS = 3 * MiB;
constexpr size_t WS_LSE = 4 * MiB;
constexpr size_t WS_WIN = 6 * MiB;
constexpr size_t WS_WG = 8 * MiB;
constexpr size_t WS_WPO = 9 * MiB;
constexpr size_t WS_WGU0 = 11 * MiB;
constexpr size_t WS_WD0 = 22 * MiB;
constexpr size_t WS_WQKV = 28 * MiB;
constexpr size_t WS_WAO = 34 * MiB;
constexpr size_t WS_WGU1 = 36 * MiB;
constexpr size_t WS_WD1 = 47 * MiB;
constexpr size_t WS_BIG = 56 * MiB;
constexpr size_t WS_XB = 184 * MiB;
constexpr size_t WS_ZO = 216 * MiB;
constexpr size_t WS_END = 248 * MiB;
constexpr int CW_BAR = 1024;

constexpr int LDS_BYTES = 147456;

#define GAS __attribute__((address_space(1)))
#define LAS __attribute__((address_space(3)))
typedef unsigned short bf16;
typedef unsigned v4u __attribute__((ext_vector_type(4)));
typedef unsigned v2u __attribute__((ext_vector_type(2)));
typedef float f32x4 __attribute__((ext_vector_type(4)));
#define LDS_WAIT() asm volatile("s_waitcnt lgkmcnt(0)" ::: "memory")
__device__ __forceinline__ unsigned f2bf(float f) { unsigned u = __builtin_bit_cast(unsigned, f); return (u + 0x7fffu + ((u >> 16) & 1u)) >> 16; }
__device__ __forceinline__ unsigned pk2(float lo, float hi) { return f2bf(lo) | (f2bf(hi) << 16); }
__device__ __forceinline__ float bflo(unsigned w) { return __builtin_bit_cast(float, w << 16); }
__device__ __forceinline__ float bfhi(unsigned w) { return __builtin_bit_cast(float, w & 0xffff0000u); }

#define XB_TMO      128
#define XB_XCNT(j)  (256  + 64 * (j))
#define XB_XSUB(j)  (1280 + 64 * (j))
#define XB_XGEN(j)  (2304 + 64 * (j))
#define XB_TOP      3328
#define XB_TOPGEN   3392
#define XCD_BAR_WORDS 3456
#define XB_SPIN_CAP (1u << 22)
__device__ __forceinline__ unsigned xb_ld(unsigned* p)              { return __hip_atomic_load(p, __ATOMIC_RELAXED, __HIP_MEMORY_SCOPE_AGENT); }
__device__ __forceinline__ unsigned xb_add(unsigned* p, unsigned v) { return __hip_atomic_fetch_add(p, v, __ATOMIC_RELAXED, __HIP_MEMORY_SCOPE_AGENT); }
__device__ __forceinline__ unsigned xb_xcc_id() { return (unsigned)__builtin_amdgcn_s_getreg((3 << 11) | 20) & 0xFu; }
#define XB_SPIN(cond, bar) do { unsigned _sp = 0; while (cond) { __builtin_amdgcn_s_sleep(1); \
    if ((++_sp & 255u) == 0u) { if (xb_ld(&(bar)[XB_TMO])) break; if (_sp > XB_SPIN_CAP) { atomicAdd(&(bar)[XB_TMO], 1u); break; } } } } while (0)
struct XcdBarrier { unsigned* bar; unsigned x; volatile LAS unsigned* st; };
__device__ __forceinline__ XcdBarrier xcd_barrier_post(unsigned* bar, volatile LAS unsigned* st) {
    XcdBarrier b; b.bar = bar; b.x = xb_xcc_id(); b.st = st;
    if (threadIdx.x == 0) (void)xb_add(&bar[XB_XCNT(b.x)], 1u);
    return b;
}
__device__ __forceinline__ void xcd_barrier_complete(unsigned* bar, unsigned x, unsigned& nloc, unsigned& nx) {
    const unsigned G = gridDim.x * gridDim.y * gridDim.z;
    unsigned sum, cnt, mine, sp = 0u;
    for (;;) {
        sum = 0u; cnt = 0u; mine = 0u;
#pragma unroll
        for (unsigned j = 0; j < 16; ++j) { const unsigned c = xb_ld(&bar[XB_XCNT(j)]); sum += c; cnt += (c > 0u) ? 1u : 0u; mine = (j == x) ? c : mine; }
        if (sum == G) break;
        __builtin_amdgcn_s_sleep(1);
        if ((++sp & 255u) == 0u) { if (xb_ld(&bar[XB_TMO])) break; if (sp > XB_SPIN_CAP) { atomicAdd(&bar[XB_TMO], 1u); break; } }
    }
    nloc = mine > 0u ? mine : 1u; nx = cnt > 0u ? cnt : 1u;
}
__device__ __forceinline__ void xcd_barrier(const XcdBarrier& b) {
    asm volatile("s_waitcnt vmcnt(0)" ::: "memory");
    __syncthreads();
    if (threadIdx.x == 0) {
        unsigned* bar = b.bar;
        __builtin_amdgcn_s_waitcnt(0);
        unsigned nloc = b.st[0], nx = b.st[1];
        if (nloc == 0u) { xcd_barrier_complete(bar, b.x, nloc, nx); b.st[0] = nloc; b.st[1] = nx; }
        const unsigned old = xb_add(&bar[XB_XSUB(b.x)], 1u);
        const unsigned gen = old / nloc;
        if (old + 1u == (gen + 1u) * nloc) {
            __builtin_amdgcn_fence(__ATOMIC_RELEASE, "agent");
            asm volatile("s_waitcnt vmcnt(0)" ::: "memory");
            const unsigned og = xb_add(&bar[XB_TOP], 1u);
            const unsigned tg = og / nx;
            if (og + 1u == (tg + 1u) * nx) xb_add(&bar[XB_TOPGEN], 1u);
            else XB_SPIN(xb_ld(&bar[XB_TOPGEN]) == tg, bar);
            __builtin_amdgcn_fence(__ATOMIC_ACQUIRE, "agent");
            xb_add(&bar[XB_XGEN(b.x)], 1u);
            asm volatile("s_waitcnt vmcnt(0)" ::: "memory");
        } else {
            XB_SPIN(xb_ld(&bar[XB_XGEN(b.x)]) == gen, bar);
            __builtin_amdgcn_fence(__ATOMIC_ACQUIRE, "agent");
            asm volatile("s_waitcnt vmcnt(0)" ::: "memory");
        }
    }
    __syncthreads();
}

struct EpiFinal {
    const bf16* xb; float* out; float* ss; const float* gf; XcdBarrier bar;
    __device__ __forceinline__ void load_base(int row, int col0, pg8::f32x4 (&nb)[4]) const {
        using pg8::f32x4; using pg8::u32x4; using pg8::bf_lo; using pg8::bf_hi;
        const bf16* bp = xb + (size_t)row * 1024 + col0; const u32x4 a = *(const u32x4*)(bp), c = *(const u32x4*)(bp + pg8::HALF);
        nb[0] = (f32x4){bf_lo(a.x), bf_hi(a.x), bf_lo(a.y), bf_hi(a.y)}; nb[1] = (f32x4){bf_lo(a.z), bf_hi(a.z), bf_lo(a.w), bf_hi(a.w)};
        nb[2] = (f32x4){bf_lo(c.x), bf_hi(c.x), bf_lo(c.y), bf_hi(c.y)}; nb[3] = (f32x4){bf_lo(c.z), bf_hi(c.z), bf_lo(c.w), bf_hi(c.w)};
    }
    __device__ __forceinline__ void operator()(pg8::f32x4 (&acc)[2][2][4][2], const pg8::Unit& u, int wr, int wc, int fr, int fq) const {
        using pg8::f32x4; using pg8::HALF; using pg8::BM;
        const int row0 = u.pm * BM + wr * 64 + fr, col0 = u.pn * BM + wc * 32 + 8 * fq;
        f32x4 nb[4];
        load_base(row0, col0, nb);
#pragma unroll
        for (int it = 0; it < 8; ++it) { const int ai = it >> 2, m = it & 3;
            const size_t row = (size_t)(row0 + ai * HALF + m * 16); float s = 0.f;
            const f32x4 b0 = nb[0], b1 = nb[1], b2 = nb[2], b3 = nb[3];
            if (it < 7) load_base(row0 + ((it + 1) >> 2) * HALF + ((it + 1) & 3) * 16, col0, nb);
#pragma unroll
            for (int bj = 0; bj < 2; ++bj) {
                const f32x4 v0 = acc[ai][bj][m][0] + (bj == 0 ? b0 : b2), v1 = acc[ai][bj][m][1] + (bj == 0 ? b1 : b3);
                acc[ai][bj][m][0] = v0; acc[ai][bj][m][1] = v1;
                s += (v0[0] * v0[0] + v0[1] * v0[1]) + (v0[2] * v0[2] + v0[3] * v0[3]) + (v1[0] * v1[0] + v1[1] * v1[1]) + (v1[2] * v1[2] + v1[3] * v1[3]); }
            s += __shfl_xor(s, 16); s += __shfl_xor(s, 32);
            if (fq == 0) ss[row * 16 + u.pn * 4 + wc] = s; }
        xcd_barrier(bar);
        f32x4 gq[2][2];
#pragma unroll
        for (int bj = 0; bj < 2; ++bj)
#pragma unroll
            for (int n = 0; n < 2; ++n) gq[bj][n] = *(const f32x4*)(gf + col0 + bj * HALF + 4 * n);
        f32x4 pr[8];
#pragma unroll
        for (int it = 0; it < 8; ++it) pr[it] = *(const f32x4*)(ss + (size_t)(row0 + (it >> 2) * HALF + (it & 3) * 16) * 16 + 4 * fq);
#pragma unroll
        for (int it = 0; it < 8; ++it) { const int ai = it >> 2, m = it & 3;
            const size_t row = (size_t)(row0 + ai * HALF + m * 16); const size_t off = row * 1024 + col0;
            float sq = (pr[it][0] + pr[it][1]) + (pr[it][2] + pr[it][3]); sq += __shfl_xor(sq, 16); sq += __shfl_xor(sq, 32);
            const float rstd = rsqrtf(sq * (1.0f / 1024.0f) + pg8::RMS_EPS);
#pragma unroll
            for (int bj = 0; bj < 2; ++bj) { *(f32x4*)(out + off + bj * HALF) = acc[ai][bj][m][0] * rstd * gq[bj][0]; *(f32x4*)(out + off + bj * HALF + 4) = acc[ai][bj][m][1] * rstd * gq[bj][1]; } }
    }
};

struct Frame {
    LAS unsigned char* lds;
    int tid, lane, wave, vcu, G;
};
__device__ __forceinline__ float wave_sum(float v) {
#pragma unroll
    for (int o = 1; o < 64; o <<= 1) v += __shfl_xor(v, o);
    return v;
}

constexpr int LDS_RSTAB = 131072 + 4096;
__device__ __forceinline__ pg8::RsTab fill_rstd_tab(LAS unsigned char* lds, const float* ss, int pm) {
    LAS float* tab = (LAS float*)(lds + LDS_RSTAB);
    int tid = threadIdx.x; asm volatile("" : "+v"(tid));
    if (tid < 256) { const float* p = ss + ((size_t)pm * 256 + tid) * 16; float s = 0.f;
#pragma unroll
        for (int q = 0; q < 4; ++q) { const f32x4 v = *(const GAS f32x4*)(p + 4 * q); s += (v[0] + v[1]) + (v[2] + v[3]); }
        tab[tid] = rsqrtf(s * (1.0f / 1024.0f) + 1e-6f); }
    LDS_WAIT(); __syncthreads();
    pg8::RsTab r; r.tab = tab; r.pm = pm; return r;
}

__device__ __forceinline__ const LAS float* seg_fill(LAS unsigned char* lds, const float* lse, int pm) {
    LAS float* tab = (LAS float*)(lds + LDS_RSTAB);
    int tid = threadIdx.x; asm volatile("" : "+v"(tid));
    if (tid < 256) { const float* p = lse + ((size_t)pm * 256 + tid) * 16; float L[16];
#pragma unroll
        for (int q4 = 0; q4 < 4; ++q4) { const f32x4 v = *(const GAS f32x4*)(p + 4 * q4); L[4 * q4] = v[0]; L[4 * q4 + 1] = v[1]; L[4 * q4 + 2] = v[2]; L[4 * q4 + 3] = v[3]; }
        float lg0, lg1, lg2;
        { float mx = L[0];
_Pragma("unroll") for (int i = 1; i < 6; ++i) mx = fmaxf(mx, L[i]); float s = 0.f;
_Pragma("unroll") for (int i = 0; i < 6; ++i) s += __expf(L[i] - mx); lg0 = mx + __logf(s) - 1.791759469228055f; }
        { float mx = L[6];
_Pragma("unroll") for (int i = 7; i < 11; ++i) mx = fmaxf(mx, L[i]); float s = 0.f;
_Pragma("unroll") for (int i = 6; i < 11; ++i) s += __expf(L[i] - mx); lg1 = mx + __logf(s) - 1.6094379124341003f; }
        { float mx = L[11];
_Pragma("unroll") for (int i = 12; i < 16; ++i) mx = fmaxf(mx, L[i]); float s = 0.f;
_Pragma("unroll") for (int i = 11; i < 16; ++i) s += __expf(L[i] - mx); lg2 = mx + __logf(s) - 1.6094379124341003f; }
        const float mx = fmaxf(lg0, fmaxf(lg1, lg2));
        const float e0 = __expf(lg0 - mx), e1 = __expf(lg1 - mx), e2 = __expf(lg2 - mx); const float is = 3.0f / (e0 + e1 + e2);
        const float s0 = fmaxf(e0 * is, 1e-30f), s1 = fmaxf(e1 * is, 1e-30f), s2 = fmaxf(e2 * is, 1e-30f);
        tab[tid] = s0 / s1; tab[256 + tid] = s1 / s2; tab[512 + tid] = s2; }
    LDS_WAIT(); __syncthreads();
    return tab;
}

__device__ __forceinline__ int p0_map_row(int mode, int sel, int row_off, int n) {
    if (mode == 0) return row_off + n;
    if (mode == 1) return 256 * (n >> 7) + 128 * sel + (n & 127);
    const int pn = n >> 8, w = n & 255, wc = w >> 6, d = w & 63; return 256 * pn + 128 * (d >> 5) + 32 * wc + (d & 31);
}
__device__ __forceinline__ void p0_tr_item(const float* W, int K, int N, bf16* WT, int mode, int sel, int row_off, const float* kgain, const float* nscale, LAS unsigned* scr, int item, int lane) {
    const int nblk = N / 64, kb = item / nblk, nb = item % nblk, k0 = 64 * kb, n0 = 64 * nb;
    const int kq = lane >> 4, n4 = (lane & 15) * 4;
    f32x4 ns = (f32x4){1.f, 1.f, 1.f, 1.f}; if (nscale) ns = *(const GAS f32x4*)(nscale + n0 + n4);
    f32x4 v[16];
#pragma unroll
    for (int i = 0; i < 16; ++i) { const int k = 8 * (i >> 1) + 2 * kq + (i & 1); v[i] = *(const GAS f32x4*)(W + (size_t)(k0 + k) * N + n0 + n4); }
    if (kgain) {
#pragma unroll
        for (int i = 0; i < 16; ++i) { const int k = 8 * (i >> 1) + 2 * kq + (i & 1); v[i] = v[i] * kgain[k0 + k]; }
    }
#pragma unroll
    for (int ip = 0; ip < 8; ++ip) { const f32x4 e = v[2 * ip] * ns, o = v[2 * ip + 1] * ns;
#pragma unroll
        for (int c = 0; c < 4; ++c) scr[(n4 + c) * 33 + 4 * ip + kq] = pk2(e[c], o[c]); }
    LDS_WAIT(); asm volatile("" ::: "memory");
    const int kc = lane & 7;
#pragma unroll
    for (int jj = 0; jj < 8; ++jj) { const int n = (lane >> 3) + 8 * jj; const LAS unsigned* sp = scr + n * 33 + 4 * kc;
        v4u o; o.x = sp[0]; o.y = sp[1]; o.z = sp[2]; o.w = sp[3];
        *(GAS v4u*)(WT + (size_t)p0_map_row(mode, sel, row_off, n0 + n) * K + k0 + 8 * kc) = o; }
    LDS_WAIT(); asm volatile("" ::: "memory");
}

struct Args { const float* in[13]; float* out; unsigned char* ws; int ph_lo, ph_hi; };

__device__ __forceinline__ void sincos_acc(float angf, float& c, float& s) {
    const double x = (double)angf; const double k = __builtin_rint(x * 0.15915494309189535);
    double y = (x - k * 6.283185307179586) * 0.25;
    const double y2 = y * y;
    double sn = y * (1.0 + y2 * (-1.0 / 6 + y2 * (1.0 / 120 + y2 * (-1.0 / 5040 + y2 * (1.0 / 362880 + y2 * (-1.0 / 39916800 + y2 * (1.0 / 6227020800.0)))))));
    double cs = 1.0 + y2 * (-0.5 + y2 * (1.0 / 24 + y2 * (-1.0 / 720 + y2 * (1.0 / 40320 + y2 * (-1.0 / 3628800 + y2 * (1.0 / 479001600.0 + y2 * (-1.0 / 87178291200.0)))))));
#pragma unroll
    for (int i = 0; i < 2; ++i) { const double s2 = 2.0 * sn * cs, c2 = 1.0 - 2.0 * sn * sn; sn = s2; cs = c2; }
    c = (float)cs; s = (float)sn;
}

template <int GI>
__device__ __forceinline__ void pool_group(f32x4 (&cur)[16], f32x4 (&prev)[16], f32x4& S2, f32x4& S4, f32x4& S8, f32x4& S16, const f32x4 gv, const float* x, bf16* hp,
                                           int R0, bool bstart, int c4, int hl, int lane, int wq, LAS float* part, LAS float* rs) {
    const bool zero = (GI == 0) && bstart;
#pragma unroll
    for (int j = 0; j < 16; ++j) { const f32x4 v = cur[j]; part[j * 256 + hl] = (v[0] * v[0] + v[1] * v[1]) + (v[2] * v[2] + v[3] * v[3]); }
    LDS_WAIT(); __syncthreads();
#pragma unroll
    for (int q = 0; q < 4; ++q) { const int j = 4 * wq + q; const f32x4 p = *(const LAS f32x4*)(part + j * 256 + 4 * lane);
        const float s = wave_sum((p[0] + p[1]) + (p[2] + p[3])); if (lane == 0) rs[j] = zero ? 0.f : rsqrtf(s * (1.0f / D) + 1e-6f); }
    LDS_WAIT(); __syncthreads();
#pragma unroll
    for (int j = 0; j < 16; ++j) {
        const int row = R0 - 16 + GI * 16 + j;
        const f32x4 hv = cur[j] * rs[j] * gv;
        const f32x4 h2 = j >= 2 ? cur[j >= 2 ? j - 2 : 0] : prev[(j + 14) & 15], h4 = j >= 4 ? cur[j >= 4 ? j - 4 : 0] : prev[(j + 12) & 15], h8 = j >= 8 ? cur[j >= 8 ? j - 8 : 0] : prev[(j + 8) & 15];
        S2 = S2 + hv - h2; S4 = S4 + hv - h4; S8 = S8 + hv - h8; S16 = S16 + hv - prev[j];
        cur[j] = hv;
        if (GI < 2) prev[j] = *(const GAS f32x4*)(x + (size_t)(row + 16) * D + 4 * c4);
        if (GI > 0) {
            const int t = row & (SEQ - 1);
            const float i2 = t >= 1 ? 0.5f : 1.0f, i4 = t >= 3 ? 0.25f : 1.0f / (float)(t + 1), i8 = t >= 7 ? 0.125f : 1.0f / (float)(t + 1), i16 = t >= 15 ? 0.0625f : 1.0f / (float)(t + 1);
            const f32x4 o2 = S2 * i2 - hv, o4 = S4 * i4 - hv, o8 = S8 * i8 - hv, o16 = S16 * i16 - hv;
            const size_t off = (size_t)row * D + 4 * c4;
            *(GAS v2u*)(hp + off) = (v2u){pk2(o2[0], o2[1]), pk2(o2[2], o2[3])};
            *(GAS v2u*)(hp + (size_t)M * D + off) = (v2u){pk2(o4[0], o4[1]), pk2(o4[2], o4[3])};
            *(GAS v2u*)(hp + 2 * (size_t)M * D + off) = (v2u){pk2(o8[0], o8[1]), pk2(o8[2], o8[3])};
            *(GAS v2u*)(hp + 3 * (size_t)M * D + off) = (v2u){pk2(o16[0], o16[1]), pk2(o16[2], o16[3])};
        }
    }
}

constexpr int I_SQ = 16 * 16, I_GU = 16 * 44, I_DN = 44 * 16, I_QKV = 16 * 48, I_W2 = 4 * 32 * 8;
constexpr int W_EARLY = I_W2 + I_SQ + 2 * I_GU, W_ITEMS = W_EARLY + I_DN + I_QKV + I_SQ + 2 * I_GU + I_DN;
__device__ __forceinline__ void w2_item(const Args& a, int it, int lane) {
    typedef float f32x16 __attribute__((ext_vector_type(16)));
    const int g = it >> 8, r = it & 255, n0 = (r >> 3) * 32, c0 = (r & 7) * 32, i = lane & 31, h = lane >> 5;
    const float* wout = a.in[7] + (size_t)(g * 256) * 1024 + n0 + i;
    const float* wgr = a.in[5] + (size_t)g * 65536 + (size_t)(c0 + i) * 256;
    const float* sc = a.in[6] + g * 256;
    f32x16 acc = {0.f, 0.f, 0.f, 0.f, 0.f, 0.f, 0.f, 0.f, 0.f, 0.f, 0.f, 0.f, 0.f, 0.f, 0.f, 0.f};
#pragma unroll 4
    for (int jq = 0; jq < 64; ++jq) {
        const f32x4 bq = *(const GAS f32x4*)(wgr + 4 * jq), sq = *(const GAS f32x4*)(sc + 4 * jq);
        const float a0 = wout[(size_t)(4 * jq + h) * 1024], a1 = wout[(size_t)(4 * jq + 2 + h) * 1024];
        const float b0 = h ? bq[1] * sq[1] : bq[0] * sq[0], b1 = h ? bq[3] * sq[3] : bq[2] * sq[2];
        acc = __builtin_amdgcn_mfma_f32_32x32x2f32(a0, b0, acc, 0, 0, 0);
        acc = __builtin_amdgcn_mfma_f32_32x32x2f32(a1, b1, acc, 0, 0, 0);
    }
    bf16* W2T = (bf16*)(a.ws + WS_WPO) + (size_t)n0 * 1024 + g * 256 + c0 + i;
#pragma unroll
    for (int rr = 0; rr < 16; ++rr) W2T[(size_t)((rr & 3) + 8 * (rr >> 2) + 4 * h) * 1024] = (bf16)f2bf(acc[rr]);
}
__device__ __forceinline__ void weight_item(const Args& a, int it, LAS unsigned* scr, int lane) {
    unsigned char* ws = a.ws; const float* norm_mix = a.in[1]; const float* norm_ffn = a.in[2];
    int r = it;
    if (r < I_W2) { w2_item(a, r, lane); return; } r -= I_W2;
    if (r < I_SQ) { p0_tr_item(a.in[4], D, D, (bf16*)(ws + WS_WIN), 0, 0, 0, nullptr, nullptr, scr, r, lane); return; } r -= I_SQ;
    if (r < I_GU) { p0_tr_item(a.in[10], D, FF, (bf16*)(ws + WS_WGU0), 1, 0, 0, norm_ffn, nullptr, scr, r, lane); return; } r -= I_GU;
    if (r < I_GU) { p0_tr_item(a.in[11], D, FF, (bf16*)(ws + WS_WGU0), 1, 1, 0, norm_ffn, nullptr, scr, r, lane); return; } r -= I_GU;
    if (r < I_DN) { p0_tr_item(a.in[12], FF, D, (bf16*)(ws + WS_WD0), 0, 0, 0, nullptr, nullptr, scr, r, lane); return; } r -= I_DN;
    if (r < I_QKV) { p0_tr_item(a.in[8], D, 3 * D, (bf16*)(ws + WS_WQKV), 2, 0, 0, norm_mix + D, nullptr, scr, r, lane); return; } r -= I_QKV;
    if (r < I_SQ) { p0_tr_item(a.in[9], D, D, (bf16*)(ws + WS_WAO), 0, 0, 0, nullptr, nullptr, scr, r, lane); return; } r -= I_SQ;
    if (r < I_GU) { p0_tr_item(a.in[10] + (size_t)D * FF, D, FF, (bf16*)(ws + WS_WGU1), 1, 0, 0, norm_ffn + D, nullptr, scr, r, lane); return; } r -= I_GU;
    if (r < I_GU) { p0_tr_item(a.in[11] + (size_t)D * FF, D, FF, (bf16*)(ws + WS_WGU1), 1, 1, 0, norm_ffn + D, nullptr, scr, r, lane); return; } r -= I_GU;
    p0_tr_item(a.in[12] + (size_t)D * FF, FF, D, (bf16*)(ws + WS_WD1), 0, 0, 0, nullptr, nullptr, scr, r, lane);
}
__device__ __forceinline__ void rope_entries(unsigned char* ws, int first, int stride) {
    float* rope = (float*)(ws + WS_ROPE);
    for (int e = first; e < SEQ * 32; e += stride) {
        const int t = e >> 5, j = e & 31;
        const float invf = (float)(1.0 / (double)(float)exp2(13.287712379549449 * (double)j / 32.0));
        const float ang = (float)t * invf; float c, s; sincos_acc(ang, c, s);
        rope[(size_t)t * 64 + j] = c; rope[(size_t)t * 64 + 32 + j] = s;
    }
}
__device__ __forceinline__ void late_prep(const Args& a0, LAS unsigned char* lds, int widx, int nidle) {
    Args a = a0;
#pragma unroll
    for (int i = 0; i < 13; ++i) asm volatile("" : "+s"(a.in[i]));
    asm volatile("" : "+s"(a.ws));
    int tid = threadIdx.x; asm volatile("" : "+v"(tid)); const int lane = tid & 63, wave = __builtin_amdgcn_readfirstlane(tid >> 6);
    LAS unsigned* scr = (LAS unsigned*)(lds + wave * 16384);
    for (int it = W_EARLY + widx * NWAVES + wave; it < W_ITEMS; it += nidle * NWAVES) weight_item(a, it, scr, lane);
}

__device__ __forceinline__ void p0_prologue(const Frame& F0, const Args& a, bool defer_late) {
    Frame F = F0; { int tid = threadIdx.x; asm volatile("" : "+v"(tid)); F.tid = tid; F.lane = tid & 63; F.wave = __builtin_amdgcn_readfirstlane(tid >> 6); }
    unsigned char* ws = a.ws;
    LAS unsigned* scr = (LAS unsigned*)(F.lds + F.wave * 16384);
    const int gw = F.vcu * NWAVES + F.wave, NGW = F.G * NWAVES;
    const float* norm_mix = a.in[1];
    const int n_items = defer_late ? W_EARLY : W_ITEMS;
    for (int it = gw; it < n_items; it += NGW) weight_item(a, it, scr, F.lane);
    rope_entries(ws, F.vcu * NWAVES * 64 + F.tid, F.G * NWAVES * 64);
    __syncthreads();
    {
        const float* x = a.in[0]; const float* g0 = norm_mix;
        bf16* hp = (bf16*)(ws + WS_BIG);
        const int half = F.tid >> 8, c4 = F.tid & 255, hl = c4, wq = F.wave & 3;
        LAS float* part = (LAS float*)(F.lds) + half * (16 * 256);
        LAS float* rs = (LAS float*)(F.lds + 32768) + half * 16;
        const f32x4 gv = *(const GAS f32x4*)(g0 + 4 * c4);
        for (int blk = F.vcu; blk < M / 64; blk += F.G) {
            const int R0 = blk * 64 + half * 32;
            const bool bstart = (R0 & (SEQ - 1)) == 0;
            f32x4 A[16], B[16];
#pragma unroll
            for (int j = 0; j < 16; ++j) { B[j] = (f32x4){0.f, 0.f, 0.f, 0.f}; A[j] = B[j]; if (!bstart) A[j] = *(const GAS f32x4*)(x + (size_t)(R0 - 16 + j) * D + 4 * c4); }
            f32x4 S2 = B[0], S4 = B[0], S8 = B[0], S16 = B[0];
            pool_group<0>(A, B, S2, S4, S8, S16, gv, x, hp, R0, bstart, c4, hl, F.lane, wq, part, rs);
            pool_group<1>(B, A, S2, S4, S8, S16, gv, x, hp, R0, bstart, c4, hl, F.lane, wq, part, rs);
            pool_group<2>(A, B, S2, S4, S8, S16, gv, x, hp, R0, bstart, c4, hl, F.lane, wq, part, rs);
            __syncthreads();
        }
    }
}

namespace att {
typedef short bf16x8 __attribute__((ext_vector_type(8)));
typedef short s16x4 __attribute__((ext_vector_type(4)));
typedef float f32x16 __attribute__((ext_vector_type(16)));
typedef unsigned u32x4 __attribute__((ext_vector_type(4)));
constexpr int KCH = 6160;
constexpr int LDS_K = 0, LDS_V = 8 * KCH, VDH = 24 * 1024 + 64, LDS_OST = LDS_V + 2 * VDH, LDS_TOTAL = LDS_OST + 8 * 4096;
static_assert(LDS_TOTAL <= LDS_BYTES, "attention LDS");
__device__ __forceinline__ int crow(int r, int hi) { return (r & 3) + 8 * (r >> 2) + 4 * hi; }
__device__ __forceinline__ s16x4 vtr(const LAS unsigned char* p) { return __builtin_bit_cast(s16x4, __builtin_amdgcn_ds_read_tr16_b64_v4i16((LAS s16x4*)p)); }
struct KVQ { u32x4 k[6], v[6]; bf16x8 q[4]; };
__device__ __forceinline__ void attn_load(int item, const bf16* Qp, const bf16* Kp, const bf16* Vp, KVQ& R, int tid, int wid, int r32, int hi) {
    const int bh = item >> 5, j = item & 31, h = bh & 15;
    const int dsh = h < 6 ? 0 : (h < 11 ? 2 : 4);
    const bool first = (j & ((32 >> dsh) - 1)) == 0;
    const size_t hb = (size_t)bh * (SEQ * 64);
    const int pos0 = j * 256;
#pragma unroll
    for (int it = 0; it < 6; ++it) {
        const int p = tid + 512 * it, key = p >> 3, c = p & 7;
        const int keyc = (first && key < 128) ? 128 : key;
        const size_t go = hb + (size_t)(pos0 - 128 + keyc) * 64 + c * 8; R.k[it] = *(const GAS u32x4*)(Kp + go); R.v[it] = *(const GAS u32x4*)(Vp + go);
    }
#pragma unroll
    for (int d0 = 0; d0 < 4; ++d0) R.q[d0] = *(const GAS bf16x8*)(Qp + hb + (size_t)(pos0 + 32 * wid + r32) * 64 + d0 * 16 + hi * 8);
}
__device__ __forceinline__ void attn_phase(int item0, int nitems, const bf16* Qp, const bf16* Kp, const bf16* Vp, bf16* O, float* lse, LAS unsigned char* shm) {
    int tid = threadIdx.x; asm volatile("" : "+v"(tid));
    const int wid = __builtin_amdgcn_readfirstlane(tid >> 6);
    KVQ R;
    if (nitems > 0) attn_load(item0, Qp, Kp, Vp, R, tid, wid, tid & 31, (tid & 63) >> 5);
#pragma unroll 1
  for (int ii = 0; ii < nitems; ++ii) {
    asm volatile("" : "+v"(tid));
    const int lane = tid & 63, r32 = lane & 31, hi = lane >> 5;
    const int item = item0 + ii, bh = item >> 5, j = item & 31;
    const int b = bh >> 4, h = bh & 15;
    const int dsh = h < 6 ? 0 : (h < 11 ? 2 : 4);
    const int nqb = 32 >> dsh, r = j >> (5 - dsh), qb = j & (nqb - 1);
    const bool first = (qb == 0);
#pragma unroll
    for (int it = 0; it < 6; ++it) {
        const int p = tid + 512 * it, key = p >> 3, c = p & 7;
        const bool dead = first && key < 128; const u32x4 z4 = (u32x4){0u, 0u, 0u, 0u};
        *(LAS u32x4*)(shm + LDS_K + c * KCH + key * 16) = dead ? z4 : R.k[it];
        *(LAS u32x4*)(shm + LDS_V + (c >> 2) * VDH + (key >> 4) * 1024 + (key & 15) * 64 + (c & 3) * 16) = dead ? z4 : R.v[it];
    }
    bf16x8 qr[4];
#pragma unroll
    for (int d0 = 0; d0 < 4; ++d0) qr[d0] = R.q[d0];
    LDS_WAIT(); __syncthreads();
    if (ii + 1 < nitems) attn_load(item + 1, Qp, Kp, Vp, R, tid, wid, r32, hi);
    f32x16 P[5];
    const LAS unsigned char* kbase = shm + LDS_K + hi * KCH + (32 * wid + r32) * 16;
#pragma unroll
    for (int kt = 0; kt < 5; ++kt) {
        f32x16 acc = {0.f, 0.f, 0.f, 0.f, 0.f, 0.f, 0.f, 0.f, 0.f, 0.f, 0.f, 0.f, 0.f, 0.f, 0.f, 0.f};
#pragma unroll
        for (int d0 = 0; d0 < 4; ++d0) { const bf16x8 kf = *(const LAS bf16x8*)(kbase + (2 * d0) * KCH + kt * 512); acc = __builtin_amdgcn_mfma_f32_32x32x16_bf16(kf, qr[d0], acc, 0, 0, 0); }
        P[kt] = acc;
    }
    const float NEG = -INFINITY;
    const int lowlim = first ? (128 - 32 * wid) : 0;
    const int lo0 = r32 > lowlim ? r32 : lowlim;
#pragma unroll
    for (int rr = 0; rr < 16; ++rr) { const int cr = crow(rr, hi); if (cr < lo0) P[0][rr] = NEG; if (cr > r32) P[4][rr] = NEG; }
    if (first) {
#pragma unroll
        for (int kt = 1; kt < 4; ++kt)
#pragma unroll
            for (int rr = 0; rr < 16; ++rr) if (32 * kt + crow(rr, hi) < lowlim) P[kt][rr] = NEG;
    }
    float mx = NEG;
#pragma unroll
    for (int kt = 0; kt < 5; ++kt)
#pragma unroll
        for (int rr = 0; rr < 16; ++rr) mx = fmaxf(mx, P[kt][rr]);
    mx = fmaxf(mx, __shfl_xor(mx, 32));
    float l = 0.f;
#pragma unroll
    for (int kt = 0; kt < 5; ++kt)
#pragma unroll
        for (int rr = 0; rr < 16; ++rr) { const float e = __builtin_amdgcn_exp2f(P[kt][rr] - mx); P[kt][rr] = e; l += e; }
    l += __shfl_xor(l, 32);
    const float inv = __builtin_amdgcn_rcpf(l);
    {
        const int i = qb * 256 + 32 * wid + r32, t = (i << dsh) + r;
        if (hi == 0) lse[((size_t)b * SEQ + t) * 16 + h] = (mx + __log2f(l)) * 0.6931471805599453f;
    }
    f32x16 o[2];
    o[0] = (f32x16){0.f, 0.f, 0.f, 0.f, 0.f, 0.f, 0.f, 0.f, 0.f, 0.f, 0.f, 0.f, 0.f, 0.f, 0.f, 0.f}; o[1] = o[0];
    const LAS unsigned char* vb = shm + LDS_V + ((lane >> 4) & 1) * 32 + (lane & 3) * 8 + (4 * hi + ((lane & 15) >> 2)) * 64;
#pragma unroll
    for (int kt = 0; kt < 5; ++kt)
#pragma unroll
        for (int s = 0; s < 2; ++s) {
            u32x4 pw;
            pw.x = pg8::cvt_pk_bf16(P[kt][8 * s + 0] * inv, P[kt][8 * s + 1] * inv); pw.y = pg8::cvt_pk_bf16(P[kt][8 * s + 2] * inv, P[kt][8 * s + 3] * inv);
            pw.z = pg8::cvt_pk_bf16(P[kt][8 * s + 4] * inv, P[kt][8 * s + 5] * inv); pw.w = pg8::cvt_pk_bf16(P[kt][8 * s + 6] * inv, P[kt][8 * s + 7] * inv);
            const bf16x8 pa = __builtin_bit_cast(bf16x8, pw);
            const int kblk = 2 * wid + 2 * kt + s;
#pragma unroll
            for (int dh = 0; dh < 2; ++dh) {
                const s16x4 vlo = vtr(vb + dh * VDH + kblk * 1024), vhi = vtr(vb + dh * VDH + kblk * 1024 + 512);
                const bf16x8 vf = (bf16x8){vlo[0], vlo[1], vlo[2], vlo[3], vhi[0], vhi[1], vhi[2], vhi[3]};
                o[dh] = __builtin_amdgcn_mfma_f32_32x32x16_bf16(pa, vf, o[dh], 0, 0, 0);
            }
        }
    {
        LAS bf16* stg = (LAS bf16*)(shm + LDS_OST + wid * 4096);
#pragma unroll
        for (int rr = 0; rr < 16; ++rr) { const int orow = crow(rr, hi);
#pragma unroll
            for (int dh = 0; dh < 2; ++dh) stg[orow * 64 + dh * 32 + r32] = (bf16)f2bf(o[dh][rr]); }
        LDS_WAIT(); asm volatile("" ::: "memory");
#pragma unroll
        for (int i4 = 0; i4 < 4; ++i4) { const int row = i4 * 8 + (lane >> 3), ch = lane & 7; const u32x4 v = *(const LAS u32x4*)(stg + row * 64 + ch * 8);
            const int i = qb * 256 + 32 * wid + row, t = (i << dsh) + r;
            *(GAS u32x4*)(O + ((size_t)b * SEQ + t) * D + h * 64 + ch * 8) = v; }
    }
    LDS_WAIT(); __syncthreads();
  }
}
}

__global__ void __launch_bounds__(NWAVES * 64, 2) fwd_megakernel(Args args) {
    extern __shared__ __attribute__((aligned(16))) unsigned char lds[];
    Frame F;
    F.lds = (LAS unsigned char*)lds;
    F.tid = threadIdx.x; F.lane = F.tid & 63; F.wave = __builtin_amdgcn_readfirstlane(F.tid >> 6);
    F.G = gridDim.x; { const int bx = blockIdx.x; F.vcu = (F.G % 8 == 0) ? (bx % 8) * (F.G / 8) + bx / 8 : bx; }
    unsigned char* ws = args.ws;
    const int lo = args.ph_lo, hi = args.ph_hi;
    const bool one_launch = (hi - lo) > 1;
    volatile LAS unsigned* bst = (volatile LAS unsigned*)(F.lds + 131072 + 1024);
    if (F.tid < 2) bst[F.tid] = 0u;
    __syncthreads();
    XcdBarrier bar; bar.bar = (unsigned*)(ws + WS_CTL) + CW_BAR; bar.x = 0; bar.st = bst;
    if (one_launch) bar = xcd_barrier_post((unsigned*)(ws + WS_CTL) + CW_BAR, bst);
#define IN(k) (lo <= (k) && (k) < hi)
#define SEAM(k) do { if (IN(k) && IN((k) + 1)) { xcd_barrier(bar); } } while (0)

    if (lo < 0) cg::this_grid().sync();
    float* resid = args.out;
    float* ssb = (float*)(ws + WS_SS);
    bf16* xb = (bf16*)(ws + WS_XB);
    bf16* zo = (bf16*)(ws + WS_ZO);
    bf16* big = (bf16*)(ws + WS_BIG);

    bool fused_done = false;
    const bool defer_late = one_launch && IN(0) && IN(4) && (F.G == 256);
    if (IN(0)) { p0_prologue(F, args, defer_late); }
    SEAM(0);
    if (IN(1)) {
        pg8::Gemm g{big, (const bf16*)(ws + WS_WIN), M, D, D, D, D, (size_t)M * D * 2};
        pg8::StaticOrder S; S.init(M, D, F.G, (int)blockIdx.x);
        pg8::EpiBf16 E{zo, D};
        pg8::gemm_phase<pg8::EpiBf16, pg8::StaticOrder, true>(F.lds, g, S, E);
    }
    SEAM(1);
    if (IN(3)) {
        pg8::Gemm g{zo, (const bf16*)(ws + WS_WPO), M, D, D, D, D, 0};
        pg8::StaticOrder S; S.init(M, D, F.G, (int)blockIdx.x);
        pg8::EpiRes<true> E{args.in[0], xb, ssb, nullptr};
        pg8::gemm_phase<pg8::EpiRes<true>, pg8::StaticOrder, true>(F.lds, g, S, E);
    }
    SEAM(3);
#pragma unroll 1
    for (int layer = 0; layer < 2; ++layer) {
        const int pb = layer == 0 ? 4 : 10;
        if (IN(pb)) {
            pg8::Gemm g{xb, (const bf16*)(ws + (layer == 0 ? WS_WGU0 : WS_WGU1)), M, 2 * FF, D, D, D, 0};
            pg8::StaticOrder S; S.init(M, 2 * FF, F.G, (int)blockIdx.x);
            pg8::Unit u0; const pg8::RsTab rt = fill_rstd_tab(F.lds, ssb, S.next(0, u0) ? u0.pm : 0);
            pg8::EpiSwiGLU E{big, ssb, FF, rt};
            pg8::gemm_phase<pg8::EpiSwiGLU, pg8::StaticOrder, true>(F.lds, g, S, E);
            if (layer == 0 && defer_late && (int)blockIdx.x >= 128) late_prep(args, F.lds, (int)blockIdx.x - 128, 128);
        }
        SEAM(pb);
#ifndef FUSE_FINAL
#define FUSE_FINAL 1
#endif
        const bool fuse_final = FUSE_FINAL && (layer == 1) && one_launch && IN(12) && (F.G == (M / 256) * (D / 256));
        if (IN(pb + 1)) {
            pg8::Gemm g{big, (const bf16*)(ws + (layer == 0 ? WS_WD0 : WS_WD1)), M, D, FF, FF, FF, 0};
            pg8::StaticOrder S; S.init(M, D, F.G, (int)blockIdx.x);
            if (fuse_final) { EpiFinal E{xb, resid, ssb, args.in[3], bar}; pg8::gemm_phase<EpiFinal, pg8::StaticOrder, true>(F.lds, g, S, E); }
            else { pg8::EpiRes<false> E{nullptr, xb, ssb, nullptr}; pg8::gemm_phase<pg8::EpiRes<false>, pg8::StaticOrder, true>(F.lds, g, S, E); }
        }
        if (fuse_final) { fused_done = true; break; }
        SEAM(pb + 1);
        if (layer == 0) {
            bf16* qb_ = big; bf16* kb_ = big + (size_t)M * D; bf16* vb_ = big + 2 * (size_t)M * D;
            if (IN(6)) {
                pg8::Gemm g{xb, (const bf16*)(ws + WS_WQKV), M, 3 * D, D, D, D, 0};
                pg8::StaticOrder S; S.init(M, 3 * D, F.G, (int)blockIdx.x);
                pg8::Unit u0; const pg8::RsTab rt = fill_rstd_tab(F.lds, ssb, S.next(0, u0) ? u0.pm : 0);
                pg8::EpiQKV E{qb_, ssb, (const float*)(ws + WS_ROPE), rt};
                pg8::gemm_phase<pg8::EpiQKV, pg8::StaticOrder, true>(F.lds, g, S, E);
            }
            SEAM(6);
            if (IN(7)) {
                const int ipw = (1024 + F.G - 1) / F.G;
                const int it0 = F.vcu * ipw, nit = it0 >= 1024 ? 0 : (1024 - it0 < ipw ? 1024 - it0 : ipw);
                att::attn_phase(it0, nit, qb_, kb_, vb_, zo, (float*)(ws + WS_LSE), F.lds);
            }
            SEAM(7);
            const bool merge_fused = one_launch && IN(8) && IN(9) && (F.G == (M / 256) * (D / 256));
            if (IN(8) && !merge_fused) {
                int tid8 = threadIdx.x; asm volatile("" : "+v"(tid8)); const int lane8 = tid8 & 63, wave8 = __builtin_amdgcn_readfirstlane(tid8 >> 6);
                const float* lse = (const float*)(ws + WS_LSE);
                for (int m = F.vcu * NWAVES + wave8; m < M; m += F.G * NWAVES) {
                    float L[16];
#pragma unroll
                    for (int q4 = 0; q4 < 4; ++q4) { const f32x4 v = *(const GAS f32x4*)(lse + (size_t)m * 16 + 4 * q4); L[4 * q4] = v[0]; L[4 * q4 + 1] = v[1]; L[4 * q4 + 2] = v[2]; L[4 * q4 + 3] = v[3]; }
                    float lg[3];
                    { float mx = L[0];
_Pragma("unroll") for (int i = 1; i < 6; ++i) mx = fmaxf(mx, L[i]); float s = 0.f;
_Pragma("unroll") for (int i = 0; i < 6; ++i) s += __expf(L[i] - mx); lg[0] = mx + __logf(s) - 1.791759469228055f; }
                    { float mx = L[6];
_Pragma("unroll") for (int i = 7; i < 11; ++i) mx = fmaxf(mx, L[i]); float s = 0.f;
_Pragma("unroll") for (int i = 6; i < 11; ++i) s += __expf(L[i] - mx); lg[1] = mx + __logf(s) - 1.6094379124341003f; }
                    { float mx = L[11];
_Pragma("unroll") for (int i = 12; i < 16; ++i) mx = fmaxf(mx, L[i]); float s = 0.f;
_Pragma("unroll") for (int i = 11; i < 16; ++i) s += __expf(L[i] - mx); lg[2] = mx + __logf(s) - 1.6094379124341003f; }
                    const float mx = fmaxf(lg[0], fmaxf(lg[1], lg[2]));
                    const float e0 = __expf(lg[0] - mx), e1 = __expf(lg[1] - mx), e2 = __expf(lg[2] - mx); const float is = 3.0f / (e0 + e1 + e2);
                    const int head = lane8 >> 2; const float sc = (head < 6 ? e0 : (head < 11 ? e1 : e2)) * is;
                    GAS v4u* p = (GAS v4u*)(zo + (size_t)m * D + 16 * lane8);
#pragma unroll
                    for (int q2 = 0; q2 < 2; ++q2) { v4u w = p[q2];
                        w.x = pk2(bflo(w.x) * sc, bfhi(w.x) * sc); w.y = pk2(bflo(w.y) * sc, bfhi(w.y) * sc); w.z = pk2(bflo(w.z) * sc, bfhi(w.z) * sc); w.w = pk2(bflo(w.w) * sc, bfhi(w.w) * sc);
                        p[q2] = w; }
                }
            }
            if (!merge_fused) SEAM(8);
            if (IN(9)) {
                pg8::Gemm g{zo, (const bf16*)(ws + WS_WAO), M, D, D, D, D, 0};
                pg8::StaticOrder S; S.init(M, D, F.G, (int)blockIdx.x);
                if (merge_fused) { pg8::Unit u0; const LAS float* st = seg_fill(F.lds, (const float*)(ws + WS_LSE), S.next(0, u0) ? u0.pm : 0);
                    pg8::EpiRes<false, true> E{nullptr, xb, ssb, st + 512};
                    pg8::gemm_phase<pg8::EpiRes<false, true>, pg8::StaticOrder, true, true>(F.lds, g, S, E, st); }
                else { pg8::EpiRes<false> E{nullptr, xb, ssb, nullptr};
                    pg8::gemm_phase<pg8::EpiRes<false>, pg8::StaticOrder, true>(F.lds, g, S, E); }
            }
            SEAM(9);
        }
    }
    if (IN(12) && !fused_done) {
        const float* gf = args.in[3];
        int tid12 = threadIdx.x; asm volatile("" : "+v"(tid12)); const int lane12 = tid12 & 63, wave12 = __builtin_amdgcn_readfirstlane(tid12 >> 6);
        for (int m = F.vcu * NWAVES + wave12; m < M; m += F.G * NWAVES) {
            float s = 0.f;
#pragma unroll
            for (int q4 = 0; q4 < 4; ++q4) { const f32x4 v = *(const GAS f32x4*)(ssb + (size_t)m * 16 + 4 * q4); s += (v[0] + v[1]) + (v[2] + v[3]); }
            const float rstd = rsqrtf(s * (1.0f / D) + 1e-6f);
            const GAS v4u* xr = (const GAS v4u*)(xb + (size_t)m * D + 16 * lane12);
            GAS f32x4* orow = (GAS f32x4*)(resid + (size_t)m * D + 16 * lane12);
#pragma unroll
            for (int q2 = 0; q2 < 2; ++q2) { const v4u w = xr[q2]; const GAS f32x4* gq = (const GAS f32x4*)(gf + 16 * lane12 + 8 * q2);
                orow[2 * q2] = (f32x4){bflo(w.x), bfhi(w.x), bflo(w.y), bfhi(w.y)} * rstd * gq[0];
                orow[2 * q2 + 1] = (f32x4){bflo(w.z), bfhi(w.z), bflo(w.w), bfhi(w.w)} * rstd * gq[1]; }
        }
    }
#undef IN
#undef SEAM
}

extern "C" void kernel_launch(void* const* d_in, const int* in_sizes, int n_in, void* d_out, int out_size, void* d_ws, size_t ws_size, hipStream_t stream) {
    static int grid = 0;
    if (grid == 0) {
        if (n_in != 13 || in_sizes[0] != M * D || out_size != M * D || ws_size < WS_END) { fprintf(stderr, "kernel_launch: unexpected shapes (n_in %d, in0 %d, out %d, ws %zu); nothing launched\n", n_in, n_in > 0 ? in_sizes[0] : -1, out_size, ws_size); grid = -1; return; }
        int dev = 0, cus = 0, per_cu = 0;
        if (hipGetDevice(&dev) != hipSuccess || hipDeviceGetAttribute(&cus, hipDeviceAttributeMultiprocessorCount, dev) != hipSuccess) { grid = -1; return; }
        if (hipFuncSetAttribute((const void*)fwd_megakernel, hipFuncAttributeMaxDynamicSharedMemorySize, LDS_BYTES) != hipSuccess) { fprintf(stderr, "kernel_launch: hipFuncSetAttribute failed\n"); grid = -1; return; }
        if (hipOccupancyMaxActiveBlocksPerMultiprocessor(&per_cu, (const void*)fwd_megakernel, NWAVES * 64, LDS_BYTES) != hipSuccess || per_cu < 1) { fprintf(stderr, "kernel_launch: occupancy query says %d blocks per CU\n", per_cu); per_cu = 1; }
        (void)hipGetLastError();
        grid = cus;
    }
    if (grid < 0) return;
    if (hipMemsetAsync((char*)d_ws + WS_CTL, 0, CTL_ZERO_BYTES, stream) != hipSuccess) { fprintf(stderr, "kernel_launch: memset failed\n"); return; }
    Args a{};
    for (int i = 0; i < 13; ++i) a.in[i] = (const float*)d_in[i];
    a.out = (float*)d_out; a.ws = (unsigned char*)d_ws;
#if MK_N_LAUNCHES == 1
    a.ph_lo = 0; a.ph_hi = 13;
    void* kargs[] = {&a};
    hipError_t e = hipLaunchCooperativeKernel((const void*)fwd_megakernel, dim3(grid), dim3(NWAVES * 64), kargs, LDS_BYTES, stream);
    if (e != hipSuccess) fprintf(stderr, "kernel_launch: cooperative launch failed: %s (grid %d)\n", hipGetErrorString(e), grid);
#else
    for (int p = 0; p < 13; ++p) { a.ph_lo = p; a.ph_hi = p + 1; hipLaunchKernelGGL(fwd_megakernel, dim3(grid), dim3(NWAVES * 64), LDS_BYTES, stream, a); }
#endif
}
```

```cpp
#include <hip/hip_runtime.h>
#include <hip/hip_cooperative_groups.h>
#include <cstdio>
#include <cstdint>
namespace cg = cooperative_groups;

#ifndef MK_N_LAUNCHES
#define MK_N_LAUNCHES 1
#endif

namespace pg8 {
#define PG8_LAS __attribute__((address_space(3)))
typedef unsigned short bf16_t;
typedef short bf16x8 __attribute__((ext_vector_type(8)));
typedef float f32x4 __attribute__((ext_vector_type(4)));
typedef unsigned u32x4 __attribute__((ext_vector_type(4)));
constexpr int BM = 256, BK = 64, HALF = 128, HTB = HALF * BK * 2, STAGE_BYTES = 8 * HTB, NXCD = 8, WGM = 8;

__host__ __device__ __forceinline__ int lds_byte(int r, int c) { const int st = (r >> 4) * 2 + (c >> 5), rr = r & 15, cc = c & 31, ob = rr * 64 + cc * 2; return st * 1024 + (ob ^ (((ob >> 9) & 1) << 5)); }
__host__ __device__ __forceinline__ void stage_rc(int b, int& R, int& C) { const int st = b / 1024, sb = b % 1024, swz = sb ^ (((sb >> 9) & 1) << 5); R = (st >> 1) * 16 + swz / 64; C = (st & 1) * 32 + (swz % 64) / 2; }
__host__ __device__ __forceinline__ int perm32(int rho) { const int n = rho >> 4, i = rho & 15; return 8 * (i >> 2) + 4 * n + (i & 3); }

struct Unit { int pm, pn; };
struct Gemm { const bf16_t* A; const bf16_t* Bt; int M, N, K, lda, ldb; size_t a_pn_bytes; };

struct StaticOrder {
    int nM, nN, nwg, G, c;
    __host__ __device__ void init(int M, int N, int G_, int c_) { nM = M / BM; nN = N / BM; nwg = nM * nN; G = G_; c = c_; }
    __host__ __device__ bool next(int i, Unit& u) const {
        const long L = (long)i * G + c; if (L >= nwg) return false;
        int wgid = (int)L; { const int q = nwg / NXCD, r = nwg % NXCD, xcd = wgid % NXCD, off = wgid / NXCD; wgid = (xcd < r ? xcd * (q + 1) : r * (q + 1) + (xcd - r) * q) + off; }
        const int nig = WGM * nN, gid = wgid / nig, fm = gid * WGM, gsz = (nM - fm) < WGM ? (nM - fm) : WGM;
        u.pm = fm + ((wgid % nig) % gsz); u.pn = (wgid % nig) / gsz; return true;
    }
};

__device__ __forceinline__ unsigned cvt_pk_bf16(float lo, float hi) { unsigned r; asm volatile("v_cvt_pk_bf16_f32 %0, %1, %2" : "=v"(r) : "v"(lo), "v"(hi)); return r; }

constexpr float RMS_EPS = 1e-6f;

struct EpiBf16 {
    bf16_t* O; int ldc;
    __device__ __forceinline__ void operator()(const f32x4 (&acc)[2][2][4][2], const Unit& u, int wr, int wc, int fr, int fq) const {
        const int row0 = u.pm * BM + wr * 64 + fr, col0 = u.pn * BM + wc * 32 + 8 * fq;
#pragma unroll
        for (int ai = 0; ai < 2; ++ai)
#pragma unroll
            for (int m = 0; m < 4; ++m) { bf16_t* rowp = O + (size_t)(row0 + ai * HALF + m * 16) * ldc + col0;
#pragma unroll
                for (int bj = 0; bj < 2; ++bj) { const f32x4 v0 = acc[ai][bj][m][0], v1 = acc[ai][bj][m][1];
                    u32x4 w; w.x = cvt_pk_bf16(v0[0], v0[1]); w.y = cvt_pk_bf16(v0[2], v0[3]); w.z = cvt_pk_bf16(v1[0], v1[1]); w.w = cvt_pk_bf16(v1[2], v1[3]);
                    *(u32x4*)(rowp + bj * HALF) = w; } }
    }
};
__device__ __forceinline__ float bf_lo(unsigned w) { return __builtin_bit_cast(float, w << 16); }
__device__ __forceinline__ float bf_hi(unsigned w) { return __builtin_bit_cast(float, w & 0xffff0000u); }
template <bool BASE_F32, bool SCALE = false> struct EpiRes {
    const float* basef; bf16_t* xb; float* ss; const PG8_LAS float* ctab;
    __device__ __forceinline__ void load_base(int row, int col0, f32x4 (&nb)[4]) const {
        if (BASE_F32) { const float* bp = basef + (size_t)row * 1024 + col0; nb[0] = *(const f32x4*)(bp); nb[1] = *(const f32x4*)(bp + 4); nb[2] = *(const f32x4*)(bp + HALF); nb[3] = *(const f32x4*)(bp + HALF + 4); }
        else { const bf16_t* bp = xb + (size_t)row * 1024 + col0; const u32x4 a = *(const u32x4*)(bp), c = *(const u32x4*)(bp + HALF);
            nb[0] = (f32x4){bf_lo(a.x), bf_hi(a.x), bf_lo(a.y), bf_hi(a.y)}; nb[1] = (f32x4){bf_lo(a.z), bf_hi(a.z), bf_lo(a.w), bf_hi(a.w)};
            nb[2] = (f32x4){bf_lo(c.x), bf_hi(c.x), bf_lo(c.y), bf_hi(c.y)}; nb[3] = (f32x4){bf_lo(c.z), bf_hi(c.z), bf_lo(c.w), bf_hi(c.w)}; }
    }
    __device__ __forceinline__ void operator()(const f32x4 (&acc)[2][2][4][2], const Unit& u, int wr, int wc, int fr, int fq) const {
        const int row0 = u.pm * BM + wr * 64 + fr, col0 = u.pn * BM + wc * 32 + 8 * fq;
        f32x4 nb[4];
        load_base(row0, col0, nb);
#pragma unroll
        for (int it = 0; it < 8; ++it) { const int ai = it >> 2, m = it & 3;
            const size_t row = (size_t)(row0 + ai * HALF + m * 16); const size_t off = row * 1024 + col0; float s = 0.f;
            const f32x4 b0 = nb[0], b1 = nb[1], b2 = nb[2], b3 = nb[3];
            if (it < 7) load_base(row0 + ((it + 1) >> 2) * HALF + ((it + 1) & 3) * 16, col0, nb);
            const float cs = SCALE ? ctab[wr * 64 + fr + ai * HALF + m * 16] : 1.0f;
#pragma unroll
            for (int bj = 0; bj < 2; ++bj) {
                const f32x4 v0 = acc[ai][bj][m][0] * cs + (bj == 0 ? b0 : b2), v1 = acc[ai][bj][m][1] * cs + (bj == 0 ? b1 : b3);
                s += (v0[0] * v0[0] + v0[1] * v0[1]) + (v0[2] * v0[2] + v0[3] * v0[3]) + (v1[0] * v1[0] + v1[1] * v1[1]) + (v1[2] * v1[2] + v1[3] * v1[3]);
                u32x4 w; w.x = cvt_pk_bf16(v0[0], v0[1]); w.y = cvt_pk_bf16(v0[2], v0[3]); w.z = cvt_pk_bf16(v1[0], v1[1]); w.w = cvt_pk_bf16(v1[2], v1[3]);
                *(u32x4*)(xb + off + bj * HALF) = w; }
            s += __shfl_xor(s, 16); s += __shfl_xor(s, 32);
            if (fq == 0) ss[row * 16 + u.pn * 4 + wc] = s; }
    }
};
struct RsTab { const PG8_LAS float* tab; int pm; };
__device__ __forceinline__ float row_rstd(const float* ss, size_t row, int fq) {
    const f32x4 p = *(const f32x4*)(ss + row * 16 + 4 * fq); float s = (p[0] + p[1]) + (p[2] + p[3]);
    s += __shfl_xor(s, 16); s += __shfl_xor(s, 32);
    return rsqrtf(s * (1.0f / 1024.0f) + RMS_EPS);
}
struct EpiSwiGLU {
    bf16_t* act; const float* ss; int ldc; RsTab rt;
    __device__ __forceinline__ void operator()(const f32x4 (&acc)[2][2][4][2], const Unit& u, int wr, int wc, int fr, int fq) const {
        const int row0 = u.pm * BM + wr * 64 + fr, col0 = u.pn * HALF + wc * 32 + 8 * fq;
        const bool use_tab = (u.pm == rt.pm);
#pragma unroll
        for (int ai = 0; ai < 2; ++ai)
#pragma unroll
            for (int m = 0; m < 4; ++m) { const size_t row = (size_t)(row0 + ai * HALF + m * 16); float rstd; if (__builtin_expect(use_tab, 1)) rstd = rt.tab[wr * 64 + fr + ai * HALF + m * 16]; else { asm volatile("; rstd from global (grid != 256)" ::: "memory"); rstd = row_rstd(ss, row, fq); }
                float a[8];
#pragma unroll
                for (int n = 0; n < 2; ++n)
#pragma unroll
                    for (int i = 0; i < 4; ++i) { const float g = acc[ai][0][m][n][i] * rstd, up = acc[ai][1][m][n][i] * rstd;
                        a[n * 4 + i] = g * up * __builtin_amdgcn_rcpf(1.0f + __builtin_amdgcn_exp2f(-1.4426950408889634f * g)); }
                u32x4 w; w.x = cvt_pk_bf16(a[0], a[1]); w.y = cvt_pk_bf16(a[2], a[3]); w.z = cvt_pk_bf16(a[4], a[5]); w.w = cvt_pk_bf16(a[6], a[7]);
                *(u32x4*)(act + row * ldc + col0) = w; }
    }
};
struct EpiQKV {
    bf16_t* qkv; const float* ss; const float* rope; RsTab rt;
    __device__ __forceinline__ void operator()(const f32x4 (&acc)[2][2][4][2], const Unit& u, int wr, int wc, int fr, int fq) const {
        const int row0 = u.pm * BM + wr * 64 + fr; const int sect = u.pn >> 2, head = (u.pn & 3) * 4 + wc;
        const int dsh = head < 6 ? 0 : (head < 11 ? 2 : 4);
        bf16_t* dst = qkv + (size_t)sect * ((size_t)16384 * 1024);
        const float qs = sect == 0 ? 0.125f * 1.4426950408889634f : 1.0f;
        const bool use_tab = (u.pm == rt.pm);
        const bool rot = sect < 2;
        f32x4 nr[4];
        if (rot) { const float* rp = rope + (size_t)(row0 & 8191) * 64 + 8 * fq; nr[0] = *(const f32x4*)(rp); nr[1] = *(const f32x4*)(rp + 4); nr[2] = *(const f32x4*)(rp + 32); nr[3] = *(const f32x4*)(rp + 36); }
#pragma unroll
        for (int it = 0; it < 8; ++it) { const int ai = it >> 2, m = it & 3;
            const int row = row0 + ai * HALF + m * 16; float rstd; if (__builtin_expect(use_tab, 1)) rstd = rt.tab[wr * 64 + fr + ai * HALF + m * 16]; else { asm volatile("; rstd from global (grid != 256)" ::: "memory"); rstd = row_rstd(ss, (size_t)row, fq); } rstd *= qs;
            const int b = row >> 13, t = row & 8191; const int pos = ((t & ((1 << dsh) - 1)) << (13 - dsh)) + (t >> dsh);
            bf16_t* o = dst + ((size_t)(b * 16 + head) * 8192 + pos) * 64 + 8 * fq;
            const f32x4 c0 = nr[0], c1 = nr[1], s0 = nr[2], s1 = nr[3];
            if (rot && it < 7) { const int row2 = row0 + ((it + 1) >> 2) * HALF + ((it + 1) & 3) * 16; const float* rp = rope + (size_t)(row2 & 8191) * 64 + 8 * fq;
                nr[0] = *(const f32x4*)(rp); nr[1] = *(const f32x4*)(rp + 4); nr[2] = *(const f32x4*)(rp + 32); nr[3] = *(const f32x4*)(rp + 36); }
            float lo[8], hi[8];
#pragma unroll
            for (int n = 0; n < 2; ++n)
#pragma unroll
                for (int i = 0; i < 4; ++i) { lo[n * 4 + i] = acc[ai][0][m][n][i] * rstd; hi[n * 4 + i] = acc[ai][1][m][n][i] * rstd; }
            if (rot) {
#pragma unroll
                for (int i = 0; i < 8; ++i) { const float cs = i < 4 ? c0[i & 3] : c1[i & 3], sn = i < 4 ? s0[i & 3] : s1[i & 3];
                    const float l = lo[i], h = hi[i]; lo[i] = l * cs - h * sn; hi[i] = h * cs + l * sn; }
            }
            u32x4 w; w.x = cvt_pk_bf16(lo[0], lo[1]); w.y = cvt_pk_bf16(lo[2], lo[3]); w.z = cvt_pk_bf16(lo[4], lo[5]); w.w = cvt_pk_bf16(lo[6], lo[7]);
            *(u32x4*)(o) = w;
            w.x = cvt_pk_bf16(hi[0], hi[1]); w.y = cvt_pk_bf16(hi[2], hi[3]); w.z = cvt_pk_bf16(hi[4], hi[5]); w.w = cvt_pk_bf16(hi[6], hi[7]);
            *(u32x4*)(o + 32) = w; }
    }
};

template <class Epi, class Sched, bool ALIGN_EPI, bool SEG = false>
__device__ __forceinline__ void gemm_phase(PG8_LAS unsigned char* lds, const Gemm g, const Sched& S, const Epi& E, const PG8_LAS float* segtab = nullptr) {
    int tid = threadIdx.x; asm volatile("" : "+v"(tid));
    const int wid = __builtin_amdgcn_readfirstlane(tid >> 6), lane = tid & 63, wr = wid >> 2, wc = wid & 3, fr = lane & 15, fq = lane >> 4;
    const int K = g.K, nt = K / BK;
    unsigned voffA[2], voffB[2];
#pragma unroll
    for (int i = 0; i < 2; ++i) { int R, C; stage_rc(tid * 16 + i * 8192, R, C); const int Rb = (R & ~31) + perm32(R & 31);
        voffA[i] = (unsigned)(R * g.lda + C) * 2u; voffB[i] = (unsigned)(Rb * g.ldb + C) * 2u; }
    const size_t kstep = (size_t)(BK * 2);
    const size_t hstepA = (size_t)HALF * g.lda * 2, hstepB = (size_t)HALF * g.ldb * 2;
    const size_t tstepA = 2 * hstepA, tstepB = 2 * hstepB;
    const unsigned ldsw = (unsigned)wid * 1024u;
    const int aoff = lds_byte(wr * 64 + fr, fq * 8), boff = lds_byte(wc * 32 + fr, fq * 8);
#define PG8_SA(b, h) (((b) * 2 + (h)) * HTB)
#define PG8_SB(b, h) ((4 + (b) * 2 + (h)) * HTB)
#define PG8_STAGE(bufoff, gbase, voff) do { _Pragma("unroll") for (int _i = 0; _i < 2; ++_i) \
        __builtin_amdgcn_global_load_lds((const unsigned*)((const char*)(gbase) + (voff)[_i]), (PG8_LAS unsigned*)(lds + (bufoff) + ldsw + _i * 8192), 16, 0, 0); } while (0)
#define PG8_LDA(dst, b, h) do { _Pragma("unroll") for (int m = 0; m < 4; ++m) _Pragma("unroll") for (int k = 0; k < 2; ++k) dst[m][k] = *(const PG8_LAS bf16x8*)(lds + PG8_SA(b, h) + aoff + m * 2048 + k * 1024); } while (0)
#define PG8_LDB(dst, b, h) do { _Pragma("unroll") for (int n = 0; n < 2; ++n) _Pragma("unroll") for (int k = 0; k < 2; ++k) dst[n][k] = *(const PG8_LAS bf16x8*)(lds + PG8_SB(b, h) + boff + n * 2048 + k * 1024); } while (0)
#define PG8_MMA(ai, bj, At, Bt) do { __builtin_amdgcn_s_setprio(1); _Pragma("unroll") for (int m = 0; m < 4; ++m) _Pragma("unroll") for (int n = 0; n < 2; ++n) _Pragma("unroll") for (int k = 0; k < 2; ++k) \
        acc[ai][bj][m][n] = __builtin_amdgcn_mfma_f32_16x16x32_bf16(Bt[n][k], At[m][k], acc[ai][bj][m][n], 0, 0, 0); __builtin_amdgcn_s_setprio(0); } while (0)
#define PG8_SEGSCALE(tb) do { _Pragma("unroll") for (int ai = 0; ai < 2; ++ai) _Pragma("unroll") for (int m = 0; m < 4; ++m) { const float f_ = (tb)[wr * 64 + fr + ai * HALF + m * 16]; \
        _Pragma("unroll") for (int bj = 0; bj < 2; ++bj) _Pragma("unroll") for (int n = 0; n < 2; ++n) acc[ai][bj][m][n] = acc[ai][bj][m][n] * f_; } } while (0)
#define PG8_WAIT_V(n) asm volatile("s_waitcnt vmcnt(" #n ")" ::: "memory")
#define PG8_WAIT_L(n) asm volatile("s_waitcnt lgkmcnt(" #n ")" ::: "memory")
#define PG8_BAR __builtin_amdgcn_s_barrier()
#define PG8_SCHED __builtin_amdgcn_sched_barrier(0)
    Unit cur, nxt; int ui = 0;
    if (!S.next(0, cur)) return;
    f32x4 acc[2][2][4][2];
#pragma unroll
    for (int a = 0; a < 2; ++a)
#pragma unroll
        for (int b = 0; b < 2; ++b)
#pragma unroll
            for (int m = 0; m < 4; ++m)
#pragma unroll
                for (int n = 0; n < 2; ++n) acc[a][b][m][n] = (f32x4){0.f, 0.f, 0.f, 0.f};
    bf16x8 At[4][2], B0[2][2], B1[2][2];
    const char* cA = (const char*)g.A + (size_t)cur.pm * tstepA + (size_t)cur.pn * g.a_pn_bytes; const char* cB = (const char*)g.Bt + (size_t)cur.pn * tstepB;
    PG8_STAGE(PG8_SB(0, 0), cB, voffB); PG8_STAGE(PG8_SB(0, 1), cB + hstepB, voffB); PG8_STAGE(PG8_SA(0, 0), cA, voffA); PG8_STAGE(PG8_SA(0, 1), cA + hstepA, voffA);
    if (wr == 1) PG8_BAR;
    PG8_WAIT_V(2); PG8_BAR;
    PG8_STAGE(PG8_SB(1, 0), cB + kstep, voffB); PG8_STAGE(PG8_SA(1, 0), cA + kstep, voffA); PG8_STAGE(PG8_SB(1, 1), cB + hstepB + kstep, voffB);
    PG8_WAIT_V(6); PG8_BAR;
    for (;;) {
        const bool has_next = S.next(ui + 1, nxt);
        const char* nA = has_next ? (const char*)g.A + (size_t)nxt.pm * tstepA + (size_t)nxt.pn * g.a_pn_bytes : cA; const char* nB = has_next ? (const char*)g.Bt + (size_t)nxt.pn * tstepB : cB;
        for (int t = 0; t < nt; t += 2) {
            const bool last = (t == nt - 2);
            const char* a1 = cA + (size_t)(t + 1) * kstep;
            const char* a2 = last ? nA : cA + (size_t)(t + 2) * kstep; const char* b2 = last ? nB : cB + (size_t)(t + 2) * kstep;
            const char* a3 = a2 + kstep; const char* b3 = b2 + kstep;
            if constexpr (SEG) { if (t == 6) PG8_SEGSCALE(segtab); }
            PG8_LDB(B0, 0, 0); PG8_LDB(B1, 0, 1); PG8_SCHED; PG8_LDA(At, 0, 0); PG8_STAGE(PG8_SA(1, 1), a1 + hstepA, voffA);
            PG8_WAIT_V(8); PG8_WAIT_L(0); PG8_BAR; PG8_MMA(0, 0, At, B0); PG8_MMA(0, 1, At, B1); PG8_BAR; PG8_SCHED;
            PG8_LDA(At, 0, 1); PG8_STAGE(PG8_SB(0, 0), b2, voffB); PG8_STAGE(PG8_SB(0, 1), b2 + hstepB, voffB); PG8_STAGE(PG8_SA(0, 0), a2, voffA);
            PG8_WAIT_V(8); PG8_WAIT_L(0); PG8_BAR; PG8_MMA(1, 0, At, B0); PG8_MMA(1, 1, At, B1); PG8_BAR; PG8_SCHED;
            if constexpr (SEG) { if (t == 10) PG8_SEGSCALE(segtab + 256); }
            PG8_LDB(B0, 1, 0); PG8_LDB(B1, 1, 1); PG8_SCHED; PG8_LDA(At, 1, 0); PG8_STAGE(PG8_SA(0, 1), a2 + hstepA, voffA);
            PG8_WAIT_V(8); PG8_WAIT_L(0); PG8_BAR; PG8_MMA(0, 0, At, B0); PG8_MMA(0, 1, At, B1); PG8_BAR; PG8_SCHED;
            PG8_LDA(At, 1, 1); PG8_STAGE(PG8_SB(1, 0), b3, voffB); PG8_STAGE(PG8_SB(1, 1), b3 + hstepB, voffB); PG8_STAGE(PG8_SA(1, 0), a3, voffA);
            PG8_WAIT_V(8); PG8_WAIT_L(0); PG8_BAR; PG8_MMA(1, 0, At, B0); PG8_MMA(1, 1, At, B1); PG8_BAR; PG8_SCHED;
        }
        if constexpr (ALIGN_EPI) { if (wr == 0) PG8_BAR; }
        E(acc, cur, wr, wc, fr, fq);
        if (!has_next) break;
#pragma unroll
        for (int a = 0; a < 2; ++a)
#pragma unroll
            for (int b = 0; b < 2; ++b)
#pragma unroll
                for (int m = 0; m < 4; ++m)
#pragma unroll
                    for (int n = 0; n < 2; ++n) acc[a][b][m][n] = (f32x4){0.f, 0.f, 0.f, 0.f};
        cur = nxt; cA = nA; cB = nB; ++ui;
        if constexpr (ALIGN_EPI) { if (wr == 1) PG8_BAR; }
    }
    PG8_WAIT_V(0);
    if constexpr (!ALIGN_EPI) { if (wr == 0) PG8_BAR; }
    PG8_BAR;
#undef PG8_SA
#undef PG8_SB
#undef PG8_STAGE
#undef PG8_LDA
#undef PG8_LDB
#undef PG8_MMA
#undef PG8_WAIT_V
#undef PG8_SEGSCALE
#undef PG8_WAIT_L
#undef PG8_BAR
#undef PG8_SCHED
}
}

constexpr int NWAVES = 8;
constexpr int BATCH = 2, SEQ = 8192, D = 1024, H = 16, HD = 64, FF = 2816;
constexpr int M = BATCH * SEQ;
constexpr size_t MiB = 1u << 20;
constexpr size_t WS_CTL = 0, CTL_ZERO_BYTES = 64 * 1024;
constexpr size_t WS_ROPE = 1 * MiB;
constexpr size_t WS_SS = 3 * MiB;
constexpr size_t WS_LSE = 4 * MiB;
constexpr size_t WS_WIN = 6 * MiB;
constexpr size_t WS_WG = 8 * MiB;
constexpr size_t WS_WPO = 9 * MiB;
constexpr size_t WS_WGU0 = 11 * MiB;
constexpr size_t WS_WD0 = 22 * MiB;
constexpr size_t WS_WQKV = 28 * MiB;
constexpr size_t WS_WAO = 34 * MiB;
constexpr size_t WS_WGU1 = 36 * MiB;
constexpr size_t WS_WD1 = 47 * MiB;
constexpr size_t WS_BIG = 56 * MiB;
constexpr size_t WS_XB = 184 * MiB;
constexpr size_t WS_ZO = 216 * MiB;
constexpr size_t WS_END = 248 * MiB;
constexpr int CW_BAR = 1024;

constexpr int LDS_BYTES = 147456;

#define GAS __attribute__((address_space(1)))
#define LAS __attribute__((address_space(3)))
typedef unsigned short bf16;
typedef unsigned v4u __attribute__((ext_vector_type(4)));
typedef unsigned v2u __attribute__((ext_vector_type(2)));
typedef float f32x4 __attribute__((ext_vector_type(4)));
#define LDS_WAIT() asm volatile("s_waitcnt lgkmcnt(0)" ::: "memory")
__device__ __forceinline__ unsigned f2bf(float f) { unsigned u = __builtin_bit_cast(unsigned, f); return (u + 0x7fffu + ((u >> 16) & 1u)) >> 16; }
__device__ __forceinline__ unsigned pk2(float lo, float hi) { return f2bf(lo) | (f2bf(hi) << 16); }
__device__ __forceinline__ float bflo(unsigned w) { return __builtin_bit_cast(float, w << 16); }
__device__ __forceinline__ float bfhi(unsigned w) { return __builtin_bit_cast(float, w & 0xffff0000u); }

#define XB_TMO      128
#define XB_XCNT(j)  (256  + 64 * (j))
#define XB_XSUB(j)  (1280 + 64 * (j))
#define XB_XGEN(j)  (2304 + 64 * (j))
#define XB_TOP      3328
#define XB_TOPGEN   3392
#define XCD_BAR_WORDS 3456
#define XB_SPIN_CAP (1u << 22)
__device__ __forceinline__ unsigned xb_ld(unsigned* p)              { return __hip_atomic_load(p, __ATOMIC_RELAXED, __HIP_MEMORY_SCOPE_AGENT); }
__device__ __forceinline__ unsigned xb_add(unsigned* p, unsigned v) { return __hip_atomic_fetch_add(p, v, __ATOMIC_RELAXED, __HIP_MEMORY_SCOPE_AGENT); }
__device__ __forceinline__ unsigned xb_xcc_id() { return (unsigned)__builtin_amdgcn_s_getreg((3 << 11) | 20) & 0xFu; }
#define XB_SPIN(cond, bar) do { unsigned _sp = 0; while (cond) { __builtin_amdgcn_s_sleep(1); \
    if ((++_sp & 255u) == 0u) { if (xb_ld(&(bar)[XB_TMO])) break; if (_sp > XB_SPIN_CAP) { atomicAdd(&(bar)[XB_TMO], 1u); break; } } } } while (0)
struct XcdBarrier { unsigned* bar; unsigned x; volatile LAS unsigned* st; };
__device__ __forceinline__ XcdBarrier xcd_barrier_post(unsigned* bar, volatile LAS unsigned* st) {
    XcdBarrier b; b.bar = bar; b.x = xb_xcc_id(); b.st = st;
    if (threadIdx.x == 0) (void)xb_add(&bar[XB_XCNT(b.x)], 1u);
    return b;
}
__device__ __forceinline__ void xcd_barrier_complete(unsigned* bar, unsigned x, unsigned& nloc, unsigned& nx) {
    const unsigned G = gridDim.x * gridDim.y * gridDim.z;
    unsigned sum, cnt, mine, sp = 0u;
    for (;;) {
        sum = 0u; cnt = 0u; mine = 0u;
#pragma unroll
        for (unsigned j = 0; j < 16; ++j) { const unsigned c = xb_ld(&bar[XB_XCNT(j)]); sum += c; cnt += (c > 0u) ? 1u : 0u; mine = (j == x) ? c : mine; }
        if (sum == G) break;
        __builtin_amdgcn_s_sleep(1);
        if ((++sp & 255u) == 0u) { if (xb_ld(&bar[XB_TMO])) break; if (sp > XB_SPIN_CAP) { atomicAdd(&bar[XB_TMO], 1u); break; } }
    }
    nloc = mine > 0u ? mine : 1u; nx = cnt > 0u ? cnt : 1u;
}
__device__ __forceinline__ void xcd_barrier(const XcdBarrier& b) {
    asm volatile("s_waitcnt vmcnt(0)" ::: "memory");
    __syncthreads();
    if (threadIdx.x == 0) {
        unsigned* bar = b.bar;
        __builtin_amdgcn_s_waitcnt(0);
        unsigned nloc = b.st[0], nx = b.st[1];
        if (nloc == 0u) { xcd_barrier_complete(bar, b.x, nloc, nx); b.st[0] = nloc; b.st[1] = nx; }
        const unsigned old = xb_add(&bar[XB_XSUB(b.x)], 1u);
        const unsigned gen = old / nloc;
        if (old + 1u == (gen + 1u) * nloc) {
            __builtin_amdgcn_fence(__ATOMIC_RELEASE, "agent");
            asm volatile("s_waitcnt vmcnt(0)" ::: "memory");
            const unsigned og = xb_add(&bar[XB_TOP], 1u);
            const unsigned tg = og / nx;
            if (og + 1u == (tg + 1u) * nx) xb_add(&bar[XB_TOPGEN], 1u);
            else XB_SPIN(xb_ld(&bar[XB_TOPGEN]) == tg, bar);
            __builtin_amdgcn_fence(__ATOMIC_ACQUIRE, "agent");
            xb_add(&bar[XB_XGEN(b.x)], 1u);
            asm volatile("s_waitcnt vmcnt(0)" ::: "memory");
        } else {
            XB_SPIN(xb_ld(&bar[XB_XGEN(b.x)]) == gen, bar);
            __builtin_amdgcn_fence(__ATOMIC_ACQUIRE, "agent");
            asm volatile("s_waitcnt vmcnt(0)" ::: "memory");
        }
    }
    __syncthreads();
}

struct EpiFinal {
    const bf16* xb; float* out; float* ss; const float* gf; XcdBarrier bar;
    __device__ __forceinline__ void load_base(int row, int col0, pg8::f32x4 (&nb)[4]) const {
        using pg8::f32x4; using pg8::u32x4; using pg8::bf_lo; using pg8::bf_hi;
        const bf16* bp = xb + (size_t)row * 1024 + col0; const u32x4 a = *(const u32x4*)(bp), c = *(const u32x4*)(bp + pg8::HALF);
        nb[0] = (f32x4){bf_lo(a.x), bf_hi(a.x), bf_lo(a.y), bf_hi(a.y)}; nb[1] = (f32x4){bf_lo(a.z), bf_hi(a.z), bf_lo(a.w), bf_hi(a.w)};
        nb[2] = (f32x4){bf_lo(c.x), bf_hi(c.x), bf_lo(c.y), bf_hi(c.y)}; nb[3] = (f32x4){bf_lo(c.z), bf_hi(c.z), bf_lo(c.w), bf_hi(c.w)};
    }
    __device__ __forceinline__ void operator()(pg8::f32x4 (&acc)[2][2][4][2], const pg8::Unit& u, int wr, int wc, int fr, int fq) const {
        using pg8::f32x4; using pg8::HALF; using pg8::BM;
        const int row0 = u.pm * BM + wr * 64 + fr, col0 = u.pn * BM + wc * 32 + 8 * fq;
        f32x4 nb[4];
        load_base(row0, col0, nb);
#pragma unroll
        for (int it = 0; it < 8; ++it) { const int ai = it >> 2, m = it & 3;
            const size_t row = (size_t)(row0 + ai * HALF + m * 16); float s = 0.f;
            const f32x4 b0 = nb[0], b1 = nb[1], b2 = nb[2], b3 = nb[3];
            if (it < 7) load_base(row0 + ((it + 1) >> 2) * HALF + ((it + 1) & 3) * 16, col0, nb);
#pragma unroll
            for (int bj = 0; bj < 2; ++bj) {
                const f32x4 v0 = acc[ai][bj][m][0] + (bj == 0 ? b0 : b2), v1 = acc[ai][bj][m][1] + (bj == 0 ? b1 : b3);
                acc[ai][bj][m][0] = v0; acc[ai][bj][m][1] = v1;
                s += (v0[0] * v0[0] + v0[1] * v0[1]) + (v0[2] * v0[2] + v0[3] * v0[3]) + (v1[0] * v1[0] + v1[1] * v1[1]) + (v1[2] * v1[2] + v1[3] * v1[3]); }
            s += __shfl_xor(s, 16); s += __shfl_xor(s, 32);
            if (fq == 0) ss[row * 16 + u.pn * 4 + wc] = s; }
        xcd_barrier(bar);
        f32x4 gq[2][2];
#pragma unroll
        for (int bj = 0; bj < 2; ++bj)
#pragma unroll
            for (int n = 0; n < 2; ++n) gq[bj][n] = *(const f32x4*)(gf + col0 + bj * HALF + 4 * n);
        f32x4 pr[8];
#pragma unroll
        for (int it = 0; it < 8; ++it) pr[it] = *(const f32x4*)(ss + (size_t)(row0 + (it >> 2) * HALF + (it & 3) * 16) * 16 + 4 * fq);
#pragma unroll
        for (int it = 0; it < 8; ++it) { const int ai = it >> 2, m = it & 3;
            const size_t row = (size_t)(row0 + ai * HALF + m * 16); const size_t off = row * 1024 + col0;
            float sq = (pr[it][0] + pr[it][1]) + (pr[it][2] + pr[it][3]); sq += __shfl_xor(sq, 16); sq += __shfl_xor(sq, 32);
            const float rstd = rsqrtf(sq * (1.0f / 1024.0f) + pg8::RMS_EPS);
#pragma unroll
            for (int bj = 0; bj < 2; ++bj) { *(f32x4*)(out + off + bj * HALF) = acc[ai][bj][m][0] * rstd * gq[bj][0]; *(f32x4*)(out + off + bj * HALF + 4) = acc[ai][bj][m][1] * rstd * gq[bj][1]; } }
    }
};

struct Frame {
    LAS unsigned char* lds;
    int tid, lane, wave, vcu, G;
};
__device__ __forceinline__ float wave_sum(float v) {
#pragma unroll
    for (int o = 1; o < 64; o <<= 1) v += __shfl_xor(v, o);
    return v;
}

constexpr int LDS_RSTAB = 131072 + 4096;
__device__ __forceinline__ pg8::RsTab fill_rstd_tab(LAS unsigned char* lds, const float* ss, int pm) {
    LAS float* tab = (LAS float*)(lds + LDS_RSTAB);
    int tid = threadIdx.x; asm volatile("" : "+v"(tid));
    if (tid < 256) { const float* p = ss + ((size_t)pm * 256 + tid) * 16; float s = 0.f;
#pragma unroll
        for (int q = 0; q < 4; ++q) { const f32x4 v = *(const GAS f32x4*)(p + 4 * q); s += (v[0] + v[1]) + (v[2] + v[3]); }
        tab[tid] = rsqrtf(s * (1.0f / 1024.0f) + 1e-6f); }
    LDS_WAIT(); __syncthreads();
    pg8::RsTab r; r.tab = tab; r.pm = pm; return r;
}

__device__ __forceinline__ const LAS float* seg_fill(LAS unsigned char* lds, const float* lse, int pm) {
    LAS float* tab = (LAS float*)(lds + LDS_RSTAB);
    int tid = threadIdx.x; asm volatile("" : "+v"(tid));
    if (tid < 256) { const float* p = lse + ((size_t)pm * 256 + tid) * 16; float L[16];
#pragma unroll
        for (int q4 = 0; q4 < 4; ++q4) { const f32x4 v = *(const GAS f32x4*)(p + 4 * q4); L[4 * q4] = v[0]; L[4 * q4 + 1] = v[1]; L[4 * q4 + 2] = v[2]; L[4 * q4 + 3] = v[3]; }
        float lg0, lg1, lg2;
        { float mx = L[0];
_Pragma("unroll") for (int i = 1; i < 6; ++i) mx = fmaxf(mx, L[i]); float s = 0.f;
_Pragma("unroll") for (int i = 0; i < 6; ++i) s += __expf(L[i] - mx); lg0 = mx + __logf(s) - 1.791759469228055f; }
        { float mx = L[6];
_Pragma("unroll") for (int i = 7; i < 11; ++i) mx = fmaxf(mx, L[i]); float s = 0.f;
_Pragma("unroll") for (int i = 6; i < 11; ++i) s += __expf(L[i] - mx); lg1 = mx + __logf(s) - 1.6094379124341003f; }
        { float mx = L[11];
_Pragma("unroll") for (int i = 12; i < 16; ++i) mx = fmaxf(mx, L[i]); float s = 0.f;
_Pragma("unroll") for (int i = 11; i < 16; ++i) s += __expf(L[i] - mx); lg2 = mx + __logf(s) - 1.6094379124341003f; }
        const float mx = fmaxf(lg0, fmaxf(lg1, lg2));
        const float e0 = __expf(lg0 - mx), e1 = __expf(lg1 - mx), e2 = __expf(lg2 - mx); const float is = 3.0f / (e0 + e1 + e2);
        const float s0 = fmaxf(e0 * is, 1e-30f), s1 = fmaxf(e1 * is, 1e-30f), s2 = fmaxf(e2 * is, 1e-30f);
        tab[tid] = s0 / s1; tab[256 + tid] = s1 / s2; tab[512 + tid] = s2; }
    LDS_WAIT(); __syncthreads();
    return tab;
}

__device__ __forceinline__ int p0_map_row(int mode, int sel, int row_off, int n) {
    if (mode == 0) return row_off + n;
    if (mode == 1) return 256 * (n >> 7) + 128 * sel + (n & 127);
    const int pn = n >> 8, w = n & 255, wc = w >> 6, d = w & 63; return 256 * pn + 128 * (d >> 5) + 32 * wc + (d & 31);
}
__device__ __forceinline__ void p0_tr_item(const float* W, int K, int N, bf16* WT, int mode, int sel, int row_off, const float* kgain, const float* nscale, LAS unsigned* scr, int item, int lane) {
    const int nblk = N / 64, kb = item / nblk, nb = item % nblk, k0 = 64 * kb, n0 = 64 * nb;
    const int kq = lane >> 4, n4 = (lane & 15) * 4;
    f32x4 ns = (f32x4){1.f, 1.f, 1.f, 1.f}; if (nscale) ns = *(const GAS f32x4*)(nscale + n0 + n4);
    f32x4 v[16];
#pragma unroll
    for (int i = 0; i < 16; ++i) { const int k = 8 * (i >> 1) + 2 * kq + (i & 1); v[i] = *(const GAS f32x4*)(W + (size_t)(k0 + k) * N + n0 + n4); }
    if (kgain) {
#pragma unroll
        for (int i = 0; i < 16; ++i) { const int k = 8 * (i >> 1) + 2 * kq + (i & 1); v[i] = v[i] * kgain[k0 + k]; }
    }
#pragma unroll
    for (int ip = 0; ip < 8; ++ip) { const f32x4 e = v[2 * ip] * ns, o = v[2 * ip + 1] * ns;
#pragma unroll
        for (int c = 0; c < 4; ++c) scr[(n4 + c) * 33 + 4 * ip + kq] = pk2(e[c], o[c]); }
    LDS_WAIT(); asm volatile("" ::: "memory");
    const int kc = lane & 7;
#pragma unroll
    for (int jj = 0; jj < 8; ++jj) { const int n = (lane >> 3) + 8 * jj; const LAS unsigned* sp = scr + n * 33 + 4 * kc;
        v4u o; o.x = sp[0]; o.y = sp[1]; o.z = sp[2]; o.w = sp[3];
        *(GAS v4u*)(WT + (size_t)p0_map_row(mode, sel, row_off, n0 + n) * K + k0 + 8 * kc) = o; }
    LDS_WAIT(); asm volatile("" ::: "memory");
}

struct Args { const float* in[13]; float* out; unsigned char* ws; int ph_lo, ph_hi; };

__device__ __forceinline__ void sincos_acc(float angf, float& c, float& s) {
    const double x = (double)angf; const double k = __builtin_rint(x * 0.15915494309189535);
    double y = (x - k * 6.283185307179586) * 0.25;
    const double y2 = y * y;
    double sn = y * (1.0 + y2 * (-1.0 / 6 + y2 * (1.0 / 120 + y2 * (-1.0 / 5040 + y2 * (1.0 / 362880 + y2 * (-1.0 / 39916800 + y2 * (1.0 / 6227020800.0)))))));
    double cs = 1.0 + y2 * (-0.5 + y2 * (1.0 / 24 + y2 * (-1.0 / 720 + y2 * (1.0 / 40320 + y2 * (-1.0 / 3628800 + y2 * (1.0 / 479001600.0 + y2 * (-1.0 / 87178291200.0)))))));
#pragma unroll
    for (int i = 0; i < 2; ++i) { const double s2 = 2.0 * sn * cs, c2 = 1.0 - 2.0 * sn * sn; sn = s2; cs = c2; }
    c = (float)cs; s = (float)sn;
}

template <int GI>
__device__ __forceinline__ void pool_group(f32x4 (&cur)[16], f32x4 (&prev)[16], f32x4& S2, f32x4& S4, f32x4& S8, f32x4& S16, const f32x4 gv, const float* x, bf16* hp,
                                           int R0, bool bstart, int c4, int hl, int lane, int wq, LAS float* part, LAS float* rs) {
    const bool zero = (GI == 0) && bstart;
#pragma unroll
    for (int j = 0; j < 16; ++j) { const f32x4 v = cur[j]; part[j * 256 + hl] = (v[0] * v[0] + v[1] * v[1]) + (v[2] * v[2] + v[3] * v[3]); }
    LDS_WAIT(); __syncthreads();
#pragma unroll
    for (int q = 0; q < 4; ++q) { const int j = 4 * wq + q; const f32x4 p = *(const LAS f32x4*)(part + j * 256 + 4 * lane);
        const float s = wave_sum((p[0] + p[1]) + (p[2] + p[3])); if (lane == 0) rs[j] = zero ? 0.f : rsqrtf(s * (1.0f / D) + 1e-6f); }
    LDS_WAIT(); __syncthreads();
#pragma unroll
    for (int j = 0; j < 16; ++j) {
        const int row = R0 - 16 + GI * 16 + j;
        const f32x4 hv = cur[j] * rs[j] * gv;
        const f32x4 h2 = j >= 2 ? cur[j >= 2 ? j - 2 : 0] : prev[(j + 14) & 15], h4 = j >= 4 ? cur[j >= 4 ? j - 4 : 0] : prev[(j + 12) & 15], h8 = j >= 8 ? cur[j >= 8 ? j - 8 : 0] : prev[(j + 8) & 15];
        S2 = S2 + hv - h2; S4 = S4 + hv - h4; S8 = S8 + hv - h8; S16 = S16 + hv - prev[j];
        cur[j] = hv;
        if (GI < 2) prev[j] = *(const GAS f32x4*)(x + (size_t)(row + 16) * D + 4 * c4);
        if (GI > 0) {
            const int t = row & (SEQ - 1);
            const float i2 = t >= 1 ? 0.5f : 1.0f, i4 = t >= 3 ? 0.25f : 1.0f / (float)(t + 1), i8 = t >= 7 ? 0.125f : 1.0f / (float)(t + 1), i16 = t >= 15 ? 0.0625f : 1.0f / (float)(t + 1);
            const f32x4 o2 = S2 * i2 - hv, o4 = S4 * i4 - hv, o8 = S8 * i8 - hv, o16 = S16 * i16 - hv;
            const size_t off = (size_t)row * D + 4 * c4;
            *(GAS v2u*)(hp + off) = (v2u){pk2(o2[0], o2[1]), pk2(o2[2], o2[3])};
            *(GAS v2u*)(hp + (size_t)M * D + off) = (v2u){pk2(o4[0], o4[1]), pk2(o4[2], o4[3])};
            *(GAS v2u*)(hp + 2 * (size_t)M * D + off) = (v2u){pk2(o8[0], o8[1]), pk2(o8[2], o8[3])};
            *(GAS v2u*)(hp + 3 * (size_t)M * D + off) = (v2u){pk2(o16[0], o16[1]), pk2(o16[2], o16[3])};
        }
    }
}

constexpr int I_SQ = 16 * 16, I_GU = 16 * 44, I_DN = 44 * 16, I_QKV = 16 * 48, I_W2 = 4 * 32 * 8;
constexpr int W_EARLY = I_W2 + I_SQ + 2 * I_GU, W_ITEMS = W_EARLY + I_DN + I_QKV + I_SQ + 2 * I_GU + I_DN;
__device__ __forceinline__ void w2_item(const Args& a, int it, int lane) {
    typedef float f32x16 __attribute__((ext_vector_type(16)));
    const int g = it >> 8, r = it & 255, n0 = (r >> 3) * 32, c0 = (r & 7) * 32, i = lane & 31, h = lane >> 5;
    const float* wout = a.in[7] + (size_t)(g * 256) * 1024 + n0 + i;
    const float* wgr = a.in[5] + (size_t)g * 65536 + (size_t)(c0 + i) * 256;
    const float* sc = a.in[6] + g * 256;
    f32x16 acc = {0.f, 0.f, 0.f, 0.f, 0.f, 0.f, 0.f, 0.f, 0.f, 0.f, 0.f, 0.f, 0.f, 0.f, 0.f, 0.f};
#pragma unroll 1
    for (int ch = 0; ch < 4; ++ch) {
        f32x4 bq[16]; float a0[16], a1[16];
        const float scv = sc[ch * 64 + lane];
#pragma unroll
        for (int q = 0; q < 16; ++q) { const int jq = ch * 16 + q;
            bq[q] = *(const GAS f32x4*)(wgr + 4 * jq);
            a0[q] = wout[(size_t)(4 * jq + h) * 1024]; a1[q] = wout[(size_t)(4 * jq + 2 + h) * 1024]; }
        asm volatile("" ::: "memory"); __builtin_amdgcn_sched_barrier(0);
#pragma unroll
        for (int q = 0; q < 16; ++q) {
            const float s0 = __shfl(scv, 4 * q + h), s1 = __shfl(scv, 4 * q + 2 + h);
            const float b0 = (h ? bq[q][1] : bq[q][0]) * s0, b1 = (h ? bq[q][3] : bq[q][2]) * s1;
            acc = __builtin_amdgcn_mfma_f32_32x32x2f32(a0[q], b0, acc, 0, 0, 0);
            acc = __builtin_amdgcn_mfma_f32_32x32x2f32(a1[q], b1, acc, 0, 0, 0);
        }
    }
    bf16* W2T = (bf16*)(a.ws + WS_WPO) + (size_t)n0 * 1024 + g * 256 + c0 + i;
#pragma unroll
    for (int rr = 0; rr < 16; ++rr) W2T[(size_t)((rr & 3) + 8 * (rr >> 2) + 4 * h) * 1024] = (bf16)f2bf(acc[rr]);
}
__device__ __forceinline__ void weight_item(const Args& a, int it, LAS unsigned* scr, int lane) {
    unsigned char* ws = a.ws; const float* norm_mix = a.in[1]; const float* norm_ffn = a.in[2];
    int r = it;
    if (r < I_W2) { w2_item(a, r, lane); return; } r -= I_W2;
    if (r < I_SQ) { p0_tr_item(a.in[4], D, D, (bf16*)(ws + WS_WIN), 0, 0, 0, nullptr, nullptr, scr, r, lane); return; } r -= I_SQ;
    if (r < I_GU) { p0_tr_item(a.in[10], D, FF, (bf16*)(ws + WS_WGU0), 1, 0, 0, norm_ffn, nullptr, scr, r, lane); return; } r -= I_GU;
    if (r < I_GU) { p0_tr_item(a.in[11], D, FF, (bf16*)(ws + WS_WGU0), 1, 1, 0, norm_ffn, nullptr, scr, r, lane); return; } r -= I_GU;
    if (r < I_DN) { p0_tr_item(a.in[12], FF, D, (bf16*)(ws + WS_WD0), 0, 0, 0, nullptr, nullptr, scr, r, lane); return; } r -= I_DN;
    if (r < I_QKV) { p0_tr_item(a.in[8], D, 3 * D, (bf16*)(ws + WS_WQKV), 2, 0, 0, norm_mix + D, nullptr, scr, r, lane); return; } r -= I_QKV;
    if (r < I_SQ) { p0_tr_item(a.in[9], D, D, (bf16*)(ws + WS_WAO), 0, 0, 0, nullptr, nullptr, scr, r, lane); return; } r -= I_SQ;
    if (r < I_GU) { p0_tr_item(a.in[10] + (size_t)D * FF, D, FF, (bf16*)(ws + WS_WGU1), 1, 0, 0, norm_ffn + D, nullptr, scr, r, lane); return; } r -= I_GU;
    if (r < I_GU) { p0_tr_item(a.in[11] + (size_t)D * FF, D, FF, (bf16*)(ws + WS_WGU1), 1, 1, 0, norm_ffn + D, nullptr, scr, r, lane); return; } r -= I_GU;
    p0_tr_item(a.in[12] + (size_t)D * FF, FF, D, (bf16*)(ws + WS_WD1), 0, 0, 0, nullptr, nullptr, scr, r, lane);
}
__device__ __forceinline__ void rope_entries(unsigned char* ws, int first, int stride) {
    float* rope = (float*)(ws + WS_ROPE);
    for (int e = first; e < SEQ * 32; e += stride) {
        const int t = e >> 5, j = e & 31;
        const float invf = (float)(1.0 / (double)(float)exp2(13.287712379549449 * (double)j / 32.0));
        const float ang = (float)t * invf; float c, s; sincos_acc(ang, c, s);
        rope[(size_t)t * 64 + j] = c; rope[(size_t)t * 64 + 32 + j] = s;
    }
}
__device__ __forceinline__ void late_prep(const Args& a0, LAS unsigned char* lds, int widx, int nidle) {
    Args a = a0;
#pragma unroll
    for (int i = 0; i < 13; ++i) asm volatile("" : "+s"(a.in[i]));
    asm volatile("" : "+s"(a.ws));
    int tid = threadIdx.x; asm volatile("" : "+v"(tid)); const int lane = tid & 63, wave = __builtin_amdgcn_readfirstlane(tid >> 6);
    LAS unsigned* scr = (LAS unsigned*)(lds + wave * 16384);
    for (int it = W_EARLY + widx * NWAVES + wave; it < W_ITEMS; it += nidle * NWAVES) weight_item(a, it, scr, lane);
}

__device__ __forceinline__ void p0_prologue(const Frame& F0, const Args& a, bool defer_late) {
    Frame F = F0; { int tid = threadIdx.x; asm volatile("" : "+v"(tid)); F.tid = tid; F.lane = tid & 63; F.wave = __builtin_amdgcn_readfirstlane(tid >> 6); }
    unsigned char* ws = a.ws;
    LAS unsigned* scr = (LAS unsigned*)(F.lds + F.wave * 16384);
    const int gw = F.vcu * NWAVES + F.wave, NGW = F.G * NWAVES;
    const float* norm_mix = a.in[1];
    const int n_items = defer_late ? W_EARLY : W_ITEMS;
    for (int it = gw; it < n_items; it += NGW) weight_item(a, it, scr, F.lane);
    rope_entries(ws, F.vcu * NWAVES * 64 + F.tid, F.G * NWAVES * 64);
    __syncthreads();
    {
        const float* x = a.in[0]; const float* g0 = norm_mix;
        bf16* hp = (bf16*)(ws + WS_BIG);
        const int half = F.tid >> 8, c4 = F.tid & 255, hl = c4, wq = F.wave & 3;
        LAS float* part = (LAS float*)(F.lds) + half * (16 * 256);
        LAS float* rs = (LAS float*)(F.lds + 32768) + half * 16;
        const f32x4 gv = *(const GAS f32x4*)(g0 + 4 * c4);
        for (int blk = F.vcu; blk < M / 64; blk += F.G) {
            const int R0 = blk * 64 + half * 32;
            const bool bstart = (R0 & (SEQ - 1)) == 0;
            f32x4 A[16], B[16];
#pragma unroll
            for (int j = 0; j < 16; ++j) { B[j] = (f32x4){0.f, 0.f, 0.f, 0.f}; A[j] = B[j]; if (!bstart) A[j] = *(const GAS f32x4*)(x + (size_t)(R0 - 16 + j) * D + 4 * c4); }
            f32x4 S2 = B[0], S4 = B[0], S8 = B[0], S16 = B[0];
            pool_group<0>(A, B, S2, S4, S8, S16, gv, x, hp, R0, bstart, c4, hl, F.lane, wq, part, rs);
            pool_group<1>(B, A, S2, S4, S8, S16, gv, x, hp, R0, bstart, c4, hl, F.lane, wq, part, rs);
            pool_group<2>(A, B, S2, S4, S8, S16, gv, x, hp, R0, bstart, c4, hl, F.lane, wq, part, rs);
            __syncthreads();
        }
    }
}

namespace att {
typedef short bf16x8 __attribute__((ext_vector_type(8)));
typedef short s16x4 __attribute__((ext_vector_type(4)));
typedef float f32x16 __attribute__((ext_vector_type(16)));
typedef unsigned u32x4 __attribute__((ext_vector_type(4)));
constexpr int KCH = 6160;
constexpr int LDS_K = 0, LDS_V = 8 * KCH, VDH = 24 * 1024 + 64, LDS_OST = LDS_V + 2 * VDH, LDS_TOTAL = LDS_OST + 8 * 4096;
static_assert(LDS_TOTAL <= LDS_BYTES, "attention LDS");
__device__ __forceinline__ int crow(int r, int hi) { return (r & 3) + 8 * (r >> 2) + 4 * hi; }
__device__ __forceinline__ s16x4 vtr(const LAS unsigned char* p) { return __builtin_bit_cast(s16x4, __builtin_amdgcn_ds_read_tr16_b64_v4i16((LAS s16x4*)p)); }
struct KVQ { u32x4 k[6], v[6]; bf16x8 q[4]; };
__device__ __forceinline__ void attn_load(int item, const bf16* Qp, const bf16* Kp, const bf16* Vp, KVQ& R, int tid, int wid, int r32, int hi) {
    const int bh = item >> 5, j = item & 31, h = bh & 15;
    const int dsh = h < 6 ? 0 : (h < 11 ? 2 : 4);
    const bool first = (j & ((32 >> dsh) - 1)) == 0;
    const size_t hb = (size_t)bh * (SEQ * 64);
    const int pos0 = j * 256;
#pragma unroll
    for (int it = 0; it < 6; ++it) {
        const int p = tid + 512 * it, key = p >> 3, c = p & 7;
        const int keyc = (first && key < 128) ? 128 : key;
        const size_t go = hb + (size_t)(pos0 - 128 + keyc) * 64 + c * 8; R.k[it] = *(const GAS u32x4*)(Kp + go); R.v[it] = *(const GAS u32x4*)(Vp + go);
    }
#pragma unroll
    for (int d0 = 0; d0 < 4; ++d0) R.q[d0] = *(const GAS bf16x8*)(Qp + hb + (size_t)(pos0 + 32 * wid + r32) * 64 + d0 * 16 + hi * 8);
}
__device__ __forceinline__ void attn_phase(int item0, int nitems, const bf16* Qp, const bf16* Kp, const bf16* Vp, bf16* O, float* lse, LAS unsigned char* shm) {
    int tid = threadIdx.x; asm volatile("" : "+v"(tid));
    const int wid = __builtin_amdgcn_readfirstlane(tid >> 6);
    KVQ R;
    if (nitems > 0) attn_load(item0, Qp, Kp, Vp, R, tid, wid, tid & 31, (tid & 63) >> 5);
#pragma unroll 1
  for (int ii = 0; ii < nitems; ++ii) {
    asm volatile("" : "+v"(tid));
    const int lane = tid & 63, r32 = lane & 31, hi = lane >> 5;
    const int item = item0 + ii, bh = item >> 5, j = item & 31;
    const int b = bh >> 4, h = bh & 15;
    const int dsh = h < 6 ? 0 : (h < 11 ? 2 : 4);
    const int nqb = 32 >> dsh, r = j >> (5 - dsh), qb = j & (nqb - 1);
    const bool first = (qb == 0);
#pragma unroll
    for (int it = 0; it < 6; ++it) {
        const int p = tid + 512 * it, key = p >> 3, c = p & 7;
        const bool dead = first && key < 128; const u32x4 z4 = (u32x4){0u, 0u, 0u, 0u};
        *(LAS u32x4*)(shm + LDS_K + c * KCH + key * 16) = dead ? z4 : R.k[it];
        *(LAS u32x4*)(shm + LDS_V + (c >> 2) * VDH + (key >> 4) * 1024 + (key & 15) * 64 + (c & 3) * 16) = dead ? z4 : R.v[it];
    }
    bf16x8 qr[4];
#pragma unroll
    for (int d0 = 0; d0 < 4; ++d0) qr[d0] = R.q[d0];
    LDS_WAIT(); __syncthreads();
    if (ii + 1 < nitems) attn_load(item + 1, Qp, Kp, Vp, R, tid, wid, r32, hi);
    f32x16 P[5];
    const LAS unsigned char* kbase = shm + LDS_K + hi * KCH + (32 * wid + r32) * 16;
#pragma unroll
    for (int kt = 0; kt < 5; ++kt) {
        f32x16 acc = {0.f, 0.f, 0.f, 0.f, 0.f, 0.f, 0.f, 0.f, 0.f, 0.f, 0.f, 0.f, 0.f, 0.f, 0.f, 0.f};
#pragma unroll
        for (int d0 = 0; d0 < 4; ++d0) { const bf16x8 kf = *(const LAS bf16x8*)(kbase + (2 * d0) * KCH + kt * 512); acc = __builtin_amdgcn_mfma_f32_32x32x16_bf16(kf, qr[d0], acc, 0, 0, 0); }
        P[kt] = acc;
    }
    const float NEG = -INFINITY;
    const int lowlim = first ? (128 - 32 * wid) : 0;
    const int lo0 = r32 > lowlim ? r32 : lowlim;
#pragma unroll
    for (int rr = 0; rr < 16; ++rr) { const int cr = crow(rr, hi); if (cr < lo0) P[0][rr] = NEG; if (cr > r32) P[4][rr] = NEG; }
    if (first) {
#pragma unroll
        for (int kt = 1; kt < 4; ++kt)
#pragma unroll
            for (int rr = 0; rr < 16; ++rr) if (32 * kt + crow(rr, hi) < lowlim) P[kt][rr] = NEG;
    }
    float mx = NEG;
#pragma unroll
    for (int kt = 0; kt < 5; ++kt)
#pragma unroll
        for (int rr = 0; rr < 16; ++rr) mx = fmaxf(mx, P[kt][rr]);
    mx = fmaxf(mx, __shfl_xor(mx, 32));
    float l = 0.f;
#pragma unroll
    for (int kt = 0; kt < 5; ++kt)
#pragma unroll
        for (int rr = 0; rr < 16; ++rr) { const float e = __builtin_amdgcn_exp2f(P[kt][rr] - mx); P[kt][rr] = e; l += e; }
    l += __shfl_xor(l, 32);
    const float inv = __builtin_amdgcn_rcpf(l);
    {
        const int i = qb * 256 + 32 * wid + r32, t = (i << dsh) + r;
        if (hi == 0) lse[((size_t)b * SEQ + t) * 16 + h] = (mx + __log2f(l)) * 0.6931471805599453f;
    }
    f32x16 o[2];
    o[0] = (f32x16){0.f, 0.f, 0.f, 0.f, 0.f, 0.f, 0.f, 0.f, 0.f, 0.f, 0.f, 0.f, 0.f, 0.f, 0.f, 0.f}; o[1] = o[0];
    const LAS unsigned char* vb = shm + LDS_V + ((lane >> 4) & 1) * 32 + (lane & 3) * 8 + (4 * hi + ((lane & 15) >> 2)) * 64;
#pragma unroll
    for (int kt = 0; kt < 5; ++kt)
#pragma unroll
        for (int s = 0; s < 2; ++s) {
            u32x4 pw;
            pw.x = pg8::cvt_pk_bf16(P[kt][8 * s + 0] * inv, P[kt][8 * s + 1] * inv); pw.y = pg8::cvt_pk_bf16(P[kt][8 * s + 2] * inv, P[kt][8 * s + 3] * inv);
            pw.z = pg8::cvt_pk_bf16(P[kt][8 * s + 4] * inv, P[kt][8 * s + 5] * inv); pw.w = pg8::cvt_pk_bf16(P[kt][8 * s + 6] * inv, P[kt][8 * s + 7] * inv);
            const bf16x8 pa = __builtin_bit_cast(bf16x8, pw);
            const int kblk = 2 * wid + 2 * kt + s;
#pragma unroll
            for (int dh = 0; dh < 2; ++dh) {
                const s16x4 vlo = vtr(vb + dh * VDH + kblk * 1024), vhi = vtr(vb + dh * VDH + kblk * 1024 + 512);
                const bf16x8 vf = (bf16x8){vlo[0], vlo[1], vlo[2], vlo[3], vhi[0], vhi[1], vhi[2], vhi[3]};
                o[dh] = __builtin_amdgcn_mfma_f32_32x32x16_bf16(pa, vf, o[dh], 0, 0, 0);
            }
        }
    {
        LAS bf16* stg = (LAS bf16*)(shm + LDS_OST + wid * 4096);
#pragma unroll
        for (int rr = 0; rr < 16; ++rr) { const int orow = crow(rr, hi);
#pragma unroll
            for (int dh = 0; dh < 2; ++dh) stg[orow * 64 + dh * 32 + r32] = (bf16)f2bf(o[dh][rr]); }
        LDS_WAIT(); asm volatile("" ::: "memory");
#pragma unroll
        for (int i4 = 0; i4 < 4; ++i4) { const int row = i4 * 8 + (lane >> 3), ch = lane & 7; const u32x4 v = *(const LAS u32x4*)(stg + row * 64 + ch * 8);
            const int i = qb * 256 + 32 * wid + row, t = (i << dsh) + r;
            *(GAS u32x4*)(O + ((size_t)b * SEQ + t) * D + h * 64 + ch * 8) = v; }
    }
    LDS_WAIT(); __syncthreads();
  }
}
}

__global__ void __launch_bounds__(NWAVES * 64, 2) fwd_megakernel(Args args) {
    extern __shared__ __attribute__((aligned(16))) unsigned char lds[];
    Frame F;
    F.lds = (LAS unsigned char*)lds;
    F.tid = threadIdx.x; F.lane = F.tid & 63; F.wave = __builtin_amdgcn_readfirstlane(F.tid >> 6);
    F.G = gridDim.x; { const int bx = blockIdx.x; F.vcu = (F.G % 8 == 0) ? (bx % 8) * (F.G / 8) + bx / 8 : bx; }
    unsigned char* ws = args.ws;
    const int lo = args.ph_lo, hi = args.ph_hi;
    const bool one_launch = (hi - lo) > 1;
    volatile LAS unsigned* bst = (volatile LAS unsigned*)(F.lds + 131072 + 1024);
    if (F.tid < 2) bst[F.tid] = 0u;
    __syncthreads();
    XcdBarrier bar; bar.bar = (unsigned*)(ws + WS_CTL) + CW_BAR; bar.x = 0; bar.st = bst;
    if (one_launch) bar = xcd_barrier_post((unsigned*)(ws + WS_CTL) + CW_BAR, bst);
#define IN(k) (lo <= (k) && (k) < hi)
#define SEAM(k) do { if (IN(k) && IN((k) + 1)) { xcd_barrier(bar); } } while (0)

    if (lo < 0) cg::this_grid().sync();
    float* resid = args.out;
    float* ssb = (float*)(ws + WS_SS);
    bf16* xb = (bf16*)(ws + WS_XB);
    bf16* zo = (bf16*)(ws + WS_ZO);
    bf16* big = (bf16*)(ws + WS_BIG);

    bool fused_done = false;
    const bool defer_late = one_launch && IN(0) && IN(4) && (F.G == 256);
    if (IN(0)) { p0_prologue(F, args, defer_late); }
    SEAM(0);
    if (IN(1)) {
        pg8::Gemm g{big, (const bf16*)(ws + WS_WIN), M, D, D, D, D, (size_t)M * D * 2};
        pg8::StaticOrder S; S.init(M, D, F.G, (int)blockIdx.x);
        pg8::EpiBf16 E{zo, D};
        pg8::gemm_phase<pg8::EpiBf16, pg8::StaticOrder, true>(F.lds, g, S, E);
    }
    SEAM(1);
    if (IN(3)) {
        pg8::Gemm g{zo, (const bf16*)(ws + WS_WPO), M, D, D, D, D, 0};
        pg8::StaticOrder S; S.init(M, D, F.G, (int)blockIdx.x);
        pg8::EpiRes<true> E{args.in[0], xb, ssb, nullptr};
        pg8::gemm_phase<pg8::EpiRes<true>, pg8::StaticOrder, true>(F.lds, g, S, E);
    }
    SEAM(3);
#pragma unroll 1
    for (int layer = 0; layer < 2; ++layer) {
        const int pb = layer == 0 ? 4 : 10;
        if (IN(pb)) {
            pg8::Gemm g{xb, (const bf16*)(ws + (layer == 0 ? WS_WGU0 : WS_WGU1)), M, 2 * FF, D, D, D, 0};
            pg8::StaticOrder S; S.init(M, 2 * FF, F.G, (int)blockIdx.x);
            pg8::Unit u0; const pg8::RsTab rt = fill_rstd_tab(F.lds, ssb, S.next(0, u0) ? u0.pm : 0);
            pg8::EpiSwiGLU E{big, ssb, FF, rt};
            pg8::gemm_phase<pg8::EpiSwiGLU, pg8::StaticOrder, true>(F.lds, g, S, E);
            if (layer == 0 && defer_late && (int)blockIdx.x >= 128) late_prep(args, F.lds, (int)blockIdx.x - 128, 128);
        }
        SEAM(pb);
#ifndef FUSE_FINAL
#define FUSE_FINAL 1
#endif
        const bool fuse_final = FUSE_FINAL && (layer == 1) && one_launch && IN(12) && (F.G == (M / 256) * (D / 256));
        if (IN(pb + 1)) {
            pg8::Gemm g{big, (const bf16*)(ws + (layer == 0 ? WS_WD0 : WS_WD1)), M, D, FF, FF, FF, 0};
            pg8::StaticOrder S; S.init(M, D, F.G, (int)blockIdx.x);
            if (fuse_final) { EpiFinal E{xb, resid, ssb, args.in[3], bar}; pg8::gemm_phase<EpiFinal, pg8::StaticOrder, true>(F.lds, g, S, E); }
            else { pg8::EpiRes<false> E{nullptr, xb, ssb, nullptr}; pg8::gemm_phase<pg8::EpiRes<false>, pg8::StaticOrder, true>(F.lds, g, S, E); }
        }
        if (fuse_final) { fused_done = true; break; }
        SEAM(pb + 1);
        if (layer == 0) {
            bf16* qb_ = big; bf16* kb_ = big + (size_t)M * D; bf16* vb_ = big + 2 * (size_t)M * D;
            if (IN(6)) {
                pg8::Gemm g{xb, (const bf16*)(ws + WS_WQKV), M, 3 * D, D, D, D, 0};
                pg8::StaticOrder S; S.init(M, 3 * D, F.G, (int)blockIdx.x);
                pg8::Unit u0; const pg8::RsTab rt = fill_rstd_tab(F.lds, ssb, S.next(0, u0) ? u0.pm : 0);
                pg8::EpiQKV E{qb_, ssb, (const float*)(ws + WS_ROPE), rt};
                pg8::gemm_phase<pg8::EpiQKV, pg8::StaticOrder, true>(F.lds, g, S, E);
            }
            SEAM(6);
            if (IN(7)) {
                const int ipw = (1024 + F.G - 1) / F.G;
                const int it0 = F.vcu * ipw, nit = it0 >= 1024 ? 0 : (1024 - it0 < ipw ? 1024 - it0 : ipw);
                att::attn_phase(it0, nit, qb_, kb_, vb_, zo, (float*)(ws + WS_LSE), F.lds);
            }
            SEAM(7);
            const bool merge_fused = one_launch && IN(8) && IN(9) && (F.G == (M / 256) * (D / 256));
            if (IN(8) && !merge_fused) {
                int tid8 = threadIdx.x; asm volatile("" : "+v"(tid8)); const int lane8 = tid8 & 63, wave8 = __builtin_amdgcn_readfirstlane(tid8 >> 6);
                const float* lse = (const float*)(ws + WS_LSE);
                for (int m = F.vcu * NWAVES + wave8; m < M; m += F.G * NWAVES) {
                    float L[16];
#pragma unroll
                    for (int q4 = 0; q4 < 4; ++q4) { const f32x4 v = *(const GAS f32x4*)(lse + (size_t)m * 16 + 4 * q4); L[4 * q4] = v[0]; L[4 * q4 + 1] = v[1]; L[4 * q4 + 2] = v[2]; L[4 * q4 + 3] = v[3]; }
                    float lg[3];
                    { float mx = L[0];
_Pragma("unroll") for (int i = 1; i < 6; ++i) mx = fmaxf(mx, L[i]); float s = 0.f;
_Pragma("unroll") for (int i = 0; i < 6; ++i) s += __expf(L[i] - mx); lg[0] = mx + __logf(s) - 1.791759469228055f; }
                    { float mx = L[6];
_Pragma("unroll") for (int i = 7; i < 11; ++i) mx = fmaxf(mx, L[i]); float s = 0.f;
_Pragma("unroll") for (int i = 6; i < 11; ++i) s += __expf(L[i] - mx); lg[1] = mx + __logf(s) - 1.6094379124341003f; }
                    { float mx = L[11];
_Pragma("unroll") for (int i = 12; i < 16; ++i) mx = fmaxf(mx, L[i]); float s = 0.f;
_Pragma("unroll") for (int i = 11; i < 16; ++i) s += __expf(L[i] - mx); lg[2] = mx + __logf(s) - 1.6094379124341003f; }
                    const float mx = fmaxf(lg[0], fmaxf(lg[1], lg[2]));
                    const float e0 = __expf(lg[0] - mx), e1 = __expf(lg[1] - mx), e2 = __expf(lg[2] - mx); const float is = 3.0f / (e0 + e1 + e2);
                    const int head = lane8 >> 2; const float sc = (head < 6 ? e0 : (head < 11 ? e1 : e2)) * is;
                    GAS v4u* p = (GAS v4u*)(zo + (size_t)m * D + 16 * lane8);
#pragma unroll
                    for (int q2 = 0; q2 < 2; ++q2) { v4u w = p[q2];
                        w.x = pk2(bflo(w.x) * sc, bfhi(w.x) * sc); w.y = pk2(bflo(w.y) * sc, bfhi(w.y) * sc); w.z = pk2(bflo(w.z) * sc, bfhi(w.z) * sc); w.w = pk2(bflo(w.w) * sc, bfhi(w.w) * sc);
                        p[q2] = w; }
                }
            }
            if (!merge_fused) SEAM(8);
            if (IN(9)) {
                pg8::Gemm g{zo, (const bf16*)(ws + WS_WAO), M, D, D, D, D, 0};
                pg8::StaticOrder S; S.init(M, D, F.G, (int)blockIdx.x);
                if (merge_fused) { pg8::Unit u0; const LAS float* st = seg_fill(F.lds, (const float*)(ws + WS_LSE), S.next(0, u0) ? u0.pm : 0);
                    pg8::EpiRes<false, true> E{nullptr, xb, ssb, st + 512};
                    pg8::gemm_phase<pg8::EpiRes<false, true>, pg8::StaticOrder, true, true>(F.lds, g, S, E, st); }
                else { pg8::EpiRes<false> E{nullptr, xb, ssb, nullptr};
                    pg8::gemm_phase<pg8::EpiRes<false>, pg8::StaticOrder, true>(F.lds, g, S, E); }
            }
            SEAM(9);
        }
    }
    if (IN(12) && !fused_done) {
        const float* gf = args.in[3];
        int tid12 = threadIdx.x; asm volatile("" : "+v"(tid12)); const int lane12 = tid12 & 63, wave12 = __builtin_amdgcn_readfirstlane(tid12 >> 6);
        for (int m = F.vcu * NWAVES + wave12; m < M; m += F.G * NWAVES) {
            float s = 0.f;
#pragma unroll
            for (int q4 = 0; q4 < 4; ++q4) { const f32x4 v = *(const GAS f32x4*)(ssb + (size_t)m * 16 + 4 * q4); s += (v[0] + v[1]) + (v[2] + v[3]); }
            const float rstd = rsqrtf(s * (1.0f / D) + 1e-6f);
            const GAS v4u* xr = (const GAS v4u*)(xb + (size_t)m * D + 16 * lane12);
            GAS f32x4* orow = (GAS f32x4*)(resid + (size_t)m * D + 16 * lane12);
#pragma unroll
            for (int q2 = 0; q2 < 2; ++q2) { const v4u w = xr[q2]; const GAS f32x4* gq = (const GAS f32x4*)(gf + 16 * lane12 + 8 * q2);
                orow[2 * q2] = (f32x4){bflo(w.x), bfhi(w.x), bflo(w.y), bfhi(w.y)} * rstd * gq[0];
                orow[2 * q2 + 1] = (f32x4){bflo(w.z), bfhi(w.z), bflo(w.w), bfhi(w.w)} * rstd * gq[1]; }
        }
    }
#undef IN
#undef SEAM
}

extern "C" void kernel_launch(void* const* d_in, const int* in_sizes, int n_in, void* d_out, int out_size, void* d_ws, size_t ws_size, hipStream_t stream) {
    static int grid = 0;
    if (grid == 0) {
        if (n_in != 13 || in_sizes[0] != M * D || out_size != M * D || ws_size < WS_END) { fprintf(stderr, "kernel_launch: unexpected shapes (n_in %d, in0 %d, out %d, ws %zu); nothing launched\n", n_in, n_in > 0 ? in_sizes[0] : -1, out_size, ws_size); grid = -1; return; }
        int dev = 0, cus = 0, per_cu = 0;
        if (hipGetDevice(&dev) != hipSuccess || hipDeviceGetAttribute(&cus, hipDeviceAttributeMultiprocessorCount, dev) != hipSuccess) { grid = -1; return; }
        if (hipFuncSetAttribute((const void*)fwd_megakernel, hipFuncAttributeMaxDynamicSharedMemorySize, LDS_BYTES) != hipSuccess) { fprintf(stderr, "kernel_launch: hipFuncSetAttribute failed\n"); grid = -1; return; }
        if (hipOccupancyMaxActiveBlocksPerMultiprocessor(&per_cu, (const void*)fwd_megakernel, NWAVES * 64, LDS_BYTES) != hipSuccess || per_cu < 1) { fprintf(stderr, "kernel_launch: occupancy query says %d blocks per CU\n", per_cu); per_cu = 1; }
        (void)hipGetLastError();
        grid = cus;
    }
    if (grid < 0) return;
    if (hipMemsetAsync((char*)d_ws + WS_CTL, 0, CTL_ZERO_BYTES, stream) != hipSuccess) { fprintf(stderr, "kernel_launch: memset failed\n"); return; }
    Args a{};
    for (int i = 0; i < 13; ++i) a.in[i] = (const float*)d_in[i];
    a.out = (float*)d_out; a.ws = (unsigned char*)d_ws;
#if MK_N_LAUNCHES == 1
    a.ph_lo = 0; a.ph_hi = 13;
    void* kargs[] = {&a};
    hipError_t e = hipLaunchCooperativeKernel((const void*)fwd_megakernel, dim3(grid), dim3(NWAVES * 64), kargs, LDS_BYTES, stream);
    if (e != hipSuccess) fprintf(stderr, "kernel_launch: cooperative launch failed: %s (grid %d)\n", hipGetErrorString(e), grid);
#else
    for (int p = 0; p < 13; ++p) { a.ph_lo = p; a.ph_hi = p + 1; hipLaunchKernelGGL(fwd_megakernel, dim3(grid), dim3(NWAVES * 64), LDS_BYTES, stream, a); }
#endif
}
```

```cpp
#include <hip/hip_runtime.h>
#include <hip/hip_cooperative_groups.h>
#include <cstdio>
#include <cstdint>
namespace cg = cooperative_groups;

#ifndef MK_N_LAUNCHES
#define MK_N_LAUNCHES 1
#endif

namespace pg8 {
#define PG8_LAS __attribute__((address_space(3)))
typedef unsigned short bf16_t;
typedef short bf16x8 __attribute__((ext_vector_type(8)));
typedef float f32x4 __attribute__((ext_vector_type(4)));
typedef unsigned u32x4 __attribute__((ext_vector_type(4)));
constexpr int BM = 256, BK = 64, HALF = 128, HTB = HALF * BK * 2, STAGE_BYTES = 8 * HTB, NXCD = 8, WGM = 8;

__host__ __device__ __forceinline__ int lds_byte(int r, int c) { const int st = (r >> 4) * 2 + (c >> 5), rr = r & 15, cc = c & 31, ob = rr * 64 + cc * 2; return st * 1024 + (ob ^ (((ob >> 9) & 1) << 5)); }
__host__ __device__ __forceinline__ void stage_rc(int b, int& R, int& C) { const int st = b / 1024, sb = b % 1024, swz = sb ^ (((sb >> 9) & 1) << 5); R = (st >> 1) * 16 + swz / 64; C = (st & 1) * 32 + (swz % 64) / 2; }
__host__ __device__ __forceinline__ int perm32(int rho) { const int n = rho >> 4, i = rho & 15; return 8 * (i >> 2) + 4 * n + (i & 3); }

struct Unit { int pm, pn; };
struct Gemm { const bf16_t* A; const bf16_t* Bt; int M, N, K, lda, ldb; size_t a_pn_bytes; };

struct StaticOrder {
    int nM, nN, nwg, G, c;
    __host__ __device__ void init(int M, int N, int G_, int c_) { nM = M / BM; nN = N / BM; nwg = nM * nN; G = G_; c = c_; }
    __host__ __device__ bool next(int i, Unit& u) const {
        const long L = (long)i * G + c; if (L >= nwg) return false;
        int wgid = (int)L; { const int q = nwg / NXCD, r = nwg % NXCD, xcd = wgid % NXCD, off = wgid / NXCD; wgid = (xcd < r ? xcd * (q + 1) : r * (q + 1) + (xcd - r) * q) + off; }
        const int nig = WGM * nN, gid = wgid / nig, fm = gid * WGM, gsz = (nM - fm) < WGM ? (nM - fm) : WGM;
        u.pm = fm + ((wgid % nig) % gsz); u.pn = (wgid % nig) / gsz; return true;
    }
};

__device__ __forceinline__ unsigned cvt_pk_bf16(float lo, float hi) { unsigned r; asm volatile("v_cvt_pk_bf16_f32 %0, %1, %2" : "=v"(r) : "v"(lo), "v"(hi)); return r; }

constexpr float RMS_EPS = 1e-6f;

struct EpiBf16 {
    bf16_t* O; int ldc;
    __device__ __forceinline__ void operator()(const f32x4 (&acc)[2][2][4][2], const Unit& u, int wr, int wc, int fr, int fq) const {
        const int row0 = u.pm * BM + wr * 64 + fr, col0 = u.pn * BM + wc * 32 + 8 * fq;
#pragma unroll
        for (int ai = 0; ai < 2; ++ai)
#pragma unroll
            for (int m = 0; m < 4; ++m) { bf16_t* rowp = O + (size_t)(row0 + ai * HALF + m * 16) * ldc + col0;
#pragma unroll
                for (int bj = 0; bj < 2; ++bj) { const f32x4 v0 = acc[ai][bj][m][0], v1 = acc[ai][bj][m][1];
                    u32x4 w; w.x = cvt_pk_bf16(v0[0], v0[1]); w.y = cvt_pk_bf16(v0[2], v0[3]); w.z = cvt_pk_bf16(v1[0], v1[1]); w.w = cvt_pk_bf16(v1[2], v1[3]);
                    *(u32x4*)(rowp + bj * HALF) = w; } }
    }
};
__device__ __forceinline__ float bf_lo(unsigned w) { return __builtin_bit_cast(float, w << 16); }
__device__ __forceinline__ float bf_hi(unsigned w) { return __builtin_bit_cast(float, w & 0xffff0000u); }
template <bool BASE_F32, bool SCALE = false> struct EpiRes {
    const float* basef; bf16_t* xb; float* ss; const PG8_LAS float* ctab;
    __device__ __forceinline__ void load_base(int row, int col0, f32x4 (&nb)[4]) const {
        if (BASE_F32) { const float* bp = basef + (size_t)row * 1024 + col0; nb[0] = *(const f32x4*)(bp); nb[1] = *(const f32x4*)(bp + 4); nb[2] = *(const f32x4*)(bp + HALF); nb[3] = *(const f32x4*)(bp + HALF + 4); }
        else { const bf16_t* bp = xb + (size_t)row * 1024 + col0; const u32x4 a = *(const u32x4*)(bp), c = *(const u32x4*)(bp + HALF);
            nb[0] = (f32x4){bf_lo(a.x), bf_hi(a.x), bf_lo(a.y), bf_hi(a.y)}; nb[1] = (f32x4){bf_lo(a.z), bf_hi(a.z), bf_lo(a.w), bf_hi(a.w)};
            nb[2] = (f32x4){bf_lo(c.x), bf_hi(c.x), bf_lo(c.y), bf_hi(c.y)}; nb[3] = (f32x4){bf_lo(c.z), bf_hi(c.z), bf_lo(c.w), bf_hi(c.w)}; }
    }
    __device__ __forceinline__ void operator()(const f32x4 (&acc)[2][2][4][2], const Unit& u, int wr, int wc, int fr, int fq) const {
        const int row0 = u.pm * BM + wr * 64 + fr, col0 = u.pn * BM + wc * 32 + 8 * fq;
        f32x4 nb[4];
        load_base(row0, col0, nb);
#pragma unroll
        for (int it = 0; it < 8; ++it) { const int ai = it >> 2, m = it & 3;
            const size_t row = (size_t)(row0 + ai * HALF + m * 16); const size_t off = row * 1024 + col0; float s = 0.f;
            const f32x4 b0 = nb[0], b1 = nb[1], b2 = nb[2], b3 = nb[3];
            if (it < 7) load_base(row0 + ((it + 1) >> 2) * HALF + ((it + 1) & 3) * 16, col0, nb);
            const float cs = SCALE ? ctab[wr * 64 + fr + ai * HALF + m * 16] : 1.0f;
#pragma unroll
            for (int bj = 0; bj < 2; ++bj) {
                const f32x4 v0 = acc[ai][bj][m][0] * cs + (bj == 0 ? b0 : b2), v1 = acc[ai][bj][m][1] * cs + (bj == 0 ? b1 : b3);
                s += (v0[0] * v0[0] + v0[1] * v0[1]) + (v0[2] * v0[2] + v0[3] * v0[3]) + (v1[0] * v1[0] + v1[1] * v1[1]) + (v1[2] * v1[2] + v1[3] * v1[3]);
                u32x4 w; w.x = cvt_pk_bf16(v0[0], v0[1]); w.y = cvt_pk_bf16(v0[2], v0[3]); w.z = cvt_pk_bf16(v1[0], v1[1]); w.w = cvt_pk_bf16(v1[2], v1[3]);
                *(u32x4*)(xb + off + bj * HALF) = w; }
            s += __shfl_xor(s, 16); s += __shfl_xor(s, 32);
            if (fq == 0) ss[row * 16 + u.pn * 4 + wc] = s; }
    }
};
struct RsTab { const PG8_LAS float* tab; int pm; };
__device__ __forceinline__ float row_rstd(const float* ss, size_t row, int fq) {
    const f32x4 p = *(const f32x4*)(ss + row * 16 + 4 * fq); float s = (p[0] + p[1]) + (p[2] + p[3]);
    s += __shfl_xor(s, 16); s += __shfl_xor(s, 32);
    return rsqrtf(s * (1.0f / 1024.0f) + RMS_EPS);
}
struct EpiSwiGLU {
    bf16_t* act; const float* ss; int ldc; RsTab rt;
    __device__ __forceinline__ void operator()(const f32x4 (&acc)[2][2][4][2], const Unit& u, int wr, int wc, int fr, int fq) const {
        const int row0 = u.pm * BM + wr * 64 + fr, col0 = u.pn * HALF + wc * 32 + 8 * fq;
        const bool use_tab = (u.pm == rt.pm);
#pragma unroll
        for (int ai = 0; ai < 2; ++ai)
#pragma unroll
            for (int m = 0; m < 4; ++m) { const size_t row = (size_t)(row0 + ai * HALF + m * 16); float rstd; if (__builtin_expect(use_tab, 1)) rstd = rt.tab[wr * 64 + fr + ai * HALF + m * 16]; else { asm volatile("; rstd from global (grid != 256)" ::: "memory"); rstd = row_rstd(ss, row, fq); }
                float a[8];
#pragma unroll
                for (int n = 0; n < 2; ++n)
#pragma unroll
                    for (int i = 0; i < 4; ++i) { const float g = acc[ai][0][m][n][i] * rstd, up = acc[ai][1][m][n][i] * rstd;
                        a[n * 4 + i] = g * up * __builtin_amdgcn_rcpf(1.0f + __builtin_amdgcn_exp2f(-1.4426950408889634f * g)); }
                u32x4 w; w.x = cvt_pk_bf16(a[0], a[1]); w.y = cvt_pk_bf16(a[2], a[3]); w.z = cvt_pk_bf16(a[4], a[5]); w.w = cvt_pk_bf16(a[6], a[7]);
                *(u32x4*)(act + row * ldc + col0) = w; }
    }
};
struct EpiQKV {
    bf16_t* qkv; const float* ss; const float* rope; RsTab rt;
    __device__ __forceinline__ void operator()(const f32x4 (&acc)[2][2][4][2], const Unit& u, int wr, int wc, int fr, int fq) const {
        const int row0 = u.pm * BM + wr * 64 + fr; const int sect = u.pn >> 2, head = (u.pn & 3) * 4 + wc;
        const int dsh = head < 6 ? 0 : (head < 11 ? 2 : 4);
        bf16_t* dst = qkv + (size_t)sect * ((size_t)16384 * 1024);
        const float qs = sect == 0 ? 0.125f * 1.4426950408889634f : 1.0f;
        const bool use_tab = (u.pm == rt.pm);
        const bool rot = sect < 2;
        f32x4 nr[4];
        if (rot) { const float* rp = rope + (size_t)(row0 & 8191) * 64 + 8 * fq; nr[0] = *(const f32x4*)(rp); nr[1] = *(const f32x4*)(rp + 4); nr[2] = *(const f32x4*)(rp + 32); nr[3] = *(const f32x4*)(rp + 36); }
#pragma unroll
        for (int it = 0; it < 8; ++it) { const int ai = it >> 2, m = it & 3;
            const int row = row0 + ai * HALF + m * 16; float rstd; if (__builtin_expect(use_tab, 1)) rstd = rt.tab[wr * 64 + fr + ai * HALF + m * 16]; else { asm volatile("; rstd from global (grid != 256)" ::: "memory"); rstd = row_rstd(ss, (size_t)row, fq); } rstd *= qs;
            const int b = row >> 13, t = row & 8191; const int pos = ((t & ((1 << dsh) - 1)) << (13 - dsh)) + (t >> dsh);
            bf16_t* o = dst + ((size_t)(b * 16 + head) * 8192 + pos) * 64 + 8 * fq;
            const f32x4 c0 = nr[0], c1 = nr[1], s0 = nr[2], s1 = nr[3];
            if (rot && it < 7) { const int row2 = row0 + ((it + 1) >> 2) * HALF + ((it + 1) & 3) * 16; const float* rp = rope + (size_t)(row2 & 8191) * 64 + 8 * fq;
                nr[0] = *(const f32x4*)(rp); nr[1] = *(const f32x4*)(rp + 4); nr[2] = *(const f32x4*)(rp + 32); nr[3] = *(const f32x4*)(rp + 36); }
            float lo[8], hi[8];
#pragma unroll
            for (int n = 0; n < 2; ++n)
#pragma unroll
                for (int i = 0; i < 4; ++i) { lo[n * 4 + i] = acc[ai][0][m][n][i] * rstd; hi[n * 4 + i] = acc[ai][1][m][n][i] * rstd; }
            if (rot) {
#pragma unroll
                for (int i = 0; i < 8; ++i) { const float cs = i < 4 ? c0[i & 3] : c1[i & 3], sn = i < 4 ? s0[i & 3] : s1[i & 3];
                    const float l = lo[i], h = hi[i]; lo[i] = l * cs - h * sn; hi[i] = h * cs + l * sn; }
            }
            u32x4 w; w.x = cvt_pk_bf16(lo[0], lo[1]); w.y = cvt_pk_bf16(lo[2], lo[3]); w.z = cvt_pk_bf16(lo[4], lo[5]); w.w = cvt_pk_bf16(lo[6], lo[7]);
            *(u32x4*)(o) = w;
            w.x = cvt_pk_bf16(hi[0], hi[1]); w.y = cvt_pk_bf16(hi[2], hi[3]); w.z = cvt_pk_bf16(hi[4], hi[5]); w.w = cvt_pk_bf16(hi[6], hi[7]);
            *(u32x4*)(o + 32) = w; }
    }
};

template <class Epi, class Sched, bool ALIGN_EPI, bool SEG = false, bool AFTER_DRAIN = false>
__device__ __forceinline__ void gemm_phase(PG8_LAS unsigned char* lds, const Gemm g, const Sched& S, const Epi& E, const PG8_LAS float* segtab = nullptr) {
    int tid = threadIdx.x; asm volatile("" : "+v"(tid));
    const int wid = __builtin_amdgcn_readfirstlane(tid >> 6), lane = tid & 63, wr = wid >> 2, wc = wid & 3, fr = lane & 15, fq = lane >> 4;
    const int K = g.K, nt = K / BK;
    unsigned voffA[2], voffB[2];
#pragma unroll
    for (int i = 0; i < 2; ++i) { int R, C; stage_rc(tid * 16 + i * 8192, R, C); const int Rb = (R & ~31) + perm32(R & 31);
        voffA[i] = (unsigned)(R * g.lda + C) * 2u; voffB[i] = (unsigned)(Rb * g.ldb + C) * 2u; }
    const size_t kstep = (size_t)(BK * 2);
    const size_t hstepA = (size_t)HALF * g.lda * 2, hstepB = (size_t)HALF * g.ldb * 2;
    const size_t tstepA = 2 * hstepA, tstepB = 2 * hstepB;
    const unsigned ldsw = (unsigned)wid * 1024u;
    const int aoff = lds_byte(wr * 64 + fr, fq * 8), boff = lds_byte(wc * 32 + fr, fq * 8);
#define PG8_SA(b, h) (((b) * 2 + (h)) * HTB)
#define PG8_SB(b, h) ((4 + (b) * 2 + (h)) * HTB)
#define PG8_STAGE(bufoff, gbase, voff) do { _Pragma("unroll") for (int _i = 0; _i < 2; ++_i) \
        __builtin_amdgcn_global_load_lds((const unsigned*)((const char*)(gbase) + (voff)[_i]), (PG8_LAS unsigned*)(lds + (bufoff) + ldsw + _i * 8192), 16, 0, 0); } while (0)
#define PG8_LDA(dst, b, h) do { _Pragma("unroll") for (int m = 0; m < 4; ++m) _Pragma("unroll") for (int k = 0; k < 2; ++k) dst[m][k] = *(const PG8_LAS bf16x8*)(lds + PG8_SA(b, h) + aoff + m * 2048 + k * 1024); } while (0)
#define PG8_LDB(dst, b, h) do { _Pragma("unroll") for (int n = 0; n < 2; ++n) _Pragma("unroll") for (int k = 0; k < 2; ++k) dst[n][k] = *(const PG8_LAS bf16x8*)(lds + PG8_SB(b, h) + boff + n * 2048 + k * 1024); } while (0)
#define PG8_MMA(ai, bj, At, Bt) do { __builtin_amdgcn_s_setprio(1); _Pragma("unroll") for (int m = 0; m < 4; ++m) _Pragma("unroll") for (int n = 0; n < 2; ++n) _Pragma("unroll") for (int k = 0; k < 2; ++k) \
        acc[ai][bj][m][n] = __builtin_amdgcn_mfma_f32_16x16x32_bf16(Bt[n][k], At[m][k], acc[ai][bj][m][n], 0, 0, 0); __builtin_amdgcn_s_setprio(0); } while (0)
#define PG8_SEGSCALE(tb) do { _Pragma("unroll") for (int ai = 0; ai < 2; ++ai) _Pragma("unroll") for (int m = 0; m < 4; ++m) { const float f_ = (tb)[wr * 64 + fr + ai * HALF + m * 16]; \
        _Pragma("unroll") for (int bj = 0; bj < 2; ++bj) _Pragma("unroll") for (int n = 0; n < 2; ++n) acc[ai][bj][m][n] = acc[ai][bj][m][n] * f_; } } while (0)
#define PG8_WAIT_V(n) asm volatile("s_waitcnt vmcnt(" #n ")" ::: "memory")
#define PG8_WAIT_L(n) asm volatile("s_waitcnt lgkmcnt(" #n ")" ::: "memory")
#define PG8_BAR __builtin_amdgcn_s_barrier()
#define PG8_SCHED __builtin_amdgcn_sched_barrier(0)
    Unit cur, nxt; int ui = 0;
    if (!S.next(0, cur)) return;
    f32x4 acc[2][2][4][2];
#pragma unroll
    for (int a = 0; a < 2; ++a)
#pragma unroll
        for (int b = 0; b < 2; ++b)
#pragma unroll
            for (int m = 0; m < 4; ++m)
#pragma unroll
                for (int n = 0; n < 2; ++n) acc[a][b][m][n] = (f32x4){0.f, 0.f, 0.f, 0.f};
    bf16x8 At[4][2], B0[2][2], B1[2][2];
    const char* cA = (const char*)g.A + (size_t)cur.pm * tstepA + (size_t)cur.pn * g.a_pn_bytes; const char* cB = (const char*)g.Bt + (size_t)cur.pn * tstepB;
    PG8_STAGE(PG8_SB(0, 0), cB, voffB); PG8_STAGE(PG8_SB(0, 1), cB + hstepB, voffB); PG8_STAGE(PG8_SA(0, 0), cA, voffA); PG8_STAGE(PG8_SA(0, 1), cA + hstepA, voffA);
    if (wr == 1) PG8_BAR;
    PG8_WAIT_V(2); PG8_BAR;
    PG8_STAGE(PG8_SB(1, 0), cB + kstep, voffB); PG8_STAGE(PG8_SA(1, 0), cA + kstep, voffA); PG8_STAGE(PG8_SB(1, 1), cB + hstepB + kstep, voffB);
    PG8_WAIT_V(6); PG8_BAR;
    for (;;) {
        const bool has_next = S.next(ui + 1, nxt);
        const char* nA = has_next ? (const char*)g.A + (size_t)nxt.pm * tstepA + (size_t)nxt.pn * g.a_pn_bytes : cA; const char* nB = has_next ? (const char*)g.Bt + (size_t)nxt.pn * tstepB : cB;
        for (int t = 0; t < nt; t += 2) {
            const bool last = (t == nt - 2);
            const char* a1 = cA + (size_t)(t + 1) * kstep;
            const char* a2 = last ? nA : cA + (size_t)(t + 2) * kstep; const char* b2 = last ? nB : cB + (size_t)(t + 2) * kstep;
            const char* a3 = a2 + kstep; const char* b3 = b2 + kstep;
            if constexpr (SEG) { if (t == 6) PG8_SEGSCALE(segtab); }
            PG8_LDB(B0, 0, 0); PG8_LDB(B1, 0, 1); PG8_SCHED; PG8_LDA(At, 0, 0); PG8_STAGE(PG8_SA(1, 1), a1 + hstepA, voffA);
            PG8_WAIT_V(8); PG8_WAIT_L(0); PG8_BAR; PG8_MMA(0, 0, At, B0); PG8_MMA(0, 1, At, B1); PG8_BAR; PG8_SCHED;
            PG8_LDA(At, 0, 1); PG8_STAGE(PG8_SB(0, 0), b2, voffB); PG8_STAGE(PG8_SB(0, 1), b2 + hstepB, voffB); PG8_STAGE(PG8_SA(0, 0), a2, voffA);
            PG8_WAIT_V(8); PG8_WAIT_L(0); PG8_BAR; PG8_MMA(1, 0, At, B0); PG8_MMA(1, 1, At, B1); PG8_BAR; PG8_SCHED;
            if constexpr (SEG) { if (t == 10) PG8_SEGSCALE(segtab + 256); }
            PG8_LDB(B0, 1, 0); PG8_LDB(B1, 1, 1); PG8_SCHED; PG8_LDA(At, 1, 0); PG8_STAGE(PG8_SA(0, 1), a2 + hstepA, voffA);
            PG8_WAIT_V(8); PG8_WAIT_L(0); PG8_BAR; PG8_MMA(0, 0, At, B0); PG8_MMA(0, 1, At, B1); PG8_BAR; PG8_SCHED;
            PG8_LDA(At, 1, 1); PG8_STAGE(PG8_SB(1, 0), b3, voffB); PG8_STAGE(PG8_SB(1, 1), b3 + hstepB, voffB); PG8_STAGE(PG8_SA(1, 0), a3, voffA);
            PG8_WAIT_V(8); PG8_WAIT_L(0); PG8_BAR; PG8_MMA(1, 0, At, B0); PG8_MMA(1, 1, At, B1); PG8_BAR; PG8_SCHED;
        }
        if constexpr (ALIGN_EPI) { if (wr == 0) PG8_BAR; }
        if constexpr (!AFTER_DRAIN) E(acc, cur, wr, wc, fr, fq);
        if (!has_next) break;
#pragma unroll
        for (int a = 0; a < 2; ++a)
#pragma unroll
            for (int b = 0; b < 2; ++b)
#pragma unroll
                for (int m = 0; m < 4; ++m)
#pragma unroll
                    for (int n = 0; n < 2; ++n) acc[a][b][m][n] = (f32x4){0.f, 0.f, 0.f, 0.f};
        cur = nxt; cA = nA; cB = nB; ++ui;
        if constexpr (ALIGN_EPI) { if (wr == 1) PG8_BAR; }
    }
    PG8_WAIT_V(0);
    if constexpr (!ALIGN_EPI) { if (wr == 0) PG8_BAR; }
    PG8_BAR;
    if constexpr (AFTER_DRAIN) E(acc, cur, wr, wc, fr, fq);
#undef PG8_SA
#undef PG8_SB
#undef PG8_STAGE
#undef PG8_LDA
#undef PG8_LDB
#undef PG8_MMA
#undef PG8_WAIT_V
#undef PG8_SEGSCALE
#undef PG8_WAIT_L
#undef PG8_BAR
#undef PG8_SCHED
}
}

constexpr int NWAVES = 8;
constexpr int BATCH = 2, SEQ = 8192, D = 1024, H = 16, HD = 64, FF = 2816;
constexpr int M = BATCH * SEQ;
constexpr size_t MiB = 1u << 20;
constexpr size_t WS_CTL = 0, CTL_ZERO_BYTES = 128 * 1024;
constexpr int CW_HALO = 8192;
constexpr size_t WS_ROPE = 1 * MiB;
constexpr size_t WS_SS = 3 * MiB;
constexpr size_t WS_LSE = 4 * MiB;
constexpr size_t WS_WIN = 6 * MiB;
constexpr size_t WS_WG = 8 * MiB;
constexpr size_t WS_WPO = 9 * MiB;
constexpr size_t WS_WGU0 = 11 * MiB;
constexpr size_t WS_WD0 = 22 * MiB;
constexpr size_t WS_WQKV = 28 * MiB;
constexpr size_t WS_WAO = 34 * MiB;
constexpr size_t WS_WGU1 = 36 * MiB;
constexpr size_t WS_WD1 = 47 * MiB;
constexpr size_t WS_BIG = 56 * MiB;
constexpr size_t WS_XB = 184 * MiB;
constexpr size_t WS_ZO = 216 * MiB;
constexpr size_t WS_HALO = 248 * MiB;
constexpr size_t WS_END = 250 * MiB;
constexpr int CW_BAR = 1024;

constexpr int LDS_BYTES = 147456;

#define GAS __attribute__((address_space(1)))
#define LAS __attribute__((address_space(3)))
typedef unsigned short bf16;
typedef unsigned v4u __attribute__((ext_vector_type(4)));
typedef unsigned v2u __attribute__((ext_vector_type(2)));
typedef float f32x4 __attribute__((ext_vector_type(4)));
#define LDS_WAIT() asm volatile("s_waitcnt lgkmcnt(0)" ::: "memory")
__device__ __forceinline__ unsigned f2bf(float f) { unsigned u = __builtin_bit_cast(unsigned, f); return (u + 0x7fffu + ((u >> 16) & 1u)) >> 16; }
__device__ __forceinline__ unsigned pk2(float lo, float hi) { return f2bf(lo) | (f2bf(hi) << 16); }
__device__ __forceinline__ float bflo(unsigned w) { return __builtin_bit_cast(float, w << 16); }
__device__ __forceinline__ float bfhi(unsigned w) { return __builtin_bit_cast(float, w & 0xffff0000u); }

#define XB_TMO      128
#define XB_XCNT(j)  (256  + 64 * (j))
#define XB_XSUB(j)  (1280 + 64 * (j))
#define XB_XGEN(j)  (2304 + 64 * (j))
#define XB_TOP      3328
#define XB_TOPGEN   3392
#define XCD_BAR_WORDS 3456
#define XB_SPIN_CAP (1u << 22)
__device__ __forceinline__ unsigned xb_ld(unsigned* p)              { return __hip_atomic_load(p, __ATOMIC_RELAXED, __HIP_MEMORY_SCOPE_AGENT); }
__device__ __forceinline__ unsigned xb_add(unsigned* p, unsigned v) { return __hip_atomic_fetch_add(p, v, __ATOMIC_RELAXED, __HIP_MEMORY_SCOPE_AGENT); }
__device__ __forceinline__ unsigned xb_xcc_id() { return (unsigned)__builtin_amdgcn_s_getreg((3 << 11) | 20) & 0xFu; }
#define XB_SPIN(cond, bar) do { unsigned _sp = 0; while (cond) { __builtin_amdgcn_s_sleep(1); \
    if ((++_sp & 255u) == 0u) { if (xb_ld(&(bar)[XB_TMO])) break; if (_sp > XB_SPIN_CAP) { atomicAdd(&(bar)[XB_TMO], 1u); break; } } } } while (0)
struct XcdBarrier { unsigned* bar; unsigned x; volatile LAS unsigned* st; };
__device__ __forceinline__ XcdBarrier xcd_barrier_post(unsigned* bar, volatile LAS unsigned* st) {
    XcdBarrier b; b.bar = bar; b.x = xb_xcc_id(); b.st = st;
    if (threadIdx.x == 0) (void)xb_add(&bar[XB_XCNT(b.x)], 1u);
    return b;
}
__device__ __forceinline__ void xcd_barrier_complete(unsigned* bar, unsigned x, unsigned& nloc, unsigned& nx) {
    const unsigned G = gridDim.x * gridDim.y * gridDim.z;
    unsigned sum, cnt, mine, sp = 0u;
    for (;;) {
        sum = 0u; cnt = 0u; mine = 0u;
#pragma unroll
        for (unsigned j = 0; j < 16; ++j) { const unsigned c = xb_ld(&bar[XB_XCNT(j)]); sum += c; cnt += (c > 0u) ? 1u : 0u; mine = (j == x) ? c : mine; }
        if (sum == G) break;
        __builtin_amdgcn_s_sleep(1);
        if ((++sp & 255u) == 0u) { if (xb_ld(&bar[XB_TMO])) break; if (sp > XB_SPIN_CAP) { atomicAdd(&bar[XB_TMO], 1u); break; } }
    }
    nloc = mine > 0u ? mine : 1u; nx = cnt > 0u ? cnt : 1u;
}
__device__ __forceinline__ void xcd_barrier(const XcdBarrier& b) {
    asm volatile("s_waitcnt vmcnt(0)" ::: "memory");
    __syncthreads();
    if (threadIdx.x == 0) {
        unsigned* bar = b.bar;
        __builtin_amdgcn_s_waitcnt(0);
        unsigned nloc = b.st[0], nx = b.st[1];
        if (nloc == 0u) { xcd_barrier_complete(bar, b.x, nloc, nx); b.st[0] = nloc; b.st[1] = nx; }
        const unsigned old = xb_add(&bar[XB_XSUB(b.x)], 1u);
        const unsigned gen = old / nloc;
        if (old + 1u == (gen + 1u) * nloc) {
            __builtin_amdgcn_fence(__ATOMIC_RELEASE, "agent");
            asm volatile("s_waitcnt vmcnt(0)" ::: "memory");
            const unsigned og = xb_add(&bar[XB_TOP], 1u);
            const unsigned tg = og / nx;
            if (og + 1u == (tg + 1u) * nx) xb_add(&bar[XB_TOPGEN], 1u);
            else XB_SPIN(xb_ld(&bar[XB_TOPGEN]) == tg, bar);
            __builtin_amdgcn_fence(__ATOMIC_ACQUIRE, "agent");
            xb_add(&bar[XB_XGEN(b.x)], 1u);
            asm volatile("s_waitcnt vmcnt(0)" ::: "memory");
        } else {
            XB_SPIN(xb_ld(&bar[XB_XGEN(b.x)]) == gen, bar);
            __builtin_amdgcn_fence(__ATOMIC_ACQUIRE, "agent");
            asm volatile("s_waitcnt vmcnt(0)" ::: "memory");
        }
    }
    __syncthreads();
}

struct EpiFinal {
    const bf16* xb; float* out; float* ss; const float* gf; XcdBarrier bar;
    __device__ __forceinline__ void load_base(int row, int col0, pg8::f32x4 (&nb)[4]) const {
        using pg8::f32x4; using pg8::u32x4; using pg8::bf_lo; using pg8::bf_hi;
        const bf16* bp = xb + (size_t)row * 1024 + col0; const u32x4 a = *(const u32x4*)(bp), c = *(const u32x4*)(bp + pg8::HALF);
        nb[0] = (f32x4){bf_lo(a.x), bf_hi(a.x), bf_lo(a.y), bf_hi(a.y)}; nb[1] = (f32x4){bf_lo(a.z), bf_hi(a.z), bf_lo(a.w), bf_hi(a.w)};
        nb[2] = (f32x4){bf_lo(c.x), bf_hi(c.x), bf_lo(c.y), bf_hi(c.y)}; nb[3] = (f32x4){bf_lo(c.z), bf_hi(c.z), bf_lo(c.w), bf_hi(c.w)};
    }
    __device__ __forceinline__ void operator()(pg8::f32x4 (&acc)[2][2][4][2], const pg8::Unit& u, int wr, int wc, int fr, int fq) const {
        using pg8::f32x4; using pg8::HALF; using pg8::BM;
        const int row0 = u.pm * BM + wr * 64 + fr, col0 = u.pn * BM + wc * 32 + 8 * fq;
        f32x4 nb[4];
        load_base(row0, col0, nb);
#pragma unroll
        for (int it = 0; it < 8; ++it) { const int ai = it >> 2, m = it & 3;
            const size_t row = (size_t)(row0 + ai * HALF + m * 16); float s = 0.f;
            const f32x4 b0 = nb[0], b1 = nb[1], b2 = nb[2], b3 = nb[3];
            if (it < 7) load_base(row0 + ((it + 1) >> 2) * HALF + ((it + 1) & 3) * 16, col0, nb);
#pragma unroll
            for (int bj = 0; bj < 2; ++bj) {
                const f32x4 v0 = acc[ai][bj][m][0] + (bj == 0 ? b0 : b2), v1 = acc[ai][bj][m][1] + (bj == 0 ? b1 : b3);
                acc[ai][bj][m][0] = v0; acc[ai][bj][m][1] = v1;
                s += (v0[0] * v0[0] + v0[1] * v0[1]) + (v0[2] * v0[2] + v0[3] * v0[3]) + (v1[0] * v1[0] + v1[1] * v1[1]) + (v1[2] * v1[2] + v1[3] * v1[3]); }
            s += __shfl_xor(s, 16); s += __shfl_xor(s, 32);
            if (fq == 0) ss[row * 16 + u.pn * 4 + wc] = s; }
        xcd_barrier(bar);
        f32x4 gq[2][2];
#pragma unroll
        for (int bj = 0; bj < 2; ++bj)
#pragma unroll
            for (int n = 0; n < 2; ++n) gq[bj][n] = *(const f32x4*)(gf + col0 + bj * HALF + 4 * n);
        f32x4 pr[8];
#pragma unroll
        for (int it = 0; it < 8; ++it) pr[it] = *(const f32x4*)(ss + (size_t)(row0 + (it >> 2) * HALF + (it & 3) * 16) * 16 + 4 * fq);
#pragma unroll
        for (int it = 0; it < 8; ++it) { const int ai = it >> 2, m = it & 3;
            const size_t row = (size_t)(row0 + ai * HALF + m * 16); const size_t off = row * 1024 + col0;
            float sq = (pr[it][0] + pr[it][1]) + (pr[it][2] + pr[it][3]); sq += __shfl_xor(sq, 16); sq += __shfl_xor(sq, 32);
            const float rstd = rsqrtf(sq * (1.0f / 1024.0f) + pg8::RMS_EPS);
#pragma unroll
            for (int bj = 0; bj < 2; ++bj) { *(f32x4*)(out + off + bj * HALF) = acc[ai][bj][m][0] * rstd * gq[bj][0]; *(f32x4*)(out + off + bj * HALF + 4) = acc[ai][bj][m][1] * rstd * gq[bj][1]; } }
    }
};

struct EpiPool {
    LAS unsigned char* lds; const bf16* h; const bf16* wt; bf16* p; bf16* hbuf; unsigned* flags; unsigned* tmo;
    static constexpr int PITCH = 528;
    __device__ __forceinline__ void operator()(pg8::f32x4 (&acc)[2][2][4][2], const pg8::Unit& u, int wr, int wc, int fr, int fq) const {
        using pg8::f32x4; using pg8::u32x4; using pg8::bf16x8; using pg8::cvt_pk_bf16;
        int tid = threadIdx.x; asm volatile("" : "+v"(tid)); const int lane = tid & 63; const int wid = __builtin_amdgcn_readfirstlane(tid >> 6);
#pragma unroll
        for (int ai = 0; ai < 2; ++ai)
#pragma unroll
            for (int m = 0; m < 4; ++m) { const int r = ai * 128 + wr * 64 + m * 16 + fr;
#pragma unroll
                for (int bj = 0; bj < 2; ++bj) { const f32x4 v0 = acc[ai][bj][m][0], v1 = acc[ai][bj][m][1];
                    u32x4 w; w.x = cvt_pk_bf16(v0[0], v0[1]); w.y = cvt_pk_bf16(v0[2], v0[3]); w.z = cvt_pk_bf16(v1[0], v1[1]); w.w = cvt_pk_bf16(v1[2], v1[3]);
                    *(LAS u32x4*)(lds + (16 + r) * PITCH + (bj * 128 + wc * 32 + 8 * fq) * 2) = w;
                    if (ai == 1 && m == 3 && wr == 1) {
                        bf16* hp_ = hbuf + ((size_t)(u.pm * 4 + u.pn) * 16 + fr) * 256 + bj * 128 + wc * 32 + 8 * fq;
                        asm volatile("global_store_dwordx4 %0, %1, off sc1\n\ts_nop 1" :: "v"(hp_), "v"(w) : "memory"); } } }
        asm volatile("s_waitcnt vmcnt(0)" ::: "memory");
        __syncthreads();
        if (tid == 0) __hip_atomic_store(flags + (u.pm * 4 + u.pn) * 64, 1u, __ATOMIC_RELAXED, __HIP_MEMORY_SCOPE_AGENT);
        const bool seq_start = (u.pm & 31) == 0;
        if (seq_start) { for (int e = tid; e < 16 * 32; e += 512) *(LAS u32x4*)(lds + (e >> 5) * PITCH + (e & 31) * 16) = (u32x4){0u, 0u, 0u, 0u}; }
        else {
            if (tid == 0) { unsigned* fl = flags + ((u.pm - 1) * 4 + u.pn) * 64; XB_SPIN(xb_ld(fl) == 0u, tmo);
                __builtin_amdgcn_fence(__ATOMIC_ACQUIRE, "agent"); asm volatile("s_waitcnt vmcnt(0)" ::: "memory"); }
            __syncthreads();
            const u32x4 hv = *(const GAS u32x4*)(hbuf + (size_t)((u.pm - 1) * 4 + u.pn) * 4096 + tid * 8);
            *(LAS u32x4*)(lds + (tid >> 5) * PITCH + (tid & 31) * 16) = hv;
        }
        LDS_WAIT(); __syncthreads();
        const int cq = tid & 63, seg = tid >> 6, w = 2 << u.pn;
        const LAS unsigned char* colp = lds + cq * 8;
#define EP_RD4(rowi) ({ const v2u q_ = *(const LAS v2u*)(colp + (rowi) * PITCH); (f32x4){bflo(q_.x), bfhi(q_.x), bflo(q_.y), bfhi(q_.y)}; })
        f32x4 S = {0.f, 0.f, 0.f, 0.f};
        for (int d = 1; d < w; ++d) S = S + EP_RD4(16 + 32 * seg - d);
        const float invw = 1.0f / (float)w;
        bf16* pp = p + (size_t)(u.pm * 256 + 32 * seg) * 1024 + u.pn * 256 + 4 * cq;
        const int t0 = ((u.pm & 31) * 256) + 32 * seg;
#pragma unroll 4
        for (int r = 0; r < 32; ++r) {
            const int lr = 16 + 32 * seg + r;
            const f32x4 uc = EP_RD4(lr);
            S = S + uc;
            const int t = t0 + r; const float inv = (t + 1 >= w) ? invw : 1.0f / (float)(t + 1);
            const f32x4 o = S * inv - uc;
            *(GAS v2u*)(pp + (size_t)r * 1024) = (v2u){pk2(o[0], o[1]), pk2(o[2], o[3])};
            S = S - EP_RD4(lr - (w - 1));
        }
#undef EP_RD4
        LDS_WAIT(); __syncthreads();
    }
};

struct Frame {
    LAS unsigned char* lds;
    int tid, lane, wave, vcu, G;
};
__device__ __forceinline__ float wave_sum(float v) {
#pragma unroll
    for (int o = 1; o < 64; o <<= 1) v += __shfl_xor(v, o);
    return v;
}

constexpr int LDS_RSTAB = 131072 + 4096;
__device__ __forceinline__ pg8::RsTab fill_rstd_tab(LAS unsigned char* lds, const float* ss, int pm) {
    LAS float* tab = (LAS float*)(lds + LDS_RSTAB);
    int tid = threadIdx.x; asm volatile("" : "+v"(tid));
    if (tid < 256) { const float* p = ss + ((size_t)pm * 256 + tid) * 16; float s = 0.f;
#pragma unroll
        for (int q = 0; q < 4; ++q) { const f32x4 v = *(const GAS f32x4*)(p + 4 * q); s += (v[0] + v[1]) + (v[2] + v[3]); }
        tab[tid] = rsqrtf(s * (1.0f / 1024.0f) + 1e-6f); }
    LDS_WAIT(); __syncthreads();
    pg8::RsTab r; r.tab = tab; r.pm = pm; return r;
}

__device__ __forceinline__ const LAS float* seg_fill(LAS unsigned char* lds, const float* lse, int pm) {
    LAS float* tab = (LAS float*)(lds + LDS_RSTAB);
    int tid = threadIdx.x; asm volatile("" : "+v"(tid));
    if (tid < 256) { const float* p = lse + ((size_t)pm * 256 + tid) * 16; float L[16];
#pragma unroll
        for (int q4 = 0; q4 < 4; ++q4) { const f32x4 v = *(const GAS f32x4*)(p + 4 * q4); L[4 * q4] = v[0]; L[4 * q4 + 1] = v[1]; L[4 * q4 + 2] = v[2]; L[4 * q4 + 3] = v[3]; }
        float lg0, lg1, lg2;
        { float mx = L[0];
_Pragma("unroll") for (int i = 1; i < 6; ++i) mx = fmaxf(mx, L[i]); float s = 0.f;
_Pragma("unroll") for (int i = 0; i < 6; ++i) s += __expf(L[i] - mx); lg0 = mx + __logf(s) - 1.791759469228055f; }
        { float mx = L[6];
_Pragma("unroll") for (int i = 7; i < 11; ++i) mx = fmaxf(mx, L[i]); float s = 0.f;
_Pragma("unroll") for (int i = 6; i < 11; ++i) s += __expf(L[i] - mx); lg1 = mx + __logf(s) - 1.6094379124341003f; }
        { float mx = L[11];
_Pragma("unroll") for (int i = 12; i < 16; ++i) mx = fmaxf(mx, L[i]); float s = 0.f;
_Pragma("unroll") for (int i = 11; i < 16; ++i) s += __expf(L[i] - mx); lg2 = mx + __logf(s) - 1.6094379124341003f; }
        const float mx = fmaxf(lg0, fmaxf(lg1, lg2));
        const float e0 = __expf(lg0 - mx), e1 = __expf(lg1 - mx), e2 = __expf(lg2 - mx); const float is = 3.0f / (e0 + e1 + e2);
        const float s0 = fmaxf(e0 * is, 1e-30f), s1 = fmaxf(e1 * is, 1e-30f), s2 = fmaxf(e2 * is, 1e-30f);
        tab[tid] = s0 / s1; tab[256 + tid] = s1 / s2; tab[512 + tid] = s2; }
    LDS_WAIT(); __syncthreads();
    return tab;
}

__device__ __forceinline__ int p0_map_row(int mode, int sel, int row_off, int n) {
    if (mode == 0) return row_off + n;
    if (mode == 1) return 256 * (n >> 7) + 128 * sel + (n & 127);
    const int pn = n >> 8, w = n & 255, wc = w >> 6, d = w & 63; return 256 * pn + 128 * (d >> 5) + 32 * wc + (d & 31);
}
__device__ __forceinline__ void p0_tr_item(const float* W, int K, int N, bf16* WT, int mode, int sel, int row_off, const float* kgain, const float* nscale, LAS unsigned* scr, int item, int lane) {
    const int nblk = N / 64, kb = item / nblk, nb = item % nblk, k0 = 64 * kb, n0 = 64 * nb;
    const int kq = lane >> 4, n4 = (lane & 15) * 4;
    f32x4 ns = (f32x4){1.f, 1.f, 1.f, 1.f}; if (nscale) ns = *(const GAS f32x4*)(nscale + n0 + n4);
    f32x4 v[16];
#pragma unroll
    for (int i = 0; i < 16; ++i) { const int k = 8 * (i >> 1) + 2 * kq + (i & 1); v[i] = *(const GAS f32x4*)(W + (size_t)(k0 + k) * N + n0 + n4); }
    if (kgain) {
#pragma unroll
        for (int i = 0; i < 16; ++i) { const int k = 8 * (i >> 1) + 2 * kq + (i & 1); v[i] = v[i] * kgain[k0 + k]; }
    }
#pragma unroll
    for (int ip = 0; ip < 8; ++ip) { const f32x4 e = v[2 * ip] * ns, o = v[2 * ip + 1] * ns;
#pragma unroll
        for (int c = 0; c < 4; ++c) scr[(n4 + c) * 33 + 4 * ip + kq] = pk2(e[c], o[c]); }
    LDS_WAIT(); asm volatile("" ::: "memory");
    const int kc = lane & 7;
#pragma unroll
    for (int jj = 0; jj < 8; ++jj) { const int n = (lane >> 3) + 8 * jj; const LAS unsigned* sp = scr + n * 33 + 4 * kc;
        v4u o; o.x = sp[0]; o.y = sp[1]; o.z = sp[2]; o.w = sp[3];
        *(GAS v4u*)(WT + (size_t)p0_map_row(mode, sel, row_off, n0 + n) * K + k0 + 8 * kc) = o; }
    LDS_WAIT(); asm volatile("" ::: "memory");
}

struct Args { const float* in[13]; float* out; unsigned char* ws; int ph_lo, ph_hi; };

__device__ __forceinline__ void sincos_acc(float angf, float& c, float& s) {
    const double x = (double)angf; const double k = __builtin_rint(x * 0.15915494309189535);
    double y = (x - k * 6.283185307179586) * 0.25;
    const double y2 = y * y;
    double sn = y * (1.0 + y2 * (-1.0 / 6 + y2 * (1.0 / 120 + y2 * (-1.0 / 5040 + y2 * (1.0 / 362880 + y2 * (-1.0 / 39916800 + y2 * (1.0 / 6227020800.0)))))));
    double cs = 1.0 + y2 * (-0.5 + y2 * (1.0 / 24 + y2 * (-1.0 / 720 + y2 * (1.0 / 40320 + y2 * (-1.0 / 3628800 + y2 * (1.0 / 479001600.0 + y2 * (-1.0 / 87178291200.0)))))));
#pragma unroll
    for (int i = 0; i < 2; ++i) { const double s2 = 2.0 * sn * cs, c2 = 1.0 - 2.0 * sn * sn; sn = s2; cs = c2; }
    c = (float)cs; s = (float)sn;
}

template <int GI>
__device__ __forceinline__ void pool_group(f32x4 (&cur)[16], f32x4 (&prev)[16], f32x4& S2, f32x4& S4, f32x4& S8, f32x4& S16, const f32x4 gv, const float* x, bf16* hp,
                                           int R0, bool bstart, int c4, int hl, int lane, int wq, LAS float* part, LAS float* rs) {
    const bool zero = (GI == 0) && bstart;
#pragma unroll
    for (int j = 0; j < 16; ++j) { const f32x4 v = cur[j]; part[j * 256 + hl] = (v[0] * v[0] + v[1] * v[1]) + (v[2] * v[2] + v[3] * v[3]); }
    LDS_WAIT(); __syncthreads();
#pragma unroll
    for (int q = 0; q < 4; ++q) { const int j = 4 * wq + q; const f32x4 p = *(const LAS f32x4*)(part + j * 256 + 4 * lane);
        const float s = wave_sum((p[0] + p[1]) + (p[2] + p[3])); if (lane == 0) rs[j] = zero ? 0.f : rsqrtf(s * (1.0f / D) + 1e-6f); }
    LDS_WAIT(); __syncthreads();
#pragma unroll
    for (int j = 0; j < 16; ++j) {
        const int row = R0 - 16 + GI * 16 + j;
        const f32x4 hv = cur[j] * rs[j] * gv;
        const f32x4 h2 = j >= 2 ? cur[j >= 2 ? j - 2 : 0] : prev[(j + 14) & 15], h4 = j >= 4 ? cur[j >= 4 ? j - 4 : 0] : prev[(j + 12) & 15], h8 = j >= 8 ? cur[j >= 8 ? j - 8 : 0] : prev[(j + 8) & 15];
        S2 = S2 + hv - h2; S4 = S4 + hv - h4; S8 = S8 + hv - h8; S16 = S16 + hv - prev[j];
        cur[j] = hv;
        if (GI < 2) prev[j] = *(const GAS f32x4*)(x + (size_t)(row + 16) * D + 4 * c4);
        if (GI > 0) {
            const int t = row & (SEQ - 1);
            const float i2 = t >= 1 ? 0.5f : 1.0f, i4 = t >= 3 ? 0.25f : 1.0f / (float)(t + 1), i8 = t >= 7 ? 0.125f : 1.0f / (float)(t + 1), i16 = t >= 15 ? 0.0625f : 1.0f / (float)(t + 1);
            const f32x4 o2 = S2 * i2 - hv, o4 = S4 * i4 - hv, o8 = S8 * i8 - hv, o16 = S16 * i16 - hv;
            const size_t off = (size_t)row * D + 4 * c4;
            *(GAS v2u*)(hp + off) = (v2u){pk2(o2[0], o2[1]), pk2(o2[2], o2[3])};
            *(GAS v2u*)(hp + (size_t)M * D + off) = (v2u){pk2(o4[0], o4[1]), pk2(o4[2], o4[3])};
            *(GAS v2u*)(hp + 2 * (size_t)M * D + off) = (v2u){pk2(o8[0], o8[1]), pk2(o8[2], o8[3])};
            *(GAS v2u*)(hp + 3 * (size_t)M * D + off) = (v2u){pk2(o16[0], o16[1]), pk2(o16[2], o16[3])};
        }
    }
}

constexpr int I_SQ = 16 * 16, I_GU = 16 * 44, I_DN = 44 * 16, I_QKV = 16 * 48, I_W2 = 4 * 32 * 8;
constexpr int W_EARLY = I_W2 + I_SQ + 2 * I_GU, W_ITEMS = W_EARLY + I_DN + I_QKV + I_SQ + 2 * I_GU + I_DN;
__device__ __forceinline__ void w2_item(const Args& a, int it, int lane) {
    typedef float f32x16 __attribute__((ext_vector_type(16)));
    const int g = it >> 8, r = it & 255, n0 = (r >> 3) * 32, c0 = (r & 7) * 32, i = lane & 31, h = lane >> 5;
    const float* wout = a.in[7] + (size_t)(g * 256) * 1024 + n0 + i;
    const float* wgr = a.in[5] + (size_t)g * 65536 + (size_t)(c0 + i) * 256;
    const float* sc = a.in[6] + g * 256;
    f32x16 acc = {0.f, 0.f, 0.f, 0.f, 0.f, 0.f, 0.f, 0.f, 0.f, 0.f, 0.f, 0.f, 0.f, 0.f, 0.f, 0.f};
#pragma unroll 1
    for (int ch = 0; ch < 4; ++ch) {
        f32x4 bq[16]; float a0[16], a1[16];
        const float scv = sc[ch * 64 + lane];
#pragma unroll
        for (int q = 0; q < 16; ++q) { const int jq = ch * 16 + q;
            bq[q] = *(const GAS f32x4*)(wgr + 4 * jq);
            a0[q] = wout[(size_t)(4 * jq + h) * 1024]; a1[q] = wout[(size_t)(4 * jq + 2 + h) * 1024]; }
        asm volatile("" ::: "memory"); __builtin_amdgcn_sched_barrier(0);
#pragma unroll
        for (int q = 0; q < 16; ++q) {
            const float s0 = __shfl(scv, 4 * q + h), s1 = __shfl(scv, 4 * q + 2 + h);
            const float b0 = (h ? bq[q][1] : bq[q][0]) * s0, b1 = (h ? bq[q][3] : bq[q][2]) * s1;
            acc = __builtin_amdgcn_mfma_f32_32x32x2f32(a0[q], b0, acc, 0, 0, 0);
            acc = __builtin_amdgcn_mfma_f32_32x32x2f32(a1[q], b1, acc, 0, 0, 0);
        }
    }
    bf16* W2T = (bf16*)(a.ws + WS_WPO) + (size_t)n0 * 1024 + g * 256 + c0 + i;
#pragma unroll
    for (int rr = 0; rr < 16; ++rr) W2T[(size_t)((rr & 3) + 8 * (rr >> 2) + 4 * h) * 1024] = (bf16)f2bf(acc[rr]);
}
__device__ __forceinline__ void weight_item(const Args& a, int it, LAS unsigned* scr, int lane) {
    unsigned char* ws = a.ws; const float* norm_mix = a.in[1]; const float* norm_ffn = a.in[2];
    int r = it;
    if (r < I_W2) { w2_item(a, r, lane); return; } r -= I_W2;
    if (r < I_SQ) { p0_tr_item(a.in[4], D, D, (bf16*)(ws + WS_WIN), 0, 0, 0, nullptr, nullptr, scr, r, lane); return; } r -= I_SQ;
    if (r < I_GU) { p0_tr_item(a.in[10], D, FF, (bf16*)(ws + WS_WGU0), 1, 0, 0, norm_ffn, nullptr, scr, r, lane); return; } r -= I_GU;
    if (r < I_GU) { p0_tr_item(a.in[11], D, FF, (bf16*)(ws + WS_WGU0), 1, 1, 0, norm_ffn, nullptr, scr, r, lane); return; } r -= I_GU;
    if (r < I_DN) { p0_tr_item(a.in[12], FF, D, (bf16*)(ws + WS_WD0), 0, 0, 0, nullptr, nullptr, scr, r, lane); return; } r -= I_DN;
    if (r < I_QKV) { p0_tr_item(a.in[8], D, 3 * D, (bf16*)(ws + WS_WQKV), 2, 0, 0, norm_mix + D, nullptr, scr, r, lane); return; } r -= I_QKV;
    if (r < I_SQ) { p0_tr_item(a.in[9], D, D, (bf16*)(ws + WS_WAO), 0, 0, 0, nullptr, nullptr, scr, r, lane); return; } r -= I_SQ;
    if (r < I_GU) { p0_tr_item(a.in[10] + (size_t)D * FF, D, FF, (bf16*)(ws + WS_WGU1), 1, 0, 0, norm_ffn + D, nullptr, scr, r, lane); return; } r -= I_GU;
    if (r < I_GU) { p0_tr_item(a.in[11] + (size_t)D * FF, D, FF, (bf16*)(ws + WS_WGU1), 1, 1, 0, norm_ffn + D, nullptr, scr, r, lane); return; } r -= I_GU;
    p0_tr_item(a.in[12] + (size_t)D * FF, FF, D, (bf16*)(ws + WS_WD1), 0, 0, 0, nullptr, nullptr, scr, r, lane);
}
__device__ __forceinline__ void rope_entries(unsigned char* ws, int first, int stride) {
    float* rope = (float*)(ws + WS_ROPE);
    for (int e = first; e < SEQ * 32; e += stride) {
        const int t = e >> 5, j = e & 31;
        const float invf = (float)(1.0 / (double)(float)exp2(13.287712379549449 * (double)j / 32.0));
        const float ang = (float)t * invf; float c, s; sincos_acc(ang, c, s);
        rope[(size_t)t * 64 + j] = c; rope[(size_t)t * 64 + 32 + j] = s;
    }
}
__device__ __forceinline__ void late_prep(const Args& a0, LAS unsigned char* lds, int widx, int nidle) {
    Args a = a0;
#pragma unroll
    for (int i = 0; i < 13; ++i) asm volatile("" : "+s"(a.in[i]));
    asm volatile("" : "+s"(a.ws));
    int tid = threadIdx.x; asm volatile("" : "+v"(tid)); const int lane = tid & 63, wave = __builtin_amdgcn_readfirstlane(tid >> 6);
    LAS unsigned* scr = (LAS unsigned*)(lds + wave * 16384);
    for (int it = W_EARLY + widx * NWAVES + wave; it < W_ITEMS; it += nidle * NWAVES) weight_item(a, it, scr, lane);
}

__device__ __forceinline__ void p0_prologue(const Frame& F0, const Args& a, bool defer_late, bool pool_epi) {
    Frame F = F0; { int tid = threadIdx.x; asm volatile("" : "+v"(tid)); F.tid = tid; F.lane = tid & 63; F.wave = __builtin_amdgcn_readfirstlane(tid >> 6); }
    unsigned char* ws = a.ws;
    LAS unsigned* scr = (LAS unsigned*)(F.lds + F.wave * 16384);
    const int gw = F.vcu * NWAVES + F.wave, NGW = F.G * NWAVES;
    const float* norm_mix = a.in[1];
    const int n_items = defer_late ? W_EARLY : W_ITEMS;
    for (int it = gw; it < n_items; it += NGW) weight_item(a, it, scr, F.lane);
    rope_entries(ws, F.vcu * NWAVES * 64 + F.tid, F.G * NWAVES * 64);
    __syncthreads();
    if (pool_epi) {
        const float* x = a.in[0]; bf16* hb = (bf16*)(ws + WS_BIG);
        f32x4 gv[4];
#pragma unroll
        for (int j = 0; j < 4; ++j) gv[j] = *(const GAS f32x4*)(norm_mix + 4 * F.lane + 256 * j);
        const int gwr = F.vcu * NWAVES + F.wave;
        for (int m = gwr; m < M; m += 2 * NGW) {
            const int m2 = (m + NGW < M) ? m + NGW : m;
            const GAS f32x4* x1 = (const GAS f32x4*)(x + (size_t)m * D) + F.lane; const GAS f32x4* x2 = (const GAS f32x4*)(x + (size_t)m2 * D) + F.lane;
            f32x4 v[4], w2[4]; float s1 = 0.f, s2 = 0.f;
#pragma unroll
            for (int j = 0; j < 4; ++j) { v[j] = x1[64 * j]; w2[j] = x2[64 * j]; }
#pragma unroll
            for (int j = 0; j < 4; ++j) { s1 += (v[j][0] * v[j][0] + v[j][1] * v[j][1]) + (v[j][2] * v[j][2] + v[j][3] * v[j][3]); s2 += (w2[j][0] * w2[j][0] + w2[j][1] * w2[j][1]) + (w2[j][2] * w2[j][2] + w2[j][3] * w2[j][3]); }
            const float r1 = rsqrtf(wave_sum(s1) * (1.0f / D) + 1e-6f), r2 = rsqrtf(wave_sum(s2) * (1.0f / D) + 1e-6f);
            GAS v2u* o1 = (GAS v2u*)(hb + (size_t)m * D) + F.lane; GAS v2u* o2 = (GAS v2u*)(hb + (size_t)m2 * D) + F.lane;
#pragma unroll
            for (int j = 0; j < 4; ++j) { const f32x4 a1 = v[j] * r1 * gv[j], a2 = w2[j] * r2 * gv[j];
                o1[64 * j] = (v2u){pk2(a1[0], a1[1]), pk2(a1[2], a1[3])}; o2[64 * j] = (v2u){pk2(a2[0], a2[1]), pk2(a2[2], a2[3])}; }
        }
    } else
    {
        const float* x = a.in[0]; const float* g0 = norm_mix;
        bf16* hp = (bf16*)(ws + WS_BIG);
        const int half = F.tid >> 8, c4 = F.tid & 255, hl = c4, wq = F.wave & 3;
        LAS float* part = (LAS float*)(F.lds) + half * (16 * 256);
        LAS float* rs = (LAS float*)(F.lds + 32768) + half * 16;
        const f32x4 gv = *(const GAS f32x4*)(g0 + 4 * c4);
        for (int blk = F.vcu; blk < M / 64; blk += F.G) {
            const int R0 = blk * 64 + half * 32;
            const bool bstart = (R0 & (SEQ - 1)) == 0;
            f32x4 A[16], B[16];
#pragma unroll
            for (int j = 0; j < 16; ++j) { B[j] = (f32x4){0.f, 0.f, 0.f, 0.f}; A[j] = B[j]; if (!bstart) A[j] = *(const GAS f32x4*)(x + (size_t)(R0 - 16 + j) * D + 4 * c4); }
            f32x4 S2 = B[0], S4 = B[0], S8 = B[0], S16 = B[0];
            pool_group<0>(A, B, S2, S4, S8, S16, gv, x, hp, R0, bstart, c4, hl, F.lane, wq, part, rs);
            pool_group<1>(B, A, S2, S4, S8, S16, gv, x, hp, R0, bstart, c4, hl, F.lane, wq, part, rs);
            pool_group<2>(A, B, S2, S4, S8, S16, gv, x, hp, R0, bstart, c4, hl, F.lane, wq, part, rs);
            __syncthreads();
        }
    }
}

namespace att {
typedef short bf16x8 __attribute__((ext_vector_type(8)));
typedef short s16x4 __attribute__((ext_vector_type(4)));
typedef float f32x16 __attribute__((ext_vector_type(16)));
typedef unsigned u32x4 __attribute__((ext_vector_type(4)));
constexpr int KCH = 6160;
constexpr int LDS_K = 0, LDS_V = 8 * KCH, VDH = 24 * 1024 + 64, LDS_OST = LDS_V + 2 * VDH, LDS_TOTAL = LDS_OST + 8 * 4096;
static_assert(LDS_TOTAL <= LDS_BYTES, "attention LDS");
__device__ __forceinline__ int crow(int r, int hi) { return (r & 3) + 8 * (r >> 2) + 4 * hi; }
__device__ __forceinline__ s16x4 vtr(const LAS unsigned char* p) { return __builtin_bit_cast(s16x4, __builtin_amdgcn_ds_read_tr16_b64_v4i16((LAS s16x4*)p)); }
struct KVQ { u32x4 k[6], v[6]; bf16x8 q[4]; };
__device__ __forceinline__ void attn_load(int item, const bf16* Qp, const bf16* Kp, const bf16* Vp, KVQ& R, int tid, int wid, int r32, int hi) {
    const int bh = item >> 5, j = item & 31, h = bh & 15;
    const int dsh = h < 6 ? 0 : (h < 11 ? 2 : 4);
    const bool first = (j & ((32 >> dsh) - 1)) == 0;
    const size_t hb = (size_t)bh * (SEQ * 64);
    const int pos0 = j * 256;
#pragma unroll
    for (int it = 0; it < 6; ++it) {
        const int p = tid + 512 * it, key = p >> 3, c = p & 7;
        const int keyc = (first && key < 128) ? 128 : key;
        const size_t go = hb + (size_t)(pos0 - 128 + keyc) * 64 + c * 8; R.k[it] = *(const GAS u32x4*)(Kp + go); R.v[it] = *(const GAS u32x4*)(Vp + go);
    }
#pragma unroll
    for (int d0 = 0; d0 < 4; ++d0) R.q[d0] = *(const GAS bf16x8*)(Qp + hb + (size_t)(pos0 + 32 * wid + r32) * 64 + d0 * 16 + hi * 8);
}
__device__ __forceinline__ void attn_phase(int item0, int nitems, const bf16* Qp, const bf16* Kp, const bf16* Vp, bf16* O, float* lse, LAS unsigned char* shm) {
    int tid = threadIdx.x; asm volatile("" : "+v"(tid));
    const int wid = __builtin_amdgcn_readfirstlane(tid >> 6);
    KVQ R;
    if (nitems > 0) attn_load(item0, Qp, Kp, Vp, R, tid, wid, tid & 31, (tid & 63) >> 5);
#pragma unroll 1
  for (int ii = 0; ii < nitems; ++ii) {
    asm volatile("" : "+v"(tid));
    const int lane = tid & 63, r32 = lane & 31, hi = lane >> 5;
    const int item = item0 + ii, bh = item >> 5, j = item & 31;
    const int b = bh >> 4, h = bh & 15;
    const int dsh = h < 6 ? 0 : (h < 11 ? 2 : 4);
    const int nqb = 32 >> dsh, r = j >> (5 - dsh), qb = j & (nqb - 1);
    const bool first = (qb == 0);
#pragma unroll
    for (int it = 0; it < 6; ++it) {
        const int p = tid + 512 * it, key = p >> 3, c = p & 7;
        const bool dead = first && key < 128; const u32x4 z4 = (u32x4){0u, 0u, 0u, 0u};
        *(LAS u32x4*)(shm + LDS_K + c * KCH + key * 16) = dead ? z4 : R.k[it];
        *(LAS u32x4*)(shm + LDS_V + (c >> 2) * VDH + (key >> 4) * 1024 + (key & 15) * 64 + (c & 3) * 16) = dead ? z4 : R.v[it];
    }
    bf16x8 qr[4];
#pragma unroll
    for (int d0 = 0; d0 < 4; ++d0) qr[d0] = R.q[d0];
    LDS_WAIT(); __syncthreads();
    if (ii + 1 < nitems) attn_load(item + 1, Qp, Kp, Vp, R, tid, wid, r32, hi);
    f32x16 P[5];
    const LAS unsigned char* kbase = shm + LDS_K + hi * KCH + (32 * wid + r32) * 16;
#pragma unroll
    for (int kt = 0; kt < 5; ++kt) {
        f32x16 acc = {0.f, 0.f, 0.f, 0.f, 0.f, 0.f, 0.f, 0.f, 0.f, 0.f, 0.f, 0.f, 0.f, 0.f, 0.f, 0.f};
#pragma unroll
        for (int d0 = 0; d0 < 4; ++d0) { const bf16x8 kf = *(const LAS bf16x8*)(kbase + (2 * d0) * KCH + kt * 512); acc = __builtin_amdgcn_mfma_f32_32x32x16_bf16(kf, qr[d0], acc, 0, 0, 0); }
        P[kt] = acc;
    }
    const float NEG = -INFINITY;
    const int lowlim = first ? (128 - 32 * wid) : 0;
    const int lo0 = r32 > lowlim ? r32 : lowlim;
#pragma unroll
    for (int rr = 0; rr < 16; ++rr) { const int cr = crow(rr, hi); if (cr < lo0) P[0][rr] = NEG; if (cr > r32) P[4][rr] = NEG; }
    if (first) {
#pragma unroll
        for (int kt = 1; kt < 4; ++kt)
#pragma unroll
            for (int rr = 0; rr < 16; ++rr) if (32 * kt + crow(rr, hi) < lowlim) P[kt][rr] = NEG;
    }
    float mx = NEG;
#pragma unroll
    for (int kt = 0; kt < 5; ++kt)
#pragma unroll
        for (int rr = 0; rr < 16; ++rr) mx = fmaxf(mx, P[kt][rr]);
    mx = fmaxf(mx, __shfl_xor(mx, 32));
    float l = 0.f;
#pragma unroll
    for (int kt = 0; kt < 5; ++kt)
#pragma unroll
        for (int rr = 0; rr < 16; ++rr) { const float e = __builtin_amdgcn_exp2f(P[kt][rr] - mx); P[kt][rr] = e; l += e; }
    l += __shfl_xor(l, 32);
    const float inv = __builtin_amdgcn_rcpf(l);
    {
        const int i = qb * 256 + 32 * wid + r32, t = (i << dsh) + r;
        if (hi == 0) lse[((size_t)b * SEQ + t) * 16 + h] = (mx + __log2f(l)) * 0.6931471805599453f;
    }
    f32x16 o[2];
    o[0] = (f32x16){0.f, 0.f, 0.f, 0.f, 0.f, 0.f, 0.f, 0.f, 0.f, 0.f, 0.f, 0.f, 0.f, 0.f, 0.f, 0.f}; o[1] = o[0];
    const LAS unsigned char* vb = shm + LDS_V + ((lane >> 4) & 1) * 32 + (lane & 3) * 8 + (4 * hi + ((lane & 15) >> 2)) * 64;
#pragma unroll
    for (int kt = 0; kt < 5; ++kt)
#pragma unroll
        for (int s = 0; s < 2; ++s) {
            u32x4 pw;
            pw.x = pg8::cvt_pk_bf16(P[kt][8 * s + 0] * inv, P[kt][8 * s + 1] * inv); pw.y = pg8::cvt_pk_bf16(P[kt][8 * s + 2] * inv, P[kt][8 * s + 3] * inv);
            pw.z = pg8::cvt_pk_bf16(P[kt][8 * s + 4] * inv, P[kt][8 * s + 5] * inv); pw.w = pg8::cvt_pk_bf16(P[kt][8 * s + 6] * inv, P[kt][8 * s + 7] * inv);
            const bf16x8 pa = __builtin_bit_cast(bf16x8, pw);
            const int kblk = 2 * wid + 2 * kt + s;
#pragma unroll
            for (int dh = 0; dh < 2; ++dh) {
                const s16x4 vlo = vtr(vb + dh * VDH + kblk * 1024), vhi = vtr(vb + dh * VDH + kblk * 1024 + 512);
                const bf16x8 vf = (bf16x8){vlo[0], vlo[1], vlo[2], vlo[3], vhi[0], vhi[1], vhi[2], vhi[3]};
                o[dh] = __builtin_amdgcn_mfma_f32_32x32x16_bf16(pa, vf, o[dh], 0, 0, 0);
            }
        }
    {
        LAS bf16* stg = (LAS bf16*)(shm + LDS_OST + wid * 4096);
#pragma unroll
        for (int rr = 0; rr < 16; ++rr) { const int orow = crow(rr, hi);
#pragma unroll
            for (int dh = 0; dh < 2; ++dh) stg[orow * 64 + dh * 32 + r32] = (bf16)f2bf(o[dh][rr]); }
        LDS_WAIT(); asm volatile("" ::: "memory");
#pragma unroll
        for (int i4 = 0; i4 < 4; ++i4) { const int row = i4 * 8 + (lane >> 3), ch = lane & 7; const u32x4 v = *(const LAS u32x4*)(stg + row * 64 + ch * 8);
            const int i = qb * 256 + 32 * wid + row, t = (i << dsh) + r;
            *(GAS u32x4*)(O + ((size_t)b * SEQ + t) * D + h * 64 + ch * 8) = v; }
    }
    LDS_WAIT(); __syncthreads();
  }
}
}

__global__ void __launch_bounds__(NWAVES * 64, 2) fwd_megakernel(Args args) {
    extern __shared__ __attribute__((aligned(16))) unsigned char lds[];
    Frame F;
    F.lds = (LAS unsigned char*)lds;
    F.tid = threadIdx.x; F.lane = F.tid & 63; F.wave = __builtin_amdgcn_readfirstlane(F.tid >> 6);
    F.G = gridDim.x; { const int bx = blockIdx.x; F.vcu = (F.G % 8 == 0) ? (bx % 8) * (F.G / 8) + bx / 8 : bx; }
    unsigned char* ws = args.ws;
    const int lo = args.ph_lo, hi = args.ph_hi;
    const bool one_launch = (hi - lo) > 1;
    volatile LAS unsigned* bst = (volatile LAS unsigned*)(F.lds + LDS_BYTES - 64);
    if (F.tid < 2) bst[F.tid] = 0u;
    __syncthreads();
    XcdBarrier bar; bar.bar = (unsigned*)(ws + WS_CTL) + CW_BAR; bar.x = 0; bar.st = bst;
    if (one_launch) bar = xcd_barrier_post((unsigned*)(ws + WS_CTL) + CW_BAR, bst);
#define IN(k) (lo <= (k) && (k) < hi)
#define SEAM(k) do { if (IN(k) && IN((k) + 1)) { xcd_barrier(bar); } } while (0)

    if (lo < 0) cg::this_grid().sync();
    float* resid = args.out;
    float* ssb = (float*)(ws + WS_SS);
    bf16* xb = (bf16*)(ws + WS_XB);
    bf16* zo = (bf16*)(ws + WS_ZO);
    bf16* big = (bf16*)(ws + WS_BIG);

    bool fused_done = false;
    const bool defer_late = one_launch && IN(0) && IN(4) && (F.G == 256);
    const bool pool_epi = (F.G == 256);
    if (IN(0)) { p0_prologue(F, args, defer_late, pool_epi); }
    SEAM(0);
    if (IN(1)) {
        pg8::StaticOrder S; S.init(M, D, F.G, (int)blockIdx.x);
        if (pool_epi) { pg8::Gemm g{big, (const bf16*)(ws + WS_WIN), M, D, D, D, D, 0};
            EpiPool E{F.lds, big, (const bf16*)(ws + WS_WIN), zo, (bf16*)(ws + WS_HALO), (unsigned*)(ws + WS_CTL) + CW_HALO, bar.bar};
            pg8::gemm_phase<EpiPool, pg8::StaticOrder, true, false, true>(F.lds, g, S, E); }
        else { pg8::Gemm g{big, (const bf16*)(ws + WS_WIN), M, D, D, D, D, (size_t)M * D * 2};
            pg8::EpiBf16 E{zo, D};
            pg8::gemm_phase<pg8::EpiBf16, pg8::StaticOrder, true>(F.lds, g, S, E); }
    }
    SEAM(1);
    if (IN(3)) {
        pg8::Gemm g{zo, (const bf16*)(ws + WS_WPO), M, D, D, D, D, 0};
        pg8::StaticOrder S; S.init(M, D, F.G, (int)blockIdx.x);
        pg8::EpiRes<true> E{args.in[0], xb, ssb, nullptr};
        pg8::gemm_phase<pg8::EpiRes<true>, pg8::StaticOrder, true>(F.lds, g, S, E);
    }
    SEAM(3);
#pragma unroll 1
    for (int layer = 0; layer < 2; ++layer) {
        const int pb = layer == 0 ? 4 : 10;
        if (IN(pb)) {
            pg8::Gemm g{xb, (const bf16*)(ws + (layer == 0 ? WS_WGU0 : WS_WGU1)), M, 2 * FF, D, D, D, 0};
            pg8::StaticOrder S; S.init(M, 2 * FF, F.G, (int)blockIdx.x);
            pg8::Unit u0; const pg8::RsTab rt = fill_rstd_tab(F.lds, ssb, S.next(0, u0) ? u0.pm : 0);
            pg8::EpiSwiGLU E{big, ssb, FF, rt};
            pg8::gemm_phase<pg8::EpiSwiGLU, pg8::StaticOrder, true>(F.lds, g, S, E);
            if (layer == 0 && defer_late && (int)blockIdx.x >= 128) late_prep(args, F.lds, (int)blockIdx.x - 128, 128);
        }
        SEAM(pb);
#ifndef FUSE_FINAL
#define FUSE_FINAL 1
#endif
        const bool fuse_final = FUSE_FINAL && (layer == 1) && one_launch && IN(12) && (F.G == (M / 256) * (D / 256));
        if (IN(pb + 1)) {
            pg8::Gemm g{big, (const bf16*)(ws + (layer == 0 ? WS_WD0 : WS_WD1)), M, D, FF, FF, FF, 0};
            pg8::StaticOrder S; S.init(M, D, F.G, (int)blockIdx.x);
            if (fuse_final) { EpiFinal E{xb, resid, ssb, args.in[3], bar}; pg8::gemm_phase<EpiFinal, pg8::StaticOrder, true>(F.lds, g, S, E); }
            else { pg8::EpiRes<false> E{nullptr, xb, ssb, nullptr}; pg8::gemm_phase<pg8::EpiRes<false>, pg8::StaticOrder, true>(F.lds, g, S, E); }
        }
        if (fuse_final) { fused_done = true; break; }
        SEAM(pb + 1);
        if (layer == 0) {
            bf16* qb_ = big; bf16* kb_ = big + (size_t)M * D; bf16* vb_ = big + 2 * (size_t)M * D;
            if (IN(6)) {
                pg8::Gemm g{xb, (const bf16*)(ws + WS_WQKV), M, 3 * D, D, D, D, 0};
                pg8::StaticOrder S; S.init(M, 3 * D, F.G, (int)blockIdx.x);
                pg8::Unit u0; const pg8::RsTab rt = fill_rstd_tab(F.lds, ssb, S.next(0, u0) ? u0.pm : 0);
                pg8::EpiQKV E{qb_, ssb, (const float*)(ws + WS_ROPE), rt};
                pg8::gemm_phase<pg8::EpiQKV, pg8::StaticOrder, true>(F.lds, g, S, E);
            }
            SEAM(6);
            if (IN(7)) {
                const int ipw = (1024 + F.G - 1) / F.G;
                const int it0 = F.vcu * ipw, nit = it0 >= 1024 ? 0 : (1024 - it0 < ipw ? 1024 - it0 : ipw);
                att::attn_phase(it0, nit, qb_, kb_, vb_, zo, (float*)(ws + WS_LSE), F.lds);
            }
            SEAM(7);
            const bool merge_fused = one_launch && IN(8) && IN(9) && (F.G == (M / 256) * (D / 256));
            if (IN(8) && !merge_fused) {
                int tid8 = threadIdx.x; asm volatile("" : "+v"(tid8)); const int lane8 = tid8 & 63, wave8 = __builtin_amdgcn_readfirstlane(tid8 >> 6);
                const float* lse = (const float*)(ws + WS_LSE);
                for (int m = F.vcu * NWAVES + wave8; m < M; m += F.G * NWAVES) {
                    float L[16];
#pragma unroll
                    for (int q4 = 0; q4 < 4; ++q4) { const f32x4 v = *(const GAS f32x4*)(lse + (size_t)m * 16 + 4 * q4); L[4 * q4] = v[0]; L[4 * q4 + 1] = v[1]; L[4 * q4 + 2] = v[2]; L[4 * q4 + 3] = v[3]; }
                    float lg[3];
                    { float mx = L[0];
_Pragma("unroll") for (int i = 1; i < 6; ++i) mx = fmaxf(mx, L[i]); float s = 0.f;
_Pragma("unroll") for (int i = 0; i < 6; ++i) s += __expf(L[i] - mx); lg[0] = mx + __logf(s) - 1.791759469228055f; }
                    { float mx = L[6];
_Pragma("unroll") for (int i = 7; i < 11; ++i) mx = fmaxf(mx, L[i]); float s = 0.f;
_Pragma("unroll") for (int i = 6; i < 11; ++i) s += __expf(L[i] - mx); lg[1] = mx + __logf(s) - 1.6094379124341003f; }
                    { float mx = L[11];
_Pragma("unroll") for (int i = 12; i < 16; ++i) mx = fmaxf(mx, L[i]); float s = 0.f;
_Pragma("unroll") for (int i = 11; i < 16; ++i) s += __expf(L[i] - mx); lg[2] = mx + __logf(s) - 1.6094379124341003f; }
                    const float mx = fmaxf(lg[0], fmaxf(lg[1], lg[2]));
                    const float e0 = __expf(lg[0] - mx), e1 = __expf(lg[1] - mx), e2 = __expf(lg[2] - mx); const float is = 3.0f / (e0 + e1 + e2);
                    const int head = lane8 >> 2; const float sc = (head < 6 ? e0 : (head < 11 ? e1 : e2)) * is;
                    GAS v4u* p = (GAS v4u*)(zo + (size_t)m * D + 16 * lane8);
#pragma unroll
                    for (int q2 = 0; q2 < 2; ++q2) { v4u w = p[q2];
                        w.x = pk2(bflo(w.x) * sc, bfhi(w.x) * sc); w.y = pk2(bflo(w.y) * sc, bfhi(w.y) * sc); w.z = pk2(bflo(w.z) * sc, bfhi(w.z) * sc); w.w = pk2(bflo(w.w) * sc, bfhi(w.w) * sc);
                        p[q2] = w; }
                }
            }
            if (!merge_fused) SEAM(8);
            if (IN(9)) {
                pg8::Gemm g{zo, (const bf16*)(ws + WS_WAO), M, D, D, D, D, 0};
                pg8::StaticOrder S; S.init(M, D, F.G, (int)blockIdx.x);
                if (merge_fused) { pg8::Unit u0; const LAS float* st = seg_fill(F.lds, (const float*)(ws + WS_LSE), S.next(0, u0) ? u0.pm : 0);
                    pg8::EpiRes<false, true> E{nullptr, xb, ssb, st + 512};
                    pg8::gemm_phase<pg8::EpiRes<false, true>, pg8::StaticOrder, true, true>(F.lds, g, S, E, st); }
                else { pg8::EpiRes<false> E{nullptr, xb, ssb, nullptr};
                    pg8::gemm_phase<pg8::EpiRes<false>, pg8::StaticOrder, true>(F.lds, g, S, E); }
            }
            SEAM(9);
        }
    }
    if (IN(12) && !fused_done) {
        const float* gf = args.in[3];
        int tid12 = threadIdx.x; asm volatile("" : "+v"(tid12)); const int lane12 = tid12 & 63, wave12 = __builtin_amdgcn_readfirstlane(tid12 >> 6);
        for (int m = F.vcu * NWAVES + wave12; m < M; m += F.G * NWAVES) {
            float s = 0.f;
#pragma unroll
            for (int q4 = 0; q4 < 4; ++q4) { const f32x4 v = *(const GAS f32x4*)(ssb + (size_t)m * 16 + 4 * q4); s += (v[0] + v[1]) + (v[2] + v[3]); }
            const float rstd = rsqrtf(s * (1.0f / D) + 1e-6f);
            const GAS v4u* xr = (const GAS v4u*)(xb + (size_t)m * D + 16 * lane12);
            GAS f32x4* orow = (GAS f32x4*)(resid + (size_t)m * D + 16 * lane12);
#pragma unroll
            for (int q2 = 0; q2 < 2; ++q2) { const v4u w = xr[q2]; const GAS f32x4* gq = (const GAS f32x4*)(gf + 16 * lane12 + 8 * q2);
                orow[2 * q2] = (f32x4){bflo(w.x), bfhi(w.x), bflo(w.y), bfhi(w.y)} * rstd * gq[0];
                orow[2 * q2 + 1] = (f32x4){bflo(w.z), bfhi(w.z), bflo(w.w), bfhi(w.w)} * rstd * gq[1]; }
        }
    }
#undef IN
#undef SEAM
}

extern "C" void kernel_launch(void* const* d_in, const int* in_sizes, int n_in, void* d_out, int out_size, void* d_ws, size_t ws_size, hipStream_t stream) {
    static int grid = 0;
    if (grid == 0) {
        if (n_in != 13 || in_sizes[0] != M * D || out_size != M * D || ws_size < WS_END) { fprintf(stderr, "kernel_launch: unexpected shapes (n_in %d, in0 %d, out %d, ws %zu); nothing launched\n", n_in, n_in > 0 ? in_sizes[0] : -1, out_size, ws_size); grid = -1; return; }
        int dev = 0, cus = 0, per_cu = 0;
        if (hipGetDevice(&dev) != hipSuccess || hipDeviceGetAttribute(&cus, hipDeviceAttributeMultiprocessorCount, dev) != hipSuccess) { grid = -1; return; }
        if (hipFuncSetAttribute((const void*)fwd_megakernel, hipFuncAttributeMaxDynamicSharedMemorySize, LDS_BYTES) != hipSuccess) { fprintf(stderr, "kernel_launch: hipFuncSetAttribute failed\n"); grid = -1; return; }
        if (hipOccupancyMaxActiveBlocksPerMultiprocessor(&per_cu, (const void*)fwd_megakernel, NWAVES * 64, LDS_BYTES) != hipSuccess || per_cu < 1) { fprintf(stderr, "kernel_launch: occupancy query says %d blocks per CU\n", per_cu); per_cu = 1; }
        (void)hipGetLastError();
        grid = cus;
    }
    if (grid < 0) return;
    if (hipMemsetAsync((char*)d_ws + WS_CTL, 0, CTL_ZERO_BYTES, stream) != hipSuccess) { fprintf(stderr, "kernel_launch: memset failed\n"); return; }
    Args a{};
    for (int i = 0; i < 13; ++i) a.in[i] = (const float*)d_in[i];
    a.out = (float*)d_out; a.ws = (unsigned char*)d_ws;
#if MK_N_LAUNCHES == 1
    a.ph_lo = 0; a.ph_hi = 13;
    void* kargs[] = {&a};
    hipError_t e = hipLaunchCooperativeKernel((const void*)fwd_megakernel, dim3(grid), dim3(NWAVES * 64), kargs, LDS_BYTES, stream);
    if (e != hipSuccess) fprintf(stderr, "kernel_launch: cooperative launch failed: %s (grid %d)\n", hipGetErrorString(e), grid);
#else
    for (int p = 0; p < 13; ++p) { a.ph_lo = p; a.ph_hi = p + 1; hipLaunchKernelGGL(fwd_megakernel, dim3(grid), dim3(NWAVES * 64), LDS_BYTES, stream, a); }
#endif
}
```

```cpp
#include <hip/hip_runtime.h>
#include <hip/hip_cooperative_groups.h>
#include <cstdio>
#include <cstdint>
namespace cg = cooperative_groups;

#ifndef MK_N_LAUNCHES
#define MK_N_LAUNCHES 1
#endif

namespace pg8 {
#define PG8_LAS __attribute__((address_space(3)))
typedef unsigned short bf16_t;
typedef short bf16x8 __attribute__((ext_vector_type(8)));
typedef float f32x4 __attribute__((ext_vector_type(4)));
typedef unsigned u32x4 __attribute__((ext_vector_type(4)));
constexpr int BM = 256, BK = 64, HALF = 128, HTB = HALF * BK * 2, STAGE_BYTES = 8 * HTB, NXCD = 8, WGM = 8;

__host__ __device__ __forceinline__ int lds_byte(int r, int c) { const int st = (r >> 4) * 2 + (c >> 5), rr = r & 15, cc = c & 31, ob = rr * 64 + cc * 2; return st * 1024 + (ob ^ (((ob >> 9) & 1) << 5)); }
__host__ __device__ __forceinline__ void stage_rc(int b, int& R, int& C) { const int st = b / 1024, sb = b % 1024, swz = sb ^ (((sb >> 9) & 1) << 5); R = (st >> 1) * 16 + swz / 64; C = (st & 1) * 32 + (swz % 64) / 2; }
__host__ __device__ __forceinline__ int perm32(int rho) { const int n = rho >> 4, i = rho & 15; return 8 * (i >> 2) + 4 * n + (i & 3); }

struct Unit { int pm, pn; };
struct Gemm { const bf16_t* A; const bf16_t* Bt; int M, N, K, lda, ldb; size_t a_pn_bytes; };

struct StaticOrder {
    int nM, nN, nwg, G, c;
    __host__ __device__ void init(int M, int N, int G_, int c_) { nM = M / BM; nN = N / BM; nwg = nM * nN; G = G_; c = c_; }
    __host__ __device__ bool next(int i, Unit& u) const {
        const long L = (long)i * G + c; if (L >= nwg) return false;
        int wgid = (int)L; { const int q = nwg / NXCD, r = nwg % NXCD, xcd = wgid % NXCD, off = wgid / NXCD; wgid = (xcd < r ? xcd * (q + 1) : r * (q + 1) + (xcd - r) * q) + off; }
        const int nig = WGM * nN, gid = wgid / nig, fm = gid * WGM, gsz = (nM - fm) < WGM ? (nM - fm) : WGM;
        u.pm = fm + ((wgid % nig) % gsz); u.pn = (wgid % nig) / gsz; return true;
    }
};

__device__ __forceinline__ unsigned cvt_pk_bf16(float lo, float hi) { unsigned r; asm volatile("v_cvt_pk_bf16_f32 %0, %1, %2" : "=v"(r) : "v"(lo), "v"(hi)); return r; }

constexpr float RMS_EPS = 1e-6f;

struct EpiBf16 {
    bf16_t* O; int ldc;
    __device__ __forceinline__ void operator()(const f32x4 (&acc)[2][2][4][2], const Unit& u, int wr, int wc, int fr, int fq) const {
        const int row0 = u.pm * BM + wr * 64 + fr, col0 = u.pn * BM + wc * 32 + 8 * fq;
#pragma unroll
        for (int ai = 0; ai < 2; ++ai)
#pragma unroll
            for (int m = 0; m < 4; ++m) { bf16_t* rowp = O + (size_t)(row0 + ai * HALF + m * 16) * ldc + col0;
#pragma unroll
                for (int bj = 0; bj < 2; ++bj) { const f32x4 v0 = acc[ai][bj][m][0], v1 = acc[ai][bj][m][1];
                    u32x4 w; w.x = cvt_pk_bf16(v0[0], v0[1]); w.y = cvt_pk_bf16(v0[2], v0[3]); w.z = cvt_pk_bf16(v1[0], v1[1]); w.w = cvt_pk_bf16(v1[2], v1[3]);
                    *(u32x4*)(rowp + bj * HALF) = w; } }
    }
};
__device__ __forceinline__ float bf_lo(unsigned w) { return __builtin_bit_cast(float, w << 16); }
__device__ __forceinline__ float bf_hi(unsigned w) { return __builtin_bit_cast(float, w & 0xffff0000u); }
template <bool BASE_F32, bool SCALE = false> struct EpiRes {
    const float* basef; bf16_t* xb; float* ss; const PG8_LAS float* ctab;
    __device__ __forceinline__ void load_base(int row, int col0, f32x4 (&nb)[4]) const {
        if (BASE_F32) { const float* bp = basef + (size_t)row * 1024 + col0; nb[0] = *(const f32x4*)(bp); nb[1] = *(const f32x4*)(bp + 4); nb[2] = *(const f32x4*)(bp + HALF); nb[3] = *(const f32x4*)(bp + HALF + 4); }
        else { const bf16_t* bp = xb + (size_t)row * 1024 + col0; const u32x4 a = *(const u32x4*)(bp), c = *(const u32x4*)(bp + HALF);
            nb[0] = (f32x4){bf_lo(a.x), bf_hi(a.x), bf_lo(a.y), bf_hi(a.y)}; nb[1] = (f32x4){bf_lo(a.z), bf_hi(a.z), bf_lo(a.w), bf_hi(a.w)};
            nb[2] = (f32x4){bf_lo(c.x), bf_hi(c.x), bf_lo(c.y), bf_hi(c.y)}; nb[3] = (f32x4){bf_lo(c.z), bf_hi(c.z), bf_lo(c.w), bf_hi(c.w)}; }
    }
    __device__ __forceinline__ void operator()(const f32x4 (&acc)[2][2][4][2], const Unit& u, int wr, int wc, int fr, int fq) const {
        const int row0 = u.pm * BM + wr * 64 + fr, col0 = u.pn * BM + wc * 32 + 8 * fq;
        f32x4 nb[4];
        load_base(row0, col0, nb);
#pragma unroll
        for (int it = 0; it < 8; ++it) { const int ai = it >> 2, m = it & 3;
            const size_t row = (size_t)(row0 + ai * HALF + m * 16); const size_t off = row * 1024 + col0; float s = 0.f;
            const f32x4 b0 = nb[0], b1 = nb[1], b2 = nb[2], b3 = nb[3];
            if (it < 7) load_base(row0 + ((it + 1) >> 2) * HALF + ((it + 1) & 3) * 16, col0, nb);
            const float cs = SCALE ? ctab[wr * 64 + fr + ai * HALF + m * 16] : 1.0f;
#pragma unroll
            for (int bj = 0; bj < 2; ++bj) {
                const f32x4 v0 = acc[ai][bj][m][0] * cs + (bj == 0 ? b0 : b2), v1 = acc[ai][bj][m][1] * cs + (bj == 0 ? b1 : b3);
                s += (v0[0] * v0[0] + v0[1] * v0[1]) + (v0[2] * v0[2] + v0[3] * v0[3]) + (v1[0] * v1[0] + v1[1] * v1[1]) + (v1[2] * v1[2] + v1[3] * v1[3]);
                u32x4 w; w.x = cvt_pk_bf16(v0[0], v0[1]); w.y = cvt_pk_bf16(v0[2], v0[3]); w.z = cvt_pk_bf16(v1[0], v1[1]); w.w = cvt_pk_bf16(v1[2], v1[3]);
                *(u32x4*)(xb + off + bj * HALF) = w; }
            s += __shfl_xor(s, 16); s += __shfl_xor(s, 32);
            if (fq == 0) ss[row * 16 + u.pn * 4 + wc] = s; }
    }
};
struct RsTab { const PG8_LAS float* tab; int pm; };
__device__ __forceinline__ float row_rstd(const float* ss, size_t row, int fq) {
    const f32x4 p = *(const f32x4*)(ss + row * 16 + 4 * fq); float s = (p[0] + p[1]) + (p[2] + p[3]);
    s += __shfl_xor(s, 16); s += __shfl_xor(s, 32);
    return rsqrtf(s * (1.0f / 1024.0f) + RMS_EPS);
}
struct EpiSwiGLU {
    bf16_t* act; const float* ss; int ldc; RsTab rt;
    __device__ __forceinline__ void operator()(const f32x4 (&acc)[2][2][4][2], const Unit& u, int wr, int wc, int fr, int fq) const {
        const int row0 = u.pm * BM + wr * 64 + fr, col0 = u.pn * HALF + wc * 32 + 8 * fq;
        const bool use_tab = (u.pm == rt.pm);
#pragma unroll
        for (int ai = 0; ai < 2; ++ai)
#pragma unroll
            for (int m = 0; m < 4; ++m) { const size_t row = (size_t)(row0 + ai * HALF + m * 16); float rstd; if (__builtin_expect(use_tab, 1)) rstd = rt.tab[wr * 64 + fr + ai * HALF + m * 16]; else { asm volatile("; rstd from global (grid != 256)" ::: "memory"); rstd = row_rstd(ss, row, fq); }
                float a[8];
#pragma unroll
                for (int n = 0; n < 2; ++n)
#pragma unroll
                    for (int i = 0; i < 4; ++i) { const float g = acc[ai][0][m][n][i] * rstd, up = acc[ai][1][m][n][i] * rstd;
                        a[n * 4 + i] = g * up * __builtin_amdgcn_rcpf(1.0f + __builtin_amdgcn_exp2f(-1.4426950408889634f * g)); }
                u32x4 w; w.x = cvt_pk_bf16(a[0], a[1]); w.y = cvt_pk_bf16(a[2], a[3]); w.z = cvt_pk_bf16(a[4], a[5]); w.w = cvt_pk_bf16(a[6], a[7]);
                *(u32x4*)(act + row * ldc + col0) = w; }
    }
};
struct EpiQKV {
    bf16_t* qkv; const float* ss; const float* rope; RsTab rt;
    __device__ __forceinline__ void operator()(const f32x4 (&acc)[2][2][4][2], const Unit& u, int wr, int wc, int fr, int fq) const {
        const int row0 = u.pm * BM + wr * 64 + fr; const int sect = u.pn >> 2, head = (u.pn & 3) * 4 + wc;
        const int dsh = head < 6 ? 0 : (head < 11 ? 2 : 4);
        bf16_t* dst = qkv + (size_t)sect * ((size_t)16384 * 1024);
        const float qs = sect == 0 ? 0.125f * 1.4426950408889634f : 1.0f;
        const bool use_tab = (u.pm == rt.pm);
        const bool rot = sect < 2;
        f32x4 nr[4];
        if (rot) { const float* rp = rope + (size_t)(row0 & 8191) * 64 + 8 * fq; nr[0] = *(const f32x4*)(rp); nr[1] = *(const f32x4*)(rp + 4); nr[2] = *(const f32x4*)(rp + 32); nr[3] = *(const f32x4*)(rp + 36); }
#pragma unroll
        for (int it = 0; it < 8; ++it) { const int ai = it >> 2, m = it & 3;
            const int row = row0 + ai * HALF + m * 16; float rstd; if (__builtin_expect(use_tab, 1)) rstd = rt.tab[wr * 64 + fr + ai * HALF + m * 16]; else { asm volatile("; rstd from global (grid != 256)" ::: "memory"); rstd = row_rstd(ss, (size_t)row, fq); } rstd *= qs;
            const int b = row >> 13, t = row & 8191; const int pos = ((t & ((1 << dsh) - 1)) << (13 - dsh)) + (t >> dsh);
            bf16_t* o = dst + ((size_t)(b * 16 + head) * 8192 + pos) * 64 + 8 * fq;
            const f32x4 c0 = nr[0], c1 = nr[1], s0 = nr[2], s1 = nr[3];
            if (rot && it < 7) { const int row2 = row0 + ((it + 1) >> 2) * HALF + ((it + 1) & 3) * 16; const float* rp = rope + (size_t)(row2 & 8191) * 64 + 8 * fq;
                nr[0] = *(const f32x4*)(rp); nr[1] = *(const f32x4*)(rp + 4); nr[2] = *(const f32x4*)(rp + 32); nr[3] = *(const f32x4*)(rp + 36); }
            float lo[8], hi[8];
#pragma unroll
            for (int n = 0; n < 2; ++n)
#pragma unroll
                for (int i = 0; i < 4; ++i) { lo[n * 4 + i] = acc[ai][0][m][n][i] * rstd; hi[n * 4 + i] = acc[ai][1][m][n][i] * rstd; }
            if (rot) {
#pragma unroll
                for (int i = 0; i < 8; ++i) { const float cs = i < 4 ? c0[i & 3] : c1[i & 3], sn = i < 4 ? s0[i & 3] : s1[i & 3];
                    const float l = lo[i], h = hi[i]; lo[i] = l * cs - h * sn; hi[i] = h * cs + l * sn; }
            }
            u32x4 w; w.x = cvt_pk_bf16(lo[0], lo[1]); w.y = cvt_pk_bf16(lo[2], lo[3]); w.z = cvt_pk_bf16(lo[4], lo[5]); w.w = cvt_pk_bf16(lo[6], lo[7]);
            *(u32x4*)(o) = w;
            w.x = cvt_pk_bf16(hi[0], hi[1]); w.y = cvt_pk_bf16(hi[2], hi[3]); w.z = cvt_pk_bf16(hi[4], hi[5]); w.w = cvt_pk_bf16(hi[6], hi[7]);
            *(u32x4*)(o + 32) = w; }
    }
};

template <class Epi, class Sched, bool ALIGN_EPI, bool SEG = false, bool AFTER_DRAIN = false>
__device__ __forceinline__ void gemm_phase(PG8_LAS unsigned char* lds, const Gemm g, const Sched& S, const Epi& E, const PG8_LAS float* segtab = nullptr) {
    int tid = threadIdx.x; asm volatile("" : "+v"(tid));
    const int wid = __builtin_amdgcn_readfirstlane(tid >> 6), lane = tid & 63, wr = wid >> 2, wc = wid & 3, fr = lane & 15, fq = lane >> 4;
    const int K = g.K, nt = K / BK;
    unsigned voffA[2], voffB[2];
#pragma unroll
    for (int i = 0; i < 2; ++i) { int R, C; stage_rc(tid * 16 + i * 8192, R, C); const int Rb = (R & ~31) + perm32(R & 31);
        voffA[i] = (unsigned)(R * g.lda + C) * 2u; voffB[i] = (unsigned)(Rb * g.ldb + C) * 2u; }
    const size_t kstep = (size_t)(BK * 2);
    const size_t hstepA = (size_t)HALF * g.lda * 2, hstepB = (size_t)HALF * g.ldb * 2;
    const size_t tstepA = 2 * hstepA, tstepB = 2 * hstepB;
    const unsigned ldsw = (unsigned)wid * 1024u;
    const int aoff = lds_byte(wr * 64 + fr, fq * 8), boff = lds_byte(wc * 32 + fr, fq * 8);
#define PG8_SA(b, h) (((b) * 2 + (h)) * HTB)
#define PG8_SB(b, h) ((4 + (b) * 2 + (h)) * HTB)
#define PG8_STAGE(bufoff, gbase, voff) do { _Pragma("unroll") for (int _i = 0; _i < 2; ++_i) \
        __builtin_amdgcn_global_load_lds((const unsigned*)((const char*)(gbase) + (voff)[_i]), (PG8_LAS unsigned*)(lds + (bufoff) + ldsw + _i * 8192), 16, 0, 0); } while (0)
#define PG8_LDA(dst, b, h) do { _Pragma("unroll") for (int m = 0; m < 4; ++m) _Pragma("unroll") for (int k = 0; k < 2; ++k) dst[m][k] = *(const PG8_LAS bf16x8*)(lds + PG8_SA(b, h) + aoff + m * 2048 + k * 1024); } while (0)
#define PG8_LDB(dst, b, h) do { _Pragma("unroll") for (int n = 0; n < 2; ++n) _Pragma("unroll") for (int k = 0; k < 2; ++k) dst[n][k] = *(const PG8_LAS bf16x8*)(lds + PG8_SB(b, h) + boff + n * 2048 + k * 1024); } while (0)
#define PG8_MMA(ai, bj, At, Bt) do { __builtin_amdgcn_s_setprio(1); _Pragma("unroll") for (int m = 0; m < 4; ++m) _Pragma("unroll") for (int n = 0; n < 2; ++n) _Pragma("unroll") for (int k = 0; k < 2; ++k) \
        acc[ai][bj][m][n] = __builtin_amdgcn_mfma_f32_16x16x32_bf16(Bt[n][k], At[m][k], acc[ai][bj][m][n], 0, 0, 0); __builtin_amdgcn_s_setprio(0); } while (0)
#define PG8_SEGSCALE(tb) do { _Pragma("unroll") for (int ai = 0; ai < 2; ++ai) _Pragma("unroll") for (int m = 0; m < 4; ++m) { const float f_ = (tb)[wr * 64 + fr + ai * HALF + m * 16]; \
        _Pragma("unroll") for (int bj = 0; bj < 2; ++bj) _Pragma("unroll") for (int n = 0; n < 2; ++n) acc[ai][bj][m][n] = acc[ai][bj][m][n] * f_; } } while (0)
#define PG8_WAIT_V(n) asm volatile("s_waitcnt vmcnt(" #n ")" ::: "memory")
#define PG8_WAIT_L(n) asm volatile("s_waitcnt lgkmcnt(" #n ")" ::: "memory")
#define PG8_BAR __builtin_amdgcn_s_barrier()
#define PG8_SCHED __builtin_amdgcn_sched_barrier(0)
    Unit cur, nxt; int ui = 0;
    if (!S.next(0, cur)) return;
    f32x4 acc[2][2][4][2];
#pragma unroll
    for (int a = 0; a < 2; ++a)
#pragma unroll
        for (int b = 0; b < 2; ++b)
#pragma unroll
            for (int m = 0; m < 4; ++m)
#pragma unroll
                for (int n = 0; n < 2; ++n) acc[a][b][m][n] = (f32x4){0.f, 0.f, 0.f, 0.f};
    bf16x8 At[4][2], B0[2][2], B1[2][2];
    const char* cA = (const char*)g.A + (size_t)cur.pm * tstepA + (size_t)cur.pn * g.a_pn_bytes; const char* cB = (const char*)g.Bt + (size_t)cur.pn * tstepB;
    PG8_STAGE(PG8_SB(0, 0), cB, voffB); PG8_STAGE(PG8_SB(0, 1), cB + hstepB, voffB); PG8_STAGE(PG8_SA(0, 0), cA, voffA); PG8_STAGE(PG8_SA(0, 1), cA + hstepA, voffA);
    if (wr == 1) PG8_BAR;
    PG8_WAIT_V(2); PG8_BAR;
    PG8_STAGE(PG8_SB(1, 0), cB + kstep, voffB); PG8_STAGE(PG8_SA(1, 0), cA + kstep, voffA); PG8_STAGE(PG8_SB(1, 1), cB + hstepB + kstep, voffB);
    PG8_WAIT_V(6); PG8_BAR;
    for (;;) {
        const bool has_next = S.next(ui + 1, nxt);
        const char* nA = has_next ? (const char*)g.A + (size_t)nxt.pm * tstepA + (size_t)nxt.pn * g.a_pn_bytes : cA; const char* nB = has_next ? (const char*)g.Bt + (size_t)nxt.pn * tstepB : cB;
        for (int t = 0; t < nt; t += 2) {
            const bool last = (t == nt - 2);
            const char* a1 = cA + (size_t)(t + 1) * kstep;
            const char* a2 = last ? nA : cA + (size_t)(t + 2) * kstep; const char* b2 = last ? nB : cB + (size_t)(t + 2) * kstep;
            const char* a3 = a2 + kstep; const char* b3 = b2 + kstep;
            if constexpr (SEG) { if (t == 6) PG8_SEGSCALE(segtab); }
            PG8_LDB(B0, 0, 0); PG8_LDB(B1, 0, 1); PG8_SCHED; PG8_LDA(At, 0, 0); PG8_STAGE(PG8_SA(1, 1), a1 + hstepA, voffA);
            PG8_WAIT_V(8); PG8_WAIT_L(0); PG8_BAR; PG8_MMA(0, 0, At, B0); PG8_MMA(0, 1, At, B1); PG8_BAR; PG8_SCHED;
            PG8_LDA(At, 0, 1); PG8_STAGE(PG8_SB(0, 0), b2, voffB); PG8_STAGE(PG8_SB(0, 1), b2 + hstepB, voffB); PG8_STAGE(PG8_SA(0, 0), a2, voffA);
            PG8_WAIT_V(8); PG8_WAIT_L(0); PG8_BAR; PG8_MMA(1, 0, At, B0); PG8_MMA(1, 1, At, B1); PG8_BAR; PG8_SCHED;
            if constexpr (SEG) { if (t == 10) PG8_SEGSCALE(segtab + 256); }
            PG8_LDB(B0, 1, 0); PG8_LDB(B1, 1, 1); PG8_SCHED; PG8_LDA(At, 1, 0); PG8_STAGE(PG8_SA(0, 1), a2 + hstepA, voffA);
            PG8_WAIT_V(8); PG8_WAIT_L(0); PG8_BAR; PG8_MMA(0, 0, At, B0); PG8_MMA(0, 1, At, B1); PG8_BAR; PG8_SCHED;
            PG8_LDA(At, 1, 1); PG8_STAGE(PG8_SB(1, 0), b3, voffB); PG8_STAGE(PG8_SB(1, 1), b3 + hstepB, voffB); PG8_STAGE(PG8_SA(1, 0), a3, voffA);
            PG8_WAIT_V(8); PG8_WAIT_L(0); PG8_BAR; PG8_MMA(1, 0, At, B0); PG8_MMA(1, 1, At, B1); PG8_BAR; PG8_SCHED;
        }
        if constexpr (ALIGN_EPI) { if (wr == 0) PG8_BAR; }
        if constexpr (!AFTER_DRAIN) E(acc, cur, wr, wc, fr, fq);
        if (!has_next) break;
#pragma unroll
        for (int a = 0; a < 2; ++a)
#pragma unroll
            for (int b = 0; b < 2; ++b)
#pragma unroll
                for (int m = 0; m < 4; ++m)
#pragma unroll
                    for (int n = 0; n < 2; ++n) acc[a][b][m][n] = (f32x4){0.f, 0.f, 0.f, 0.f};
        cur = nxt; cA = nA; cB = nB; ++ui;
        if constexpr (ALIGN_EPI) { if (wr == 1) PG8_BAR; }
    }
    PG8_WAIT_V(0);
    if constexpr (!ALIGN_EPI) { if (wr == 0) PG8_BAR; }
    PG8_BAR;
    if constexpr (AFTER_DRAIN) E(acc, cur, wr, wc, fr, fq);
#undef PG8_SA
#undef PG8_SB
#undef PG8_STAGE
#undef PG8_LDA
#undef PG8_LDB
#undef PG8_MMA
#undef PG8_WAIT_V
#undef PG8_SEGSCALE
#undef PG8_WAIT_L
#undef PG8_BAR
#undef PG8_SCHED
}
}

constexpr int NWAVES = 8;
constexpr int BATCH = 2, SEQ = 8192, D = 1024, H = 16, HD = 64, FF = 2816;
constexpr int M = BATCH * SEQ;
constexpr size_t MiB = 1u << 20;
constexpr size_t WS_CTL = 0, CTL_ZERO_BYTES = 128 * 1024;
constexpr int CW_HALO = 8192;
constexpr size_t WS_ROPE = 1 * MiB;
constexpr size_t WS_SS = 3 * MiB;
constexpr size_t WS_LSE = 4 * MiB;
constexpr size_t WS_WIN = 6 * MiB;
constexpr size_t WS_WG = 8 * MiB;
constexpr size_t WS_WPO = 9 * MiB;
constexpr size_t WS_WGU0 = 11 * MiB;
constexpr size_t WS_WD0 = 22 * MiB;
constexpr size_t WS_WQKV = 28 * MiB;
constexpr size_t WS_WAO = 34 * MiB;
constexpr size_t WS_WGU1 = 36 * MiB;
constexpr size_t WS_WD1 = 47 * MiB;
constexpr size_t WS_BIG = 56 * MiB;
constexpr size_t WS_XB = 184 * MiB;
constexpr size_t WS_ZO = 216 * MiB;
constexpr size_t WS_HALO = 248 * MiB;
constexpr size_t WS_END = 250 * MiB;
constexpr int CW_BAR = 1024;

constexpr int LDS_BYTES = 147456;

#define GAS __attribute__((address_space(1)))
#define LAS __attribute__((address_space(3)))
typedef unsigned short bf16;
typedef unsigned v4u __attribute__((ext_vector_type(4)));
typedef unsigned v2u __attribute__((ext_vector_type(2)));
typedef float f32x4 __attribute__((ext_vector_type(4)));
#define LDS_WAIT() asm volatile("s_waitcnt lgkmcnt(0)" ::: "memory")
__device__ __forceinline__ unsigned f2bf(float f) { unsigned u = __builtin_bit_cast(unsigned, f); return (u + 0x7fffu + ((u >> 16) & 1u)) >> 16; }
__device__ __forceinline__ unsigned pk2(float lo, float hi) { return f2bf(lo) | (f2bf(hi) << 16); }
__device__ __forceinline__ float bflo(unsigned w) { return __builtin_bit_cast(float, w << 16); }
__device__ __forceinline__ float bfhi(unsigned w) { return __builtin_bit_cast(float, w & 0xffff0000u); }

#define XB_TMO      128
#define XB_XCNT(j)  (256  + 64 * (j))
#define XB_XSUB(j)  (1280 + 64 * (j))
#define XB_XGEN(j)  (2304 + 64 * (j))
#define XB_TOP      3328
#define XB_TOPGEN   3392
#define XCD_BAR_WORDS 3456
#define XB_SPIN_CAP (1u << 22)
__device__ __forceinline__ unsigned xb_ld(unsigned* p)              { return __hip_atomic_load(p, __ATOMIC_RELAXED, __HIP_MEMORY_SCOPE_AGENT); }
__device__ __forceinline__ unsigned xb_add(unsigned* p, unsigned v) { return __hip_atomic_fetch_add(p, v, __ATOMIC_RELAXED, __HIP_MEMORY_SCOPE_AGENT); }
__device__ __forceinline__ unsigned xb_xcc_id() { return (unsigned)__builtin_amdgcn_s_getreg((3 << 11) | 20) & 0xFu; }
#define XB_SPIN(cond, bar) do { unsigned _sp = 0; while (cond) { __builtin_amdgcn_s_sleep(1); \
    if ((++_sp & 255u) == 0u) { if (xb_ld(&(bar)[XB_TMO])) break; if (_sp > XB_SPIN_CAP) { atomicAdd(&(bar)[XB_TMO], 1u); break; } } } } while (0)
struct XcdBarrier { unsigned* bar; unsigned x; volatile LAS unsigned* st; };
__device__ __forceinline__ XcdBarrier xcd_barrier_post(unsigned* bar, volatile LAS unsigned* st) {
    XcdBarrier b; b.bar = bar; b.x = xb_xcc_id(); b.st = st;
    if (threadIdx.x == 0) (void)xb_add(&bar[XB_XCNT(b.x)], 1u);
    return b;
}
__device__ __forceinline__ void xcd_barrier_complete(unsigned* bar, unsigned x, unsigned& nloc, unsigned& nx) {
    const unsigned G = gridDim.x * gridDim.y * gridDim.z;
    unsigned sum, cnt, mine, sp = 0u;
    for (;;) {
        sum = 0u; cnt = 0u; mine = 0u;
#pragma unroll
        for (unsigned j = 0; j < 16; ++j) { const unsigned c = xb_ld(&bar[XB_XCNT(j)]); sum += c; cnt += (c > 0u) ? 1u : 0u; mine = (j == x) ? c : mine; }
        if (sum == G) break;
        __builtin_amdgcn_s_sleep(1);
        if ((++sp & 255u) == 0u) { if (xb_ld(&bar[XB_TMO])) break; if (sp > XB_SPIN_CAP) { atomicAdd(&bar[XB_TMO], 1u); break; } }
    }
    nloc = mine > 0u ? mine : 1u; nx = cnt > 0u ? cnt : 1u;
}
__device__ __forceinline__ void xcd_barrier(const XcdBarrier& b) {
    asm volatile("s_waitcnt vmcnt(0)" ::: "memory");
    __syncthreads();
    if (threadIdx.x == 0) {
        unsigned* bar = b.bar;
        __builtin_amdgcn_s_waitcnt(0);
        unsigned nloc = b.st[0], nx = b.st[1];
        if (nloc == 0u) { xcd_barrier_complete(bar, b.x, nloc, nx); b.st[0] = nloc; b.st[1] = nx; }
        const unsigned old = xb_add(&bar[XB_XSUB(b.x)], 1u);
        const unsigned gen = old / nloc;
        if (old + 1u == (gen + 1u) * nloc) {
            __builtin_amdgcn_fence(__ATOMIC_RELEASE, "agent");
            asm volatile("s_waitcnt vmcnt(0)" ::: "memory");
            const unsigned og = xb_add(&bar[XB_TOP], 1u);
            const unsigned tg = og / nx;
            if (og + 1u == (tg + 1u) * nx) xb_add(&bar[XB_TOPGEN], 1u);
            else XB_SPIN(xb_ld(&bar[XB_TOPGEN]) == tg, bar);
            __builtin_amdgcn_fence(__ATOMIC_ACQUIRE, "agent");
            xb_add(&bar[XB_XGEN(b.x)], 1u);
            asm volatile("s_waitcnt vmcnt(0)" ::: "memory");
        } else {
            XB_SPIN(xb_ld(&bar[XB_XGEN(b.x)]) == gen, bar);
            __builtin_amdgcn_fence(__ATOMIC_ACQUIRE, "agent");
            asm volatile("s_waitcnt vmcnt(0)" ::: "memory");
        }
    }
    __syncthreads();
}

struct EpiFinal {
    const bf16* xb; float* out; float* ss; const float* gf; XcdBarrier bar;
    __device__ __forceinline__ void load_base(int row, int col0, pg8::f32x4 (&nb)[4]) const {
        using pg8::f32x4; using pg8::u32x4; using pg8::bf_lo; using pg8::bf_hi;
        const bf16* bp = xb + (size_t)row * 1024 + col0; const u32x4 a = *(const u32x4*)(bp), c = *(const u32x4*)(bp + pg8::HALF);
        nb[0] = (f32x4){bf_lo(a.x), bf_hi(a.x), bf_lo(a.y), bf_hi(a.y)}; nb[1] = (f32x4){bf_lo(a.z), bf_hi(a.z), bf_lo(a.w), bf_hi(a.w)};
        nb[2] = (f32x4){bf_lo(c.x), bf_hi(c.x), bf_lo(c.y), bf_hi(c.y)}; nb[3] = (f32x4){bf_lo(c.z), bf_hi(c.z), bf_lo(c.w), bf_hi(c.w)};
    }
    __device__ __forceinline__ void operator()(pg8::f32x4 (&acc)[2][2][4][2], const pg8::Unit& u, int wr, int wc, int fr, int fq) const {
        using pg8::f32x4; using pg8::HALF; using pg8::BM;
        const int row0 = u.pm * BM + wr * 64 + fr, col0 = u.pn * BM + wc * 32 + 8 * fq;
        f32x4 nb[4];
        load_base(row0, col0, nb);
#pragma unroll
        for (int it = 0; it < 8; ++it) { const int ai = it >> 2, m = it & 3;
            const size_t row = (size_t)(row0 + ai * HALF + m * 16); float s = 0.f;
            const f32x4 b0 = nb[0], b1 = nb[1], b2 = nb[2], b3 = nb[3];
            if (it < 7) load_base(row0 + ((it + 1) >> 2) * HALF + ((it + 1) & 3) * 16, col0, nb);
#pragma unroll
            for (int bj = 0; bj < 2; ++bj) {
                const f32x4 v0 = acc[ai][bj][m][0] + (bj == 0 ? b0 : b2), v1 = acc[ai][bj][m][1] + (bj == 0 ? b1 : b3);
                acc[ai][bj][m][0] = v0; acc[ai][bj][m][1] = v1;
                s += (v0[0] * v0[0] + v0[1] * v0[1]) + (v0[2] * v0[2] + v0[3] * v0[3]) + (v1[0] * v1[0] + v1[1] * v1[1]) + (v1[2] * v1[2] + v1[3] * v1[3]); }
            s += __shfl_xor(s, 16); s += __shfl_xor(s, 32);
            if (fq == 0) ss[row * 16 + u.pn * 4 + wc] = s; }
        xcd_barrier(bar);
        f32x4 gq[2][2];
#pragma unroll
        for (int bj = 0; bj < 2; ++bj)
#pragma unroll
            for (int n = 0; n < 2; ++n) gq[bj][n] = *(const f32x4*)(gf + col0 + bj * HALF + 4 * n);
        f32x4 pr[8];
#pragma unroll
        for (int it = 0; it < 8; ++it) pr[it] = *(const f32x4*)(ss + (size_t)(row0 + (it >> 2) * HALF + (it & 3) * 16) * 16 + 4 * fq);
#pragma unroll
        for (int it = 0; it < 8; ++it) { const int ai = it >> 2, m = it & 3;
            const size_t row = (size_t)(row0 + ai * HALF + m * 16); const size_t off = row * 1024 + col0;
            float sq = (pr[it][0] + pr[it][1]) + (pr[it][2] + pr[it][3]); sq += __shfl_xor(sq, 16); sq += __shfl_xor(sq, 32);
            const float rstd = rsqrtf(sq * (1.0f / 1024.0f) + pg8::RMS_EPS);
#pragma unroll
            for (int bj = 0; bj < 2; ++bj) { *(f32x4*)(out + off + bj * HALF) = acc[ai][bj][m][0] * rstd * gq[bj][0]; *(f32x4*)(out + off + bj * HALF + 4) = acc[ai][bj][m][1] * rstd * gq[bj][1]; } }
    }
};

struct EpiPool {
    LAS unsigned char* lds; const bf16* h; const bf16* wt; bf16* p; bf16* hbuf; unsigned* flags; unsigned* tmo;
    static constexpr int PITCH = 528;
    __device__ __forceinline__ void operator()(pg8::f32x4 (&acc)[2][2][4][2], const pg8::Unit& u, int wr, int wc, int fr, int fq) const {
        using pg8::f32x4; using pg8::u32x4; using pg8::bf16x8; using pg8::cvt_pk_bf16;
        int tid = threadIdx.x; asm volatile("" : "+v"(tid)); const int lane = tid & 63; const int wid = __builtin_amdgcn_readfirstlane(tid >> 6);
#pragma unroll
        for (int ai = 0; ai < 2; ++ai)
#pragma unroll
            for (int m = 0; m < 4; ++m) { const int r = ai * 128 + wr * 64 + m * 16 + fr;
#pragma unroll
                for (int bj = 0; bj < 2; ++bj) { const f32x4 v0 = acc[ai][bj][m][0], v1 = acc[ai][bj][m][1];
                    u32x4 w; w.x = cvt_pk_bf16(v0[0], v0[1]); w.y = cvt_pk_bf16(v0[2], v0[3]); w.z = cvt_pk_bf16(v1[0], v1[1]); w.w = cvt_pk_bf16(v1[2], v1[3]);
                    *(LAS u32x4*)(lds + (16 + r) * PITCH + (bj * 128 + wc * 32 + 8 * fq) * 2) = w;
                    if (ai == 1 && m == 3 && wr == 1) {
                        bf16* hp_ = hbuf + ((size_t)(u.pm * 4 + u.pn) * 16 + fr) * 256 + bj * 128 + wc * 32 + 8 * fq;
                        asm volatile("global_store_dwordx4 %0, %1, off sc1\n\ts_nop 1" :: "v"(hp_), "v"(w) : "memory"); } } }
        asm volatile("s_waitcnt vmcnt(0)" ::: "memory");
        __syncthreads();
        if (tid == 0) __hip_atomic_store(flags + (u.pm * 4 + u.pn) * 64, 1u, __ATOMIC_RELAXED, __HIP_MEMORY_SCOPE_AGENT);
        const bool seq_start = (u.pm & 31) == 0;
        if (seq_start) { for (int e = tid; e < 16 * 32; e += 512) *(LAS u32x4*)(lds + (e >> 5) * PITCH + (e & 31) * 16) = (u32x4){0u, 0u, 0u, 0u}; }
        else {
            if (tid == 0) { unsigned* fl = flags + ((u.pm - 1) * 4 + u.pn) * 64; XB_SPIN(xb_ld(fl) == 0u, tmo);
                __builtin_amdgcn_fence(__ATOMIC_ACQUIRE, "agent"); asm volatile("s_waitcnt vmcnt(0)" ::: "memory"); }
            __syncthreads();
            const u32x4 hv = *(const GAS u32x4*)(hbuf + (size_t)((u.pm - 1) * 4 + u.pn) * 4096 + tid * 8);
            *(LAS u32x4*)(lds + (tid >> 5) * PITCH + (tid & 31) * 16) = hv;
        }
        LDS_WAIT(); __syncthreads();
        const int cq = tid & 63, seg = tid >> 6, w = 2 << u.pn;
        const LAS unsigned char* colp = lds + cq * 8;
#define EP_RD4(rowi) ({ const v2u q_ = *(const LAS v2u*)(colp + (rowi) * PITCH); (f32x4){bflo(q_.x), bfhi(q_.x), bflo(q_.y), bfhi(q_.y)}; })
        f32x4 S = {0.f, 0.f, 0.f, 0.f};
        for (int d = 1; d < w; ++d) S = S + EP_RD4(16 + 32 * seg - d);
        const float invw = 1.0f / (float)w;
        bf16* pp = p + (size_t)(u.pm * 256 + 32 * seg) * 1024 + u.pn * 256 + 4 * cq;
        const int t0 = ((u.pm & 31) * 256) + 32 * seg;
#pragma unroll 4
        for (int r = 0; r < 32; ++r) {
            const int lr = 16 + 32 * seg + r;
            const f32x4 uc = EP_RD4(lr);
            S = S + uc;
            const int t = t0 + r; const float inv = (t + 1 >= w) ? invw : 1.0f / (float)(t + 1);
            const f32x4 o = S * inv - uc;
            *(GAS v2u*)(pp + (size_t)r * 1024) = (v2u){pk2(o[0], o[1]), pk2(o[2], o[3])};
            S = S - EP_RD4(lr - (w - 1));
        }
#undef EP_RD4
        LDS_WAIT(); __syncthreads();
    }
};

struct Frame {
    LAS unsigned char* lds;
    int tid, lane, wave, vcu, G;
};
__device__ __forceinline__ float wave_sum(float v) {
#pragma unroll
    for (int o = 1; o < 64; o <<= 1) v += __shfl_xor(v, o);
    return v;
}

constexpr int LDS_RSTAB = 131072 + 4096;
__device__ __forceinline__ pg8::RsTab fill_rstd_tab(LAS unsigned char* lds, const float* ss, int pm) {
    LAS float* tab = (LAS float*)(lds + LDS_RSTAB);
    int tid = threadIdx.x; asm volatile("" : "+v"(tid));
    if (tid < 256) { const float* p = ss + ((size_t)pm * 256 + tid) * 16; float s = 0.f;
#pragma unroll
        for (int q = 0; q < 4; ++q) { const f32x4 v = *(const GAS f32x4*)(p + 4 * q); s += (v[0] + v[1]) + (v[2] + v[3]); }
        tab[tid] = rsqrtf(s * (1.0f / 1024.0f) + 1e-6f); }
    LDS_WAIT(); __syncthreads();
    pg8::RsTab r; r.tab = tab; r.pm = pm; return r;
}

__device__ __forceinline__ const LAS float* seg_fill(LAS unsigned char* lds, const float* lse, int pm) {
    LAS float* tab = (LAS float*)(lds + LDS_RSTAB);
    int tid = threadIdx.x; asm volatile("" : "+v"(tid));
    if (tid < 256) { const float* p = lse + ((size_t)pm * 256 + tid) * 16; float L[16];
#pragma unroll
        for (int q4 = 0; q4 < 4; ++q4) { const f32x4 v = *(const GAS f32x4*)(p + 4 * q4); L[4 * q4] = v[0]; L[4 * q4 + 1] = v[1]; L[4 * q4 + 2] = v[2]; L[4 * q4 + 3] = v[3]; }
        float lg0, lg1, lg2;
        { float mx = L[0];
_Pragma("unroll") for (int i = 1; i < 6; ++i) mx = fmaxf(mx, L[i]); float s = 0.f;
_Pragma("unroll") for (int i = 0; i < 6; ++i) s += __expf(L[i] - mx); lg0 = mx + __logf(s) - 1.791759469228055f; }
        { float mx = L[6];
_Pragma("unroll") for (int i = 7; i < 11; ++i) mx = fmaxf(mx, L[i]); float s = 0.f;
_Pragma("unroll") for (int i = 6; i < 11; ++i) s += __expf(L[i] - mx); lg1 = mx + __logf(s) - 1.6094379124341003f; }
        { float mx = L[11];
_Pragma("unroll") for (int i = 12; i < 16; ++i) mx = fmaxf(mx, L[i]); float s = 0.f;
_Pragma("unroll") for (int i = 11; i < 16; ++i) s += __expf(L[i] - mx); lg2 = mx + __logf(s) - 1.6094379124341003f; }
        const float mx = fmaxf(lg0, fmaxf(lg1, lg2));
        const float e0 = __expf(lg0 - mx), e1 = __expf(lg1 - mx), e2 = __expf(lg2 - mx); const float is = 3.0f / (e0 + e1 + e2);
        const float s0 = fmaxf(e0 * is, 1e-30f), s1 = fmaxf(e1 * is, 1e-30f), s2 = fmaxf(e2 * is, 1e-30f);
        tab[tid] = s0 / s1; tab[256 + tid] = s1 / s2; tab[512 + tid] = s2; }
    LDS_WAIT(); __syncthreads();
    return tab;
}

__device__ __forceinline__ int p0_map_row(int mode, int sel, int row_off, int n) {
    if (mode == 0) return row_off + n;
    if (mode == 1) return 256 * (n >> 7) + 128 * sel + (n & 127);
    const int pn = n >> 8, w = n & 255, wc = w >> 6, d = w & 63; return 256 * pn + 128 * (d >> 5) + 32 * wc + (d & 31);
}
__device__ __forceinline__ void p0_tr_item(const float* W, int K, int N, bf16* WT, int mode, int sel, int row_off, const float* kgain, const float* nscale, LAS unsigned* scr, int item, int lane) {
    const int nblk = N / 64, kb = item / nblk, nb = item % nblk, k0 = 64 * kb, n0 = 64 * nb;
    const int kq = lane >> 4, n4 = (lane & 15) * 4;
    f32x4 ns = (f32x4){1.f, 1.f, 1.f, 1.f}; if (nscale) ns = *(const GAS f32x4*)(nscale + n0 + n4);
    f32x4 v[16];
#pragma unroll
    for (int i = 0; i < 16; ++i) { const int k = 8 * (i >> 1) + 2 * kq + (i & 1); v[i] = *(const GAS f32x4*)(W + (size_t)(k0 + k) * N + n0 + n4); }
    if (kgain) {
#pragma unroll
        for (int i = 0; i < 16; ++i) { const int k = 8 * (i >> 1) + 2 * kq + (i & 1); v[i] = v[i] * kgain[k0 + k]; }
    }
#pragma unroll
    for (int ip = 0; ip < 8; ++ip) { const f32x4 e = v[2 * ip] * ns, o = v[2 * ip + 1] * ns;
#pragma unroll
        for (int c = 0; c < 4; ++c) scr[(n4 + c) * 33 + 4 * ip + kq] = pk2(e[c], o[c]); }
    LDS_WAIT(); asm volatile("" ::: "memory");
    const int kc = lane & 7;
#pragma unroll
    for (int jj = 0; jj < 8; ++jj) { const int n = (lane >> 3) + 8 * jj; const LAS unsigned* sp = scr + n * 33 + 4 * kc;
        v4u o; o.x = sp[0]; o.y = sp[1]; o.z = sp[2]; o.w = sp[3];
        *(GAS v4u*)(WT + (size_t)p0_map_row(mode, sel, row_off, n0 + n) * K + k0 + 8 * kc) = o; }
    LDS_WAIT(); asm volatile("" ::: "memory");
}

struct Args { const float* in[13]; float* out; unsigned char* ws; int ph_lo, ph_hi; };

__device__ __forceinline__ void sincos_acc(float angf, float& c, float& s) {
    const double x = (double)angf; const double k = __builtin_rint(x * 0.15915494309189535);
    double y = (x - k * 6.283185307179586) * 0.25;
    const double y2 = y * y;
    double sn = y * (1.0 + y2 * (-1.0 / 6 + y2 * (1.0 / 120 + y2 * (-1.0 / 5040 + y2 * (1.0 / 362880 + y2 * (-1.0 / 39916800 + y2 * (1.0 / 6227020800.0)))))));
    double cs = 1.0 + y2 * (-0.5 + y2 * (1.0 / 24 + y2 * (-1.0 / 720 + y2 * (1.0 / 40320 + y2 * (-1.0 / 3628800 + y2 * (1.0 / 479001600.0 + y2 * (-1.0 / 87178291200.0)))))));
#pragma unroll
    for (int i = 0; i < 2; ++i) { const double s2 = 2.0 * sn * cs, c2 = 1.0 - 2.0 * sn * sn; sn = s2; cs = c2; }
    c = (float)cs; s = (float)sn;
}

template <int GI>
__device__ __forceinline__ void pool_group(f32x4 (&cur)[16], f32x4 (&prev)[16], f32x4& S2, f32x4& S4, f32x4& S8, f32x4& S16, const f32x4 gv, const float* x, bf16* hp,
                                           int R0, bool bstart, int c4, int hl, int lane, int wq, LAS float* part, LAS float* rs) {
    const bool zero = (GI == 0) && bstart;
#pragma unroll
    for (int j = 0; j < 16; ++j) { const f32x4 v = cur[j]; part[j * 256 + hl] = (v[0] * v[0] + v[1] * v[1]) + (v[2] * v[2] + v[3] * v[3]); }
    LDS_WAIT(); __syncthreads();
#pragma unroll
    for (int q = 0; q < 4; ++q) { const int j = 4 * wq + q; const f32x4 p = *(const LAS f32x4*)(part + j * 256 + 4 * lane);
        const float s = wave_sum((p[0] + p[1]) + (p[2] + p[3])); if (lane == 0) rs[j] = zero ? 0.f : rsqrtf(s * (1.0f / D) + 1e-6f); }
    LDS_WAIT(); __syncthreads();
#pragma unroll
    for (int j = 0; j < 16; ++j) {
        const int row = R0 - 16 + GI * 16 + j;
        const f32x4 hv = cur[j] * rs[j] * gv;
        const f32x4 h2 = j >= 2 ? cur[j >= 2 ? j - 2 : 0] : prev[(j + 14) & 15], h4 = j >= 4 ? cur[j >= 4 ? j - 4 : 0] : prev[(j + 12) & 15], h8 = j >= 8 ? cur[j >= 8 ? j - 8 : 0] : prev[(j + 8) & 15];
        S2 = S2 + hv - h2; S4 = S4 + hv - h4; S8 = S8 + hv - h8; S16 = S16 + hv - prev[j];
        cur[j] = hv;
        if (GI < 2) prev[j] = *(const GAS f32x4*)(x + (size_t)(row + 16) * D + 4 * c4);
        if (GI > 0) {
            const int t = row & (SEQ - 1);
            const float i2 = t >= 1 ? 0.5f : 1.0f, i4 = t >= 3 ? 0.25f : 1.0f / (float)(t + 1), i8 = t >= 7 ? 0.125f : 1.0f / (float)(t + 1), i16 = t >= 15 ? 0.0625f : 1.0f / (float)(t + 1);
            const f32x4 o2 = S2 * i2 - hv, o4 = S4 * i4 - hv, o8 = S8 * i8 - hv, o16 = S16 * i16 - hv;
            const size_t off = (size_t)row * D + 4 * c4;
            *(GAS v2u*)(hp + off) = (v2u){pk2(o2[0], o2[1]), pk2(o2[2], o2[3])};
            *(GAS v2u*)(hp + (size_t)M * D + off) = (v2u){pk2(o4[0], o4[1]), pk2(o4[2], o4[3])};
            *(GAS v2u*)(hp + 2 * (size_t)M * D + off) = (v2u){pk2(o8[0], o8[1]), pk2(o8[2], o8[3])};
            *(GAS v2u*)(hp + 3 * (size_t)M * D + off) = (v2u){pk2(o16[0], o16[1]), pk2(o16[2], o16[3])};
        }
    }
}

constexpr int I_SQ = 16 * 16, I_GU = 16 * 44, I_DN = 44 * 16, I_QKV = 16 * 48, I_W2 = 4 * 32 * 8;
constexpr int W_EARLY = I_W2 + I_SQ + 2 * I_GU, W_ITEMS = W_EARLY + I_DN + I_QKV + I_SQ + 2 * I_GU + I_DN;
__device__ __forceinline__ void w2_item(const Args& a, int it, int lane) {
    typedef float f32x16 __attribute__((ext_vector_type(16)));
    const int g = it >> 8, r = it & 255, n0 = (r >> 3) * 32, c0 = (r & 7) * 32, i = lane & 31, h = lane >> 5;
    const float* wout = a.in[7] + (size_t)(g * 256) * 1024 + n0 + i;
    const float* wgr = a.in[5] + (size_t)g * 65536 + (size_t)(c0 + i) * 256;
    const float* sc = a.in[6] + g * 256;
    f32x16 acc = {0.f, 0.f, 0.f, 0.f, 0.f, 0.f, 0.f, 0.f, 0.f, 0.f, 0.f, 0.f, 0.f, 0.f, 0.f, 0.f};
#pragma unroll 1
    for (int ch = 0; ch < 4; ++ch) {
        float av[4][8]; f32x4 bv[4][2], sv[4][2];
#pragma unroll
        for (int ks = 0; ks < 4; ++ks) { const int j0 = 64 * ch + 16 * ks + 8 * h;
#pragma unroll
            for (int e = 0; e < 8; ++e) av[ks][e] = wout[(size_t)(j0 + e) * 1024];
            bv[ks][0] = *(const GAS f32x4*)(wgr + j0); bv[ks][1] = *(const GAS f32x4*)(wgr + j0 + 4);
            sv[ks][0] = *(const GAS f32x4*)(sc + j0); sv[ks][1] = *(const GAS f32x4*)(sc + j0 + 4); }
        asm volatile("" ::: "memory"); __builtin_amdgcn_sched_barrier(0);
#pragma unroll
        for (int ks = 0; ks < 4; ++ks) {
            pg8::u32x4 aw, bw; const f32x4 b0 = bv[ks][0] * sv[ks][0], b1 = bv[ks][1] * sv[ks][1];
            aw.x = pg8::cvt_pk_bf16(av[ks][0], av[ks][1]); aw.y = pg8::cvt_pk_bf16(av[ks][2], av[ks][3]); aw.z = pg8::cvt_pk_bf16(av[ks][4], av[ks][5]); aw.w = pg8::cvt_pk_bf16(av[ks][6], av[ks][7]);
            bw.x = pg8::cvt_pk_bf16(b0[0], b0[1]); bw.y = pg8::cvt_pk_bf16(b0[2], b0[3]); bw.z = pg8::cvt_pk_bf16(b1[0], b1[1]); bw.w = pg8::cvt_pk_bf16(b1[2], b1[3]);
            acc = __builtin_amdgcn_mfma_f32_32x32x16_bf16(__builtin_bit_cast(pg8::bf16x8, aw), __builtin_bit_cast(pg8::bf16x8, bw), acc, 0, 0, 0);
        }
    }
    bf16* W2T = (bf16*)(a.ws + WS_WPO) + (size_t)n0 * 1024 + g * 256 + c0 + i;
#pragma unroll
    for (int rr = 0; rr < 16; ++rr) W2T[(size_t)((rr & 3) + 8 * (rr >> 2) + 4 * h) * 1024] = (bf16)f2bf(acc[rr]);
}
__device__ __forceinline__ void weight_item(const Args& a, int it, LAS unsigned* scr, int lane) {
    unsigned char* ws = a.ws; const float* norm_mix = a.in[1]; const float* norm_ffn = a.in[2];
    int r = it;
    if (r < I_W2) { w2_item(a, r, lane); return; } r -= I_W2;
    if (r < I_SQ) { p0_tr_item(a.in[4], D, D, (bf16*)(ws + WS_WIN), 0, 0, 0, nullptr, nullptr, scr, r, lane); return; } r -= I_SQ;
    if (r < I_GU) { p0_tr_item(a.in[10], D, FF, (bf16*)(ws + WS_WGU0), 1, 0, 0, norm_ffn, nullptr, scr, r, lane); return; } r -= I_GU;
    if (r < I_GU) { p0_tr_item(a.in[11], D, FF, (bf16*)(ws + WS_WGU0), 1, 1, 0, norm_ffn, nullptr, scr, r, lane); return; } r -= I_GU;
    if (r < I_DN) { p0_tr_item(a.in[12], FF, D, (bf16*)(ws + WS_WD0), 0, 0, 0, nullptr, nullptr, scr, r, lane); return; } r -= I_DN;
    if (r < I_QKV) { p0_tr_item(a.in[8], D, 3 * D, (bf16*)(ws + WS_WQKV), 2, 0, 0, norm_mix + D, nullptr, scr, r, lane); return; } r -= I_QKV;
    if (r < I_SQ) { p0_tr_item(a.in[9], D, D, (bf16*)(ws + WS_WAO), 0, 0, 0, nullptr, nullptr, scr, r, lane); return; } r -= I_SQ;
    if (r < I_GU) { p0_tr_item(a.in[10] + (size_t)D * FF, D, FF, (bf16*)(ws + WS_WGU1), 1, 0, 0, norm_ffn + D, nullptr, scr, r, lane); return; } r -= I_GU;
    if (r < I_GU) { p0_tr_item(a.in[11] + (size_t)D * FF, D, FF, (bf16*)(ws + WS_WGU1), 1, 1, 0, norm_ffn + D, nullptr, scr, r, lane); return; } r -= I_GU;
    p0_tr_item(a.in[12] + (size_t)D * FF, FF, D, (bf16*)(ws + WS_WD1), 0, 0, 0, nullptr, nullptr, scr, r, lane);
}
__device__ __forceinline__ void rope_entries(unsigned char* ws, int first, int stride) {
    float* rope = (float*)(ws + WS_ROPE);
    for (int e = first; e < SEQ * 32; e += stride) {
        const int t = e >> 5, j = e & 31;
        const float invf = (float)(1.0 / (double)(float)exp2(13.287712379549449 * (double)j / 32.0));
        const float ang = (float)t * invf; float c, s; sincos_acc(ang, c, s);
        rope[(size_t)t * 64 + j] = c; rope[(size_t)t * 64 + 32 + j] = s;
    }
}
__device__ __forceinline__ void late_prep(const Args& a0, LAS unsigned char* lds, int widx, int nidle) {
    Args a = a0;
#pragma unroll
    for (int i = 0; i < 13; ++i) asm volatile("" : "+s"(a.in[i]));
    asm volatile("" : "+s"(a.ws));
    int tid = threadIdx.x; asm volatile("" : "+v"(tid)); const int lane = tid & 63, wave = __builtin_amdgcn_readfirstlane(tid >> 6);
    LAS unsigned* scr = (LAS unsigned*)(lds + wave * 16384);
    for (int it = W_EARLY + widx * NWAVES + wave; it < W_ITEMS; it += nidle * NWAVES) weight_item(a, it, scr, lane);
}

__device__ __forceinline__ void p0_prologue(const Frame& F0, const Args& a, bool defer_late, bool pool_epi) {
    Frame F = F0; { int tid = threadIdx.x; asm volatile("" : "+v"(tid)); F.tid = tid; F.lane = tid & 63; F.wave = __builtin_amdgcn_readfirstlane(tid >> 6); }
    unsigned char* ws = a.ws;
    LAS unsigned* scr = (LAS unsigned*)(F.lds + F.wave * 16384);
    const int gw = F.vcu * NWAVES + F.wave, NGW = F.G * NWAVES;
    const float* norm_mix = a.in[1];
    const int n_items = defer_late ? W_EARLY : W_ITEMS;
    for (int it = gw; it < n_items; it += NGW) weight_item(a, it, scr, F.lane);
    rope_entries(ws, F.vcu * NWAVES * 64 + F.tid, F.G * NWAVES * 64);
    __syncthreads();
    if (pool_epi) {
        const float* x = a.in[0]; bf16* hb = (bf16*)(ws + WS_BIG);
        f32x4 gv[4];
#pragma unroll
        for (int j = 0; j < 4; ++j) gv[j] = *(const GAS f32x4*)(norm_mix + 4 * F.lane + 256 * j);
        const int gwr = F.vcu * NWAVES + F.wave;
        for (int m = gwr; m < M; m += 2 * NGW) {
            const int m2 = (m + NGW < M) ? m + NGW : m;
            const GAS f32x4* x1 = (const GAS f32x4*)(x + (size_t)m * D) + F.lane; const GAS f32x4* x2 = (const GAS f32x4*)(x + (size_t)m2 * D) + F.lane;
            f32x4 v[4], w2[4]; float s1 = 0.f, s2 = 0.f;
#pragma unroll
            for (int j = 0; j < 4; ++j) { v[j] = x1[64 * j]; w2[j] = x2[64 * j]; }
#pragma unroll
            for (int j = 0; j < 4; ++j) { s1 += (v[j][0] * v[j][0] + v[j][1] * v[j][1]) + (v[j][2] * v[j][2] + v[j][3] * v[j][3]); s2 += (w2[j][0] * w2[j][0] + w2[j][1] * w2[j][1]) + (w2[j][2] * w2[j][2] + w2[j][3] * w2[j][3]); }
            const float r1 = rsqrtf(wave_sum(s1) * (1.0f / D) + 1e-6f), r2 = rsqrtf(wave_sum(s2) * (1.0f / D) + 1e-6f);
            GAS v2u* o1 = (GAS v2u*)(hb + (size_t)m * D) + F.lane; GAS v2u* o2 = (GAS v2u*)(hb + (size_t)m2 * D) + F.lane;
#pragma unroll
            for (int j = 0; j < 4; ++j) { const f32x4 a1 = v[j] * r1 * gv[j], a2 = w2[j] * r2 * gv[j];
                o1[64 * j] = (v2u){pk2(a1[0], a1[1]), pk2(a1[2], a1[3])}; o2[64 * j] = (v2u){pk2(a2[0], a2[1]), pk2(a2[2], a2[3])}; }
        }
    } else
    {
        const float* x = a.in[0]; const float* g0 = norm_mix;
        bf16* hp = (bf16*)(ws + WS_BIG);
        const int half = F.tid >> 8, c4 = F.tid & 255, hl = c4, wq = F.wave & 3;
        LAS float* part = (LAS float*)(F.lds) + half * (16 * 256);
        LAS float* rs = (LAS float*)(F.lds + 32768) + half * 16;
        const f32x4 gv = *(const GAS f32x4*)(g0 + 4 * c4);
        for (int blk = F.vcu; blk < M / 64; blk += F.G) {
            const int R0 = blk * 64 + half * 32;
            const bool bstart = (R0 & (SEQ - 1)) == 0;
            f32x4 A[16], B[16];
#pragma unroll
            for (int j = 0; j < 16; ++j) { B[j] = (f32x4){0.f, 0.f, 0.f, 0.f}; A[j] = B[j]; if (!bstart) A[j] = *(const GAS f32x4*)(x + (size_t)(R0 - 16 + j) * D + 4 * c4); }
            f32x4 S2 = B[0], S4 = B[0], S8 = B[0], S16 = B[0];
            pool_group<0>(A, B, S2, S4, S8, S16, gv, x, hp, R0, bstart, c4, hl, F.lane, wq, part, rs);
            pool_group<1>(B, A, S2, S4, S8, S16, gv, x, hp, R0, bstart, c4, hl, F.lane, wq, part, rs);
            pool_group<2>(A, B, S2, S4, S8, S16, gv, x, hp, R0, bstart, c4, hl, F.lane, wq, part, rs);
            __syncthreads();
        }
    }
}

namespace att {
typedef short bf16x8 __attribute__((ext_vector_type(8)));
typedef short s16x4 __attribute__((ext_vector_type(4)));
typedef float f32x16 __attribute__((ext_vector_type(16)));
typedef unsigned u32x4 __attribute__((ext_vector_type(4)));
constexpr int KCH = 6160;
constexpr int LDS_K = 0, LDS_V = 8 * KCH, VDH = 24 * 1024 + 64, LDS_OST = LDS_V + 2 * VDH, LDS_TOTAL = LDS_OST + 8 * 4096;
static_assert(LDS_TOTAL <= LDS_BYTES, "attention LDS");
__device__ __forceinline__ int crow(int r, int hi) { return (r & 3) + 8 * (r >> 2) + 4 * hi; }
__device__ __forceinline__ s16x4 vtr(const LAS unsigned char* p) { return __builtin_bit_cast(s16x4, __builtin_amdgcn_ds_read_tr16_b64_v4i16((LAS s16x4*)p)); }
struct KVQ { u32x4 k[6], v[6]; bf16x8 q[4]; };
__device__ __forceinline__ void attn_load(int item, const bf16* Qp, const bf16* Kp, const bf16* Vp, KVQ& R, int tid, int wid, int r32, int hi) {
    const int bh = item >> 5, j = item & 31, h = bh & 15;
    const int dsh = h < 6 ? 0 : (h < 11 ? 2 : 4);
    const bool first = (j & ((32 >> dsh) - 1)) == 0;
    const size_t hb = (size_t)bh * (SEQ * 64);
    const int pos0 = j * 256;
#pragma unroll
    for (int it = 0; it < 6; ++it) {
        const int p = tid + 512 * it, key = p >> 3, c = p & 7;
        const int keyc = (first && key < 128) ? 128 : key;
        const size_t go = hb + (size_t)(pos0 - 128 + keyc) * 64 + c * 8; R.k[it] = *(const GAS u32x4*)(Kp + go); R.v[it] = *(const GAS u32x4*)(Vp + go);
    }
#pragma unroll
    for (int d0 = 0; d0 < 4; ++d0) R.q[d0] = *(const GAS bf16x8*)(Qp + hb + (size_t)(pos0 + 32 * wid + r32) * 64 + d0 * 16 + hi * 8);
}
__device__ __forceinline__ void attn_phase(int item0, int nitems, const bf16* Qp, const bf16* Kp, const bf16* Vp, bf16* O, float* lse, LAS unsigned char* shm) {
    int tid = threadIdx.x; asm volatile("" : "+v"(tid));
    const int wid = __builtin_amdgcn_readfirstlane(tid >> 6);
    KVQ R;
    if (nitems > 0) attn_load(item0, Qp, Kp, Vp, R, tid, wid, tid & 31, (tid & 63) >> 5);
#pragma unroll 1
  for (int ii = 0; ii < nitems; ++ii) {
    asm volatile("" : "+v"(tid));
    const int lane = tid & 63, r32 = lane & 31, hi = lane >> 5;
    const int item = item0 + ii, bh = item >> 5, j = item & 31;
    const int b = bh >> 4, h = bh & 15;
    const int dsh = h < 6 ? 0 : (h < 11 ? 2 : 4);
    const int nqb = 32 >> dsh, r = j >> (5 - dsh), qb = j & (nqb - 1);
    const bool first = (qb == 0);
#pragma unroll
    for (int it = 0; it < 6; ++it) {
        const int p = tid + 512 * it, key = p >> 3, c = p & 7;
        const bool dead = first && key < 128; const u32x4 z4 = (u32x4){0u, 0u, 0u, 0u};
        *(LAS u32x4*)(shm + LDS_K + c * KCH + key * 16) = dead ? z4 : R.k[it];
        *(LAS u32x4*)(shm + LDS_V + (c >> 2) * VDH + (key >> 4) * 1024 + (key & 15) * 64 + (c & 3) * 16) = dead ? z4 : R.v[it];
    }
    bf16x8 qr[4];
#pragma unroll
    for (int d0 = 0; d0 < 4; ++d0) qr[d0] = R.q[d0];
    LDS_WAIT(); __syncthreads();
    if (ii + 1 < nitems) attn_load(item + 1, Qp, Kp, Vp, R, tid, wid, r32, hi);
    f32x16 P[5];
    const LAS unsigned char* kbase = shm + LDS_K + hi * KCH + (32 * wid + r32) * 16;
#pragma unroll
    for (int kt = 0; kt < 5; ++kt) {
        f32x16 acc = {0.f, 0.f, 0.f, 0.f, 0.f, 0.f, 0.f, 0.f, 0.f, 0.f, 0.f, 0.f, 0.f, 0.f, 0.f, 0.f};
#pragma unroll
        for (int d0 = 0; d0 < 4; ++d0) { const bf16x8 kf = *(const LAS bf16x8*)(kbase + (2 * d0) * KCH + kt * 512); acc = __builtin_amdgcn_mfma_f32_32x32x16_bf16(kf, qr[d0], acc, 0, 0, 0); }
        P[kt] = acc;
    }
    const float NEG = -INFINITY;
    const int lowlim = first ? (128 - 32 * wid) : 0;
    const int lo0 = r32 > lowlim ? r32 : lowlim;
#pragma unroll
    for (int rr = 0; rr < 16; ++rr) { const int cr = crow(rr, hi); if (cr < lo0) P[0][rr] = NEG; if (cr > r32) P[4][rr] = NEG; }
    if (first) {
#pragma unroll
        for (int kt = 1; kt < 4; ++kt)
#pragma unroll
            for (int rr = 0; rr < 16; ++rr) if (32 * kt + crow(rr, hi) < lowlim) P[kt][rr] = NEG;
    }
    float mx = NEG;
#pragma unroll
    for (int kt = 0; kt < 5; ++kt)
#pragma unroll
        for (int rr = 0; rr < 16; ++rr) mx = fmaxf(mx, P[kt][rr]);
    mx = fmaxf(mx, __shfl_xor(mx, 32));
    float l = 0.f;
#pragma unroll
    for (int kt = 0; kt < 5; ++kt)
#pragma unroll
        for (int rr = 0; rr < 16; ++rr) { const float e = __builtin_amdgcn_exp2f(P[kt][rr] - mx); P[kt][rr] = e; l += e; }
    l += __shfl_xor(l, 32);
    const float inv = __builtin_amdgcn_rcpf(l);
    {
        const int i = qb * 256 + 32 * wid + r32, t = (i << dsh) + r;
        if (hi == 0) lse[((size_t)b * SEQ + t) * 16 + h] = (mx + __log2f(l)) * 0.6931471805599453f;
    }
    f32x16 o[2];
    o[0] = (f32x16){0.f, 0.f, 0.f, 0.f, 0.f, 0.f, 0.f, 0.f, 0.f, 0.f, 0.f, 0.f, 0.f, 0.f, 0.f, 0.f}; o[1] = o[0];
    const LAS unsigned char* vb = shm + LDS_V + ((lane >> 4) & 1) * 32 + (lane & 3) * 8 + (4 * hi + ((lane & 15) >> 2)) * 64;
#pragma unroll
    for (int kt = 0; kt < 5; ++kt)
#pragma unroll
        for (int s = 0; s < 2; ++s) {
            u32x4 pw;
            pw.x = pg8::cvt_pk_bf16(P[kt][8 * s + 0] * inv, P[kt][8 * s + 1] * inv); pw.y = pg8::cvt_pk_bf16(P[kt][8 * s + 2] * inv, P[kt][8 * s + 3] * inv);
            pw.z = pg8::cvt_pk_bf16(P[kt][8 * s + 4] * inv, P[kt][8 * s + 5] * inv); pw.w = pg8::cvt_pk_bf16(P[kt][8 * s + 6] * inv, P[kt][8 * s + 7] * inv);
            const bf16x8 pa = __builtin_bit_cast(bf16x8, pw);
            const int kblk = 2 * wid + 2 * kt + s;
#pragma unroll
            for (int dh = 0; dh < 2; ++dh) {
                const s16x4 vlo = vtr(vb + dh * VDH + kblk * 1024), vhi = vtr(vb + dh * VDH + kblk * 1024 + 512);
                const bf16x8 vf = (bf16x8){vlo[0], vlo[1], vlo[2], vlo[3], vhi[0], vhi[1], vhi[2], vhi[3]};
                o[dh] = __builtin_amdgcn_mfma_f32_32x32x16_bf16(pa, vf, o[dh], 0, 0, 0);
            }
        }
    {
        LAS bf16* stg = (LAS bf16*)(shm + LDS_OST + wid * 4096);
#pragma unroll
        for (int rr = 0; rr < 16; ++rr) { const int orow = crow(rr, hi);
#pragma unroll
            for (int dh = 0; dh < 2; ++dh) stg[orow * 64 + dh * 32 + r32] = (bf16)f2bf(o[dh][rr]); }
        LDS_WAIT(); asm volatile("" ::: "memory");
#pragma unroll
        for (int i4 = 0; i4 < 4; ++i4) { const int row = i4 * 8 + (lane >> 3), ch = lane & 7; const u32x4 v = *(const LAS u32x4*)(stg + row * 64 + ch * 8);
            const int i = qb * 256 + 32 * wid + row, t = (i << dsh) + r;
            *(GAS u32x4*)(O + ((size_t)b * SEQ + t) * D + h * 64 + ch * 8) = v; }
    }
    LDS_WAIT(); __syncthreads();
  }
}
}

__global__ void __launch_bounds__(NWAVES * 64, 2) fwd_megakernel(Args args) {
    extern __shared__ __attribute__((aligned(16))) unsigned char lds[];
    Frame F;
    F.lds = (LAS unsigned char*)lds;
    F.tid = threadIdx.x; F.lane = F.tid & 63; F.wave = __builtin_amdgcn_readfirstlane(F.tid >> 6);
    F.G = gridDim.x; { const int bx = blockIdx.x; F.vcu = (F.G % 8 == 0) ? (bx % 8) * (F.G / 8) + bx / 8 : bx; }
    unsigned char* ws = args.ws;
    const int lo = args.ph_lo, hi = args.ph_hi;
    const bool one_launch = (hi - lo) > 1;
    volatile LAS unsigned* bst = (volatile LAS unsigned*)(F.lds + LDS_BYTES - 64);
    if (F.tid < 2) bst[F.tid] = 0u;
    __syncthreads();
    XcdBarrier bar; bar.bar = (unsigned*)(ws + WS_CTL) + CW_BAR; bar.x = 0; bar.st = bst;
    if (one_launch) bar = xcd_barrier_post((unsigned*)(ws + WS_CTL) + CW_BAR, bst);
#define IN(k) (lo <= (k) && (k) < hi)
#define SEAM(k) do { if (IN(k) && IN((k) + 1)) { xcd_barrier(bar); } } while (0)

    if (lo < 0) cg::this_grid().sync();
    float* resid = args.out;
    float* ssb = (float*)(ws + WS_SS);
    bf16* xb = (bf16*)(ws + WS_XB);
    bf16* zo = (bf16*)(ws + WS_ZO);
    bf16* big = (bf16*)(ws + WS_BIG);

    bool fused_done = false;
    const bool defer_late = one_launch && IN(0) && IN(4) && (F.G == 256);
    const bool pool_epi = (F.G == 256);
    if (IN(0)) { p0_prologue(F, args, defer_late, pool_epi); }
    SEAM(0);
    if (IN(1)) {
        pg8::StaticOrder S; S.init(M, D, F.G, (int)blockIdx.x);
        if (pool_epi) { pg8::Gemm g{big, (const bf16*)(ws + WS_WIN), M, D, D, D, D, 0};
            EpiPool E{F.lds, big, (const bf16*)(ws + WS_WIN), zo, (bf16*)(ws + WS_HALO), (unsigned*)(ws + WS_CTL) + CW_HALO, bar.bar};
            pg8::gemm_phase<EpiPool, pg8::StaticOrder, true, false, true>(F.lds, g, S, E); }
        else { pg8::Gemm g{big, (const bf16*)(ws + WS_WIN), M, D, D, D, D, (size_t)M * D * 2};
            pg8::EpiBf16 E{zo, D};
            pg8::gemm_phase<pg8::EpiBf16, pg8::StaticOrder, true>(F.lds, g, S, E); }
    }
    SEAM(1);
    if (IN(3)) {
        pg8::Gemm g{zo, (const bf16*)(ws + WS_WPO), M, D, D, D, D, 0};
        pg8::StaticOrder S; S.init(M, D, F.G, (int)blockIdx.x);
        pg8::EpiRes<true> E{args.in[0], xb, ssb, nullptr};
        pg8::gemm_phase<pg8::EpiRes<true>, pg8::StaticOrder, true>(F.lds, g, S, E);
    }
    SEAM(3);
#pragma unroll 1
    for (int layer = 0; layer < 2; ++layer) {
        const int pb = layer == 0 ? 4 : 10;
        if (IN(pb)) {
            pg8::Gemm g{xb, (const bf16*)(ws + (layer == 0 ? WS_WGU0 : WS_WGU1)), M, 2 * FF, D, D, D, 0};
            pg8::StaticOrder S; S.init(M, 2 * FF, F.G, (int)blockIdx.x);
            pg8::Unit u0; const pg8::RsTab rt = fill_rstd_tab(F.lds, ssb, S.next(0, u0) ? u0.pm : 0);
            pg8::EpiSwiGLU E{big, ssb, FF, rt};
            pg8::gemm_phase<pg8::EpiSwiGLU, pg8::StaticOrder, true>(F.lds, g, S, E);
            if (layer == 0 && defer_late && (int)blockIdx.x >= 128) late_prep(args, F.lds, (int)blockIdx.x - 128, 128);
        }
        SEAM(pb);
#ifndef FUSE_FINAL
#define FUSE_FINAL 1
#endif
        const bool fuse_final = FUSE_FINAL && (layer == 1) && one_launch && IN(12) && (F.G == (M / 256) * (D / 256));
        if (IN(pb + 1)) {
            pg8::Gemm g{big, (const bf16*)(ws + (layer == 0 ? WS_WD0 : WS_WD1)), M, D, FF, FF, FF, 0};
            pg8::StaticOrder S; S.init(M, D, F.G, (int)blockIdx.x);
            if (fuse_final) { EpiFinal E{xb, resid, ssb, args.in[3], bar}; pg8::gemm_phase<EpiFinal, pg8::StaticOrder, true>(F.lds, g, S, E); }
            else { pg8::EpiRes<false> E{nullptr, xb, ssb, nullptr}; pg8::gemm_phase<pg8::EpiRes<false>, pg8::StaticOrder, true>(F.lds, g, S, E); }
        }
        if (fuse_final) { fused_done = true; break; }
        SEAM(pb + 1);
        if (layer == 0) {
            bf16* qb_ = big; bf16* kb_ = big + (size_t)M * D; bf16* vb_ = big + 2 * (size_t)M * D;
            if (IN(6)) {
                pg8::Gemm g{xb, (const bf16*)(ws + WS_WQKV), M, 3 * D, D, D, D, 0};
                pg8::StaticOrder S; S.init(M, 3 * D, F.G, (int)blockIdx.x);
                pg8::Unit u0; const pg8::RsTab rt = fill_rstd_tab(F.lds, ssb, S.next(0, u0) ? u0.pm : 0);
                pg8::EpiQKV E{qb_, ssb, (const float*)(ws + WS_ROPE), rt};
                pg8::gemm_phase<pg8::EpiQKV, pg8::StaticOrder, true>(F.lds, g, S, E);
            }
            SEAM(6);
            if (IN(7)) {
                const int ipw = (1024 + F.G - 1) / F.G;
                const int it0 = F.vcu * ipw, nit = it0 >= 1024 ? 0 : (1024 - it0 < ipw ? 1024 - it0 : ipw);
                att::attn_phase(it0, nit, qb_, kb_, vb_, zo, (float*)(ws + WS_LSE), F.lds);
            }
            SEAM(7);
            const bool merge_fused = one_launch && IN(8) && IN(9) && (F.G == (M / 256) * (D / 256));
            if (IN(8) && !merge_fused) {
                int tid8 = threadIdx.x; asm volatile("" : "+v"(tid8)); const int lane8 = tid8 & 63, wave8 = __builtin_amdgcn_readfirstlane(tid8 >> 6);
                const float* lse = (const float*)(ws + WS_LSE);
                for (int m = F.vcu * NWAVES + wave8; m < M; m += F.G * NWAVES) {
                    float L[16];
#pragma unroll
                    for (int q4 = 0; q4 < 4; ++q4) { const f32x4 v = *(const GAS f32x4*)(lse + (size_t)m * 16 + 4 * q4); L[4 * q4] = v[0]; L[4 * q4 + 1] = v[1]; L[4 * q4 + 2] = v[2]; L[4 * q4 + 3] = v[3]; }
                    float lg[3];
                    { float mx = L[0];
_Pragma("unroll") for (int i = 1; i < 6; ++i) mx = fmaxf(mx, L[i]); float s = 0.f;
_Pragma("unroll") for (int i = 0; i < 6; ++i) s += __expf(L[i] - mx); lg[0] = mx + __logf(s) - 1.791759469228055f; }
                    { float mx = L[6];
_Pragma("unroll") for (int i = 7; i < 11; ++i) mx = fmaxf(mx, L[i]); float s = 0.f;
_Pragma("unroll") for (int i = 6; i < 11; ++i) s += __expf(L[i] - mx); lg[1] = mx + __logf(s) - 1.6094379124341003f; }
                    { float mx = L[11];
_Pragma("unroll") for (int i = 12; i < 16; ++i) mx = fmaxf(mx, L[i]); float s = 0.f;
_Pragma("unroll") for (int i = 11; i < 16; ++i) s += __expf(L[i] - mx); lg[2] = mx + __logf(s) - 1.6094379124341003f; }
                    const float mx = fmaxf(lg[0], fmaxf(lg[1], lg[2]));
                    const float e0 = __expf(lg[0] - mx), e1 = __expf(lg[1] - mx), e2 = __expf(lg[2] - mx); const float is = 3.0f / (e0 + e1 + e2);
                    const int head = lane8 >> 2; const float sc = (head < 6 ? e0 : (head < 11 ? e1 : e2)) * is;
                    GAS v4u* p = (GAS v4u*)(zo + (size_t)m * D + 16 * lane8);
#pragma unroll
                    for (int q2 = 0; q2 < 2; ++q2) { v4u w = p[q2];
                        w.x = pk2(bflo(w.x) * sc, bfhi(w.x) * sc); w.y = pk2(bflo(w.y) * sc, bfhi(w.y) * sc); w.z = pk2(bflo(w.z) * sc, bfhi(w.z) * sc); w.w = pk2(bflo(w.w) * sc, bfhi(w.w) * sc);
                        p[q2] = w; }
                }
            }
            if (!merge_fused) SEAM(8);
            if (IN(9)) {
                pg8::Gemm g{zo, (const bf16*)(ws + WS_WAO), M, D, D, D, D, 0};
                pg8::StaticOrder S; S.init(M, D, F.G, (int)blockIdx.x);
                if (merge_fused) { pg8::Unit u0; const LAS float* st = seg_fill(F.lds, (const float*)(ws + WS_LSE), S.next(0, u0) ? u0.pm : 0);
                    pg8::EpiRes<false, true> E{nullptr, xb, ssb, st + 512};
                    pg8::gemm_phase<pg8::EpiRes<false, true>, pg8::StaticOrder, true, true>(F.lds, g, S, E, st); }
                else { pg8::EpiRes<false> E{nullptr, xb, ssb, nullptr};
                    pg8::gemm_phase<pg8::EpiRes<false>, pg8::StaticOrder, true>(F.lds, g, S, E); }
            }
            SEAM(9);
        }
    }
    if (IN(12) && !fused_done) {
        const float* gf = args.in[3];
        int tid12 = threadIdx.x; asm volatile("" : "+v"(tid12)); const int lane12 = tid12 & 63, wave12 = __builtin_amdgcn_readfirstlane(tid12 >> 6);
        for (int m = F.vcu * NWAVES + wave12; m < M; m += F.G * NWAVES) {
            float s = 0.f;
#pragma unroll
            for (int q4 = 0; q4 < 4; ++q4) { const f32x4 v = *(const GAS f32x4*)(ssb + (size_t)m * 16 + 4 * q4); s += (v[0] + v[1]) + (v[2] + v[3]); }
            const float rstd = rsqrtf(s * (1.0f / D) + 1e-6f);
            const GAS v4u* xr = (const GAS v4u*)(xb + (size_t)m * D + 16 * lane12);
            GAS f32x4* orow = (GAS f32x4*)(resid + (size_t)m * D + 16 * lane12);
#pragma unroll
            for (int q2 = 0; q2 < 2; ++q2) { const v4u w = xr[q2]; const GAS f32x4* gq = (const GAS f32x4*)(gf + 16 * lane12 + 8 * q2);
                orow[2 * q2] = (f32x4){bflo(w.x), bfhi(w.x), bflo(w.y), bfhi(w.y)} * rstd * gq[0];
                orow[2 * q2 + 1] = (f32x4){bflo(w.z), bfhi(w.z), bflo(w.w), bfhi(w.w)} * rstd * gq[1]; }
        }
    }
#undef IN
#undef SEAM
}

extern "C" void kernel_launch(void* const* d_in, const int* in_sizes, int n_in, void* d_out, int out_size, void* d_ws, size_t ws_size, hipStream_t stream) {
    static int grid = 0;
    if (grid == 0) {
        if (n_in != 13 || in_sizes[0] != M * D || out_size != M * D || ws_size < WS_END) { fprintf(stderr, "kernel_launch: unexpected shapes (n_in %d, in0 %d, out %d, ws %zu); nothing launched\n", n_in, n_in > 0 ? in_sizes[0] : -1, out_size, ws_size); grid = -1; return; }
        int dev = 0, cus = 0, per_cu = 0;
        if (hipGetDevice(&dev) != hipSuccess || hipDeviceGetAttribute(&cus, hipDeviceAttributeMultiprocessorCount, dev) != hipSuccess) { grid = -1; return; }
        if (hipFuncSetAttribute((const void*)fwd_megakernel, hipFuncAttributeMaxDynamicSharedMemorySize, LDS_BYTES) != hipSuccess) { fprintf(stderr, "kernel_launch: hipFuncSetAttribute failed\n"); grid = -1; return; }
        if (hipOccupancyMaxActiveBlocksPerMultiprocessor(&per_cu, (const void*)fwd_megakernel, NWAVES * 64, LDS_BYTES) != hipSuccess || per_cu < 1) { fprintf(stderr, "kernel_launch: occupancy query says %d blocks per CU\n", per_cu); per_cu = 1; }
        (void)hipGetLastError();
        grid = cus;
    }
    if (grid < 0) return;
    if (hipMemsetAsync((char*)d_ws + WS_CTL, 0, CTL_ZERO_BYTES, stream) != hipSuccess) { fprintf(stderr, "kernel_launch: memset failed\n"); return; }
    Args a{};
    for (int i = 0; i < 13; ++i) a.in[i] = (const float*)d_in[i];
    a.out = (float*)d_out; a.ws = (unsigned char*)d_ws;
#if MK_N_LAUNCHES == 1
    a.ph_lo = 0; a.ph_hi = 13;
    void* kargs[] = {&a};
    hipError_t e = hipLaunchCooperativeKernel((const void*)fwd_megakernel, dim3(grid), dim3(NWAVES * 64), kargs, LDS_BYTES, stream);
    if (e != hipSuccess) fprintf(stderr, "kernel_launch: cooperative launch failed: %s (grid %d)\n", hipGetErrorString(e), grid);
#else
    for (int p = 0; p < 13; ++p) { a.ph_lo = p; a.ph_hi = p + 1; hipLaunchKernelGGL(fwd_megakernel, dim3(grid), dim3(NWAVES * 64), LDS_BYTES, stream, a); }
#endif
}
```

```cpp
#include <hip/hip_runtime.h>
#include <hip/hip_cooperative_groups.h>
#include <cstdio>
#include <cstdint>
namespace cg = cooperative_groups;

#ifndef MK_N_LAUNCHES
#define MK_N_LAUNCHES 1
#endif

namespace pg8 {
#define PG8_LAS __attribute__((address_space(3)))
typedef unsigned short bf16_t;
typedef short bf16x8 __attribute__((ext_vector_type(8)));
typedef float f32x4 __attribute__((ext_vector_type(4)));
typedef unsigned u32x4 __attribute__((ext_vector_type(4)));
constexpr int BM = 256, BK = 64, HALF = 128, HTB = HALF * BK * 2, STAGE_BYTES = 8 * HTB, NXCD = 8, WGM = 8;

__host__ __device__ __forceinline__ int lds_byte(int r, int c) { const int st = (r >> 4) * 2 + (c >> 5), rr = r & 15, cc = c & 31, ob = rr * 64 + cc * 2; return st * 1024 + (ob ^ (((ob >> 9) & 1) << 5)); }
__host__ __device__ __forceinline__ void stage_rc(int b, int& R, int& C) { const int st = b / 1024, sb = b % 1024, swz = sb ^ (((sb >> 9) & 1) << 5); R = (st >> 1) * 16 + swz / 64; C = (st & 1) * 32 + (swz % 64) / 2; }
__host__ __device__ __forceinline__ int perm32(int rho) { const int n = rho >> 4, i = rho & 15; return 8 * (i >> 2) + 4 * n + (i & 3); }

struct Unit { int pm, pn; };
struct Gemm { const bf16_t* A; const bf16_t* Bt; int M, N, K, lda, ldb; size_t a_pn_bytes; };

struct StaticOrder {
    int nM, nN, nwg, G, c;
    __host__ __device__ void init(int M, int N, int G_, int c_) { nM = M / BM; nN = N / BM; nwg = nM * nN; G = G_; c = c_; }
    __host__ __device__ bool next(int i, Unit& u) const {
        const long L = (long)i * G + c; if (L >= nwg) return false;
        int wgid = (int)L; { const int q = nwg / NXCD, r = nwg % NXCD, xcd = wgid % NXCD, off = wgid / NXCD; wgid = (xcd < r ? xcd * (q + 1) : r * (q + 1) + (xcd - r) * q) + off; }
        const int nig = WGM * nN, gid = wgid / nig, fm = gid * WGM, gsz = (nM - fm) < WGM ? (nM - fm) : WGM;
        u.pm = fm + ((wgid % nig) % gsz); u.pn = (wgid % nig) / gsz; return true;
    }
};

__device__ __forceinline__ unsigned cvt_pk_bf16(float lo, float hi) { unsigned r; asm volatile("v_cvt_pk_bf16_f32 %0, %1, %2" : "=v"(r) : "v"(lo), "v"(hi)); return r; }

constexpr float RMS_EPS = 1e-6f;

struct EpiBf16 {
    bf16_t* O; int ldc;
    __device__ __forceinline__ void operator()(const f32x4 (&acc)[2][2][4][2], const Unit& u, int wr, int wc, int fr, int fq) const {
        const int row0 = u.pm * BM + wr * 64 + fr, col0 = u.pn * BM + wc * 32 + 8 * fq;
#pragma unroll
        for (int ai = 0; ai < 2; ++ai)
#pragma unroll
            for (int m = 0; m < 4; ++m) { bf16_t* rowp = O + (size_t)(row0 + ai * HALF + m * 16) * ldc + col0;
#pragma unroll
                for (int bj = 0; bj < 2; ++bj) { const f32x4 v0 = acc[ai][bj][m][0], v1 = acc[ai][bj][m][1];
                    u32x4 w; w.x = cvt_pk_bf16(v0[0], v0[1]); w.y = cvt_pk_bf16(v0[2], v0[3]); w.z = cvt_pk_bf16(v1[0], v1[1]); w.w = cvt_pk_bf16(v1[2], v1[3]);
                    *(u32x4*)(rowp + bj * HALF) = w; } }
    }
};
__device__ __forceinline__ float bf_lo(unsigned w) { return __builtin_bit_cast(float, w << 16); }
__device__ __forceinline__ float bf_hi(unsigned w) { return __builtin_bit_cast(float, w & 0xffff0000u); }
template <bool BASE_F32, bool SCALE = false> struct EpiRes {
    const float* basef; bf16_t* xb; float* ss; const PG8_LAS float* ctab;
    __device__ __forceinline__ void load_base(int row, int col0, f32x4 (&nb)[4]) const {
        if (BASE_F32) { const float* bp = basef + (size_t)row * 1024 + col0; nb[0] = *(const f32x4*)(bp); nb[1] = *(const f32x4*)(bp + 4); nb[2] = *(const f32x4*)(bp + HALF); nb[3] = *(const f32x4*)(bp + HALF + 4); }
        else { const bf16_t* bp = xb + (size_t)row * 1024 + col0; const u32x4 a = *(const u32x4*)(bp), c = *(const u32x4*)(bp + HALF);
            nb[0] = (f32x4){bf_lo(a.x), bf_hi(a.x), bf_lo(a.y), bf_hi(a.y)}; nb[1] = (f32x4){bf_lo(a.z), bf_hi(a.z), bf_lo(a.w), bf_hi(a.w)};
            nb[2] = (f32x4){bf_lo(c.x), bf_hi(c.x), bf_lo(c.y), bf_hi(c.y)}; nb[3] = (f32x4){bf_lo(c.z), bf_hi(c.z), bf_lo(c.w), bf_hi(c.w)}; }
    }
    __device__ __forceinline__ void operator()(const f32x4 (&acc)[2][2][4][2], const Unit& u, int wr, int wc, int fr, int fq) const {
        const int row0 = u.pm * BM + wr * 64 + fr, col0 = u.pn * BM + wc * 32 + 8 * fq;
        f32x4 nb[4];
        load_base(row0, col0, nb);
#pragma unroll
        for (int it = 0; it < 8; ++it) { const int ai = it >> 2, m = it & 3;
            const size_t row = (size_t)(row0 + ai * HALF + m * 16); const size_t off = row * 1024 + col0; float s = 0.f;
            const f32x4 b0 = nb[0], b1 = nb[1], b2 = nb[2], b3 = nb[3];
            if (it < 7) load_base(row0 + ((it + 1) >> 2) * HALF + ((it + 1) & 3) * 16, col0, nb);
            const float cs = SCALE ? ctab[wr * 64 + fr + ai * HALF + m * 16] : 1.0f;
#pragma unroll
            for (int bj = 0; bj < 2; ++bj) {
                const f32x4 v0 = acc[ai][bj][m][0] * cs + (bj == 0 ? b0 : b2), v1 = acc[ai][bj][m][1] * cs + (bj == 0 ? b1 : b3);
                s += (v0[0] * v0[0] + v0[1] * v0[1]) + (v0[2] * v0[2] + v0[3] * v0[3]) + (v1[0] * v1[0] + v1[1] * v1[1]) + (v1[2] * v1[2] + v1[3] * v1[3]);
                u32x4 w; w.x = cvt_pk_bf16(v0[0], v0[1]); w.y = cvt_pk_bf16(v0[2], v0[3]); w.z = cvt_pk_bf16(v1[0], v1[1]); w.w = cvt_pk_bf16(v1[2], v1[3]);
                *(u32x4*)(xb + off + bj * HALF) = w; }
            s += __shfl_xor(s, 16); s += __shfl_xor(s, 32);
            if (fq == 0) ss[row * 16 + u.pn * 4 + wc] = s; }
    }
};
struct RsTab { const PG8_LAS float* tab; int pm; };
__device__ __forceinline__ float row_rstd(const float* ss, size_t row, int fq) {
    const f32x4 p = *(const f32x4*)(ss + row * 16 + 4 * fq); float s = (p[0] + p[1]) + (p[2] + p[3]);
    s += __shfl_xor(s, 16); s += __shfl_xor(s, 32);
    return rsqrtf(s * (1.0f / 1024.0f) + RMS_EPS);
}
struct EpiSwiGLU {
    bf16_t* act; const float* ss; int ldc; RsTab rt;
    __device__ __forceinline__ void operator()(const f32x4 (&acc)[2][2][4][2], const Unit& u, int wr, int wc, int fr, int fq) const {
        const int row0 = u.pm * BM + wr * 64 + fr, col0 = u.pn * HALF + wc * 32 + 8 * fq;
        const bool use_tab = (u.pm == rt.pm);
#pragma unroll
        for (int ai = 0; ai < 2; ++ai)
#pragma unroll
            for (int m = 0; m < 4; ++m) { const size_t row = (size_t)(row0 + ai * HALF + m * 16); float rstd; if (__builtin_expect(use_tab, 1)) rstd = rt.tab[wr * 64 + fr + ai * HALF + m * 16]; else { asm volatile("; rstd from global (grid != 256)" ::: "memory"); rstd = row_rstd(ss, row, fq); }
                float a[8];
#pragma unroll
                for (int n = 0; n < 2; ++n)
#pragma unroll
                    for (int i = 0; i < 4; ++i) { const float g = acc[ai][0][m][n][i] * rstd, up = acc[ai][1][m][n][i] * rstd;
                        a[n * 4 + i] = g * up * __builtin_amdgcn_rcpf(1.0f + __builtin_amdgcn_exp2f(-1.4426950408889634f * g)); }
                u32x4 w; w.x = cvt_pk_bf16(a[0], a[1]); w.y = cvt_pk_bf16(a[2], a[3]); w.z = cvt_pk_bf16(a[4], a[5]); w.w = cvt_pk_bf16(a[6], a[7]);
                *(u32x4*)(act + row * ldc + col0) = w; }
    }
};
struct EpiQKV {
    bf16_t* qkv; const float* ss; const float* rope; RsTab rt;
    __device__ __forceinline__ void operator()(const f32x4 (&acc)[2][2][4][2], const Unit& u, int wr, int wc, int fr, int fq) const {
        const int row0 = u.pm * BM + wr * 64 + fr; const int sect = u.pn >> 2, head = (u.pn & 3) * 4 + wc;
        const int dsh = head < 6 ? 0 : (head < 11 ? 2 : 4);
        bf16_t* dst = qkv + (size_t)sect * ((size_t)16384 * 1024);
        const float qs = sect == 0 ? 0.125f * 1.4426950408889634f : 1.0f;
        const bool use_tab = (u.pm == rt.pm);
        const bool rot = sect < 2;
        f32x4 nr[4];
        if (rot) { const float* rp = rope + (size_t)(row0 & 8191) * 64 + 8 * fq; nr[0] = *(const f32x4*)(rp); nr[1] = *(const f32x4*)(rp + 4); nr[2] = *(const f32x4*)(rp + 32); nr[3] = *(const f32x4*)(rp + 36); }
#pragma unroll
        for (int it = 0; it < 8; ++it) { const int ai = it >> 2, m = it & 3;
            const int row = row0 + ai * HALF + m * 16; float rstd; if (__builtin_expect(use_tab, 1)) rstd = rt.tab[wr * 64 + fr + ai * HALF + m * 16]; else { asm volatile("; rstd from global (grid != 256)" ::: "memory"); rstd = row_rstd(ss, (size_t)row, fq); } rstd *= qs;
            const int b = row >> 13, t = row & 8191; const int pos = ((t & ((1 << dsh) - 1)) << (13 - dsh)) + (t >> dsh);
            bf16_t* o = dst + ((size_t)(b * 16 + head) * 8192 + pos) * 64 + 8 * fq;
            const f32x4 c0 = nr[0], c1 = nr[1], s0 = nr[2], s1 = nr[3];
            if (rot && it < 7) { const int row2 = row0 + ((it + 1) >> 2) * HALF + ((it + 1) & 3) * 16; const float* rp = rope + (size_t)(row2 & 8191) * 64 + 8 * fq;
                nr[0] = *(const f32x4*)(rp); nr[1] = *(const f32x4*)(rp + 4); nr[2] = *(const f32x4*)(rp + 32); nr[3] = *(const f32x4*)(rp + 36); }
            float lo[8], hi[8];
#pragma unroll
            for (int n = 0; n < 2; ++n)
#pragma unroll
                for (int i = 0; i < 4; ++i) { lo[n * 4 + i] = acc[ai][0][m][n][i] * rstd; hi[n * 4 + i] = acc[ai][1][m][n][i] * rstd; }
            if (rot) {
#pragma unroll
                for (int i = 0; i < 8; ++i) { const float cs = i < 4 ? c0[i & 3] : c1[i & 3], sn = i < 4 ? s0[i & 3] : s1[i & 3];
                    const float l = lo[i], h = hi[i]; lo[i] = l * cs - h * sn; hi[i] = h * cs + l * sn; }
            }
            u32x4 w; w.x = cvt_pk_bf16(lo[0], lo[1]); w.y = cvt_pk_bf16(lo[2], lo[3]); w.z = cvt_pk_bf16(lo[4], lo[5]); w.w = cvt_pk_bf16(lo[6], lo[7]);
            *(u32x4*)(o) = w;
            w.x = cvt_pk_bf16(hi[0], hi[1]); w.y = cvt_pk_bf16(hi[2], hi[3]); w.z = cvt_pk_bf16(hi[4], hi[5]); w.w = cvt_pk_bf16(hi[6], hi[7]);
            *(u32x4*)(o + 32) = w; }
    }
};

template <class Epi, class Sched, bool ALIGN_EPI, bool SEG = false, bool AFTER_DRAIN = false>
__device__ __forceinline__ void gemm_phase(PG8_LAS unsigned char* lds, const Gemm g, const Sched& S, const Epi& E, const PG8_LAS float* segtab = nullptr) {
    int tid = threadIdx.x; asm volatile("" : "+v"(tid));
    const int wid = __builtin_amdgcn_readfirstlane(tid >> 6), lane = tid & 63, wr = wid >> 2, wc = wid & 3, fr = lane & 15, fq = lane >> 4;
    const int K = g.K, nt = K / BK;
    unsigned voffA[2], voffB[2];
#pragma unroll
    for (int i = 0; i < 2; ++i) { int R, C; stage_rc(tid * 16 + i * 8192, R, C); const int Rb = (R & ~31) + perm32(R & 31);
        voffA[i] = (unsigned)(R * g.lda + C) * 2u; voffB[i] = (unsigned)(Rb * g.ldb + C) * 2u; }
    const size_t kstep = (size_t)(BK * 2);
    const size_t hstepA = (size_t)HALF * g.lda * 2, hstepB = (size_t)HALF * g.ldb * 2;
    const size_t tstepA = 2 * hstepA, tstepB = 2 * hstepB;
    const unsigned ldsw = (unsigned)wid * 1024u;
    const int aoff = lds_byte(wr * 64 + fr, fq * 8), boff = lds_byte(wc * 32 + fr, fq * 8);
#define PG8_SA(b, h) (((b) * 2 + (h)) * HTB)
#define PG8_SB(b, h) ((4 + (b) * 2 + (h)) * HTB)
#define PG8_STAGE(bufoff, gbase, voff) do { _Pragma("unroll") for (int _i = 0; _i < 2; ++_i) \
        __builtin_amdgcn_global_load_lds((const unsigned*)((const char*)(gbase) + (voff)[_i]), (PG8_LAS unsigned*)(lds + (bufoff) + ldsw + _i * 8192), 16, 0, 0); } while (0)
#define PG8_LDA(dst, b, h) do { _Pragma("unroll") for (int m = 0; m < 4; ++m) _Pragma("unroll") for (int k = 0; k < 2; ++k) dst[m][k] = *(const PG8_LAS bf16x8*)(lds + PG8_SA(b, h) + aoff + m * 2048 + k * 1024); } while (0)
#define PG8_LDB(dst, b, h) do { _Pragma("unroll") for (int n = 0; n < 2; ++n) _Pragma("unroll") for (int k = 0; k < 2; ++k) dst[n][k] = *(const PG8_LAS bf16x8*)(lds + PG8_SB(b, h) + boff + n * 2048 + k * 1024); } while (0)
#define PG8_MMA(ai, bj, At, Bt) do { __builtin_amdgcn_s_setprio(1); _Pragma("unroll") for (int m = 0; m < 4; ++m) _Pragma("unroll") for (int n = 0; n < 2; ++n) _Pragma("unroll") for (int k = 0; k < 2; ++k) \
        acc[ai][bj][m][n] = __builtin_amdgcn_mfma_f32_16x16x32_bf16(Bt[n][k], At[m][k], acc[ai][bj][m][n], 0, 0, 0); __builtin_amdgcn_s_setprio(0); } while (0)
#define PG8_SEGSCALE(tb) do { _Pragma("unroll") for (int ai = 0; ai < 2; ++ai) _Pragma("unroll") for (int m = 0; m < 4; ++m) { const float f_ = (tb)[wr * 64 + fr + ai * HALF + m * 16]; \
        _Pragma("unroll") for (int bj = 0; bj < 2; ++bj) _Pragma("unroll") for (int n = 0; n < 2; ++n) acc[ai][bj][m][n] = acc[ai][bj][m][n] * f_; } } while (0)
#define PG8_WAIT_V(n) asm volatile("s_waitcnt vmcnt(" #n ")" ::: "memory")
#define PG8_WAIT_L(n) asm volatile("s_waitcnt lgkmcnt(" #n ")" ::: "memory")
#define PG8_BAR __builtin_amdgcn_s_barrier()
#define PG8_SCHED __builtin_amdgcn_sched_barrier(0)
    Unit cur, nxt; int ui = 0;
    if (!S.next(0, cur)) return;
    f32x4 acc[2][2][4][2];
#pragma unroll
    for (int a = 0; a < 2; ++a)
#pragma unroll
        for (int b = 0; b < 2; ++b)
#pragma unroll
            for (int m = 0; m < 4; ++m)
#pragma unroll
                for (int n = 0; n < 2; ++n) acc[a][b][m][n] = (f32x4){0.f, 0.f, 0.f, 0.f};
    bf16x8 At[4][2], B0[2][2], B1[2][2];
    const char* cA = (const char*)g.A + (size_t)cur.pm * tstepA + (size_t)cur.pn * g.a_pn_bytes; const char* cB = (const char*)g.Bt + (size_t)cur.pn * tstepB;
    PG8_STAGE(PG8_SB(0, 0), cB, voffB); PG8_STAGE(PG8_SB(0, 1), cB + hstepB, voffB); PG8_STAGE(PG8_SA(0, 0), cA, voffA); PG8_STAGE(PG8_SA(0, 1), cA + hstepA, voffA);
    if (wr == 1) PG8_BAR;
    PG8_WAIT_V(2); PG8_BAR;
    PG8_STAGE(PG8_SB(1, 0), cB + kstep, voffB); PG8_STAGE(PG8_SA(1, 0), cA + kstep, voffA); PG8_STAGE(PG8_SB(1, 1), cB + hstepB + kstep, voffB);
    PG8_WAIT_V(6); PG8_BAR;
    for (;;) {
        const bool has_next = S.next(ui + 1, nxt);
        const char* nA = has_next ? (const char*)g.A + (size_t)nxt.pm * tstepA + (size_t)nxt.pn * g.a_pn_bytes : cA; const char* nB = has_next ? (const char*)g.Bt + (size_t)nxt.pn * tstepB : cB;
        for (int t = 0; t < nt; t += 2) {
            const bool last = (t == nt - 2);
            const char* a1 = cA + (size_t)(t + 1) * kstep;
            const char* a2 = last ? nA : cA + (size_t)(t + 2) * kstep; const char* b2 = last ? nB : cB + (size_t)(t + 2) * kstep;
            const char* a3 = a2 + kstep; const char* b3 = b2 + kstep;
            if constexpr (SEG) { if (t == 6) PG8_SEGSCALE(segtab); }
            PG8_LDB(B0, 0, 0); PG8_LDB(B1, 0, 1); PG8_SCHED; PG8_LDA(At, 0, 0); PG8_STAGE(PG8_SA(1, 1), a1 + hstepA, voffA);
            PG8_WAIT_V(8); PG8_WAIT_L(0); PG8_BAR; PG8_MMA(0, 0, At, B0); PG8_MMA(0, 1, At, B1); PG8_BAR; PG8_SCHED;
            PG8_LDA(At, 0, 1); PG8_STAGE(PG8_SB(0, 0), b2, voffB); PG8_STAGE(PG8_SB(0, 1), b2 + hstepB, voffB); PG8_STAGE(PG8_SA(0, 0), a2, voffA);
            PG8_WAIT_V(8); PG8_WAIT_L(0); PG8_BAR; PG8_MMA(1, 0, At, B0); PG8_MMA(1, 1, At, B1); PG8_BAR; PG8_SCHED;
            if constexpr (SEG) { if (t == 10) PG8_SEGSCALE(segtab + 256); }
            PG8_LDB(B0, 1, 0); PG8_LDB(B1, 1, 1); PG8_SCHED; PG8_LDA(At, 1, 0); PG8_STAGE(PG8_SA(0, 1), a2 + hstepA, voffA);
            PG8_WAIT_V(8); PG8_WAIT_L(0); PG8_BAR; PG8_MMA(0, 0, At, B0); PG8_MMA(0, 1, At, B1); PG8_BAR; PG8_SCHED;
            PG8_LDA(At, 1, 1); PG8_STAGE(PG8_SB(1, 0), b3, voffB); PG8_STAGE(PG8_SB(1, 1), b3 + hstepB, voffB); PG8_STAGE(PG8_SA(1, 0), a3, voffA);
            PG8_WAIT_V(8); PG8_WAIT_L(0); PG8_BAR; PG8_MMA(1, 0, At, B0); PG8_MMA(1, 1, At, B1); PG8_BAR; PG8_SCHED;
        }
        if constexpr (ALIGN_EPI) { if (wr == 0) PG8_BAR; }
        if constexpr (!AFTER_DRAIN) E(acc, cur, wr, wc, fr, fq);
        if (!has_next) break;
#pragma unroll
        for (int a = 0; a < 2; ++a)
#pragma unroll
            for (int b = 0; b < 2; ++b)
#pragma unroll
                for (int m = 0; m < 4; ++m)
#pragma unroll
                    for (int n = 0; n < 2; ++n) acc[a][b][m][n] = (f32x4){0.f, 0.f, 0.f, 0.f};
        cur = nxt; cA = nA; cB = nB; ++ui;
        if constexpr (ALIGN_EPI) { if (wr == 1) PG8_BAR; }
    }
    PG8_WAIT_V(0);
    if constexpr (!ALIGN_EPI) { if (wr == 0) PG8_BAR; }
    PG8_BAR;
    if constexpr (AFTER_DRAIN) E(acc, cur, wr, wc, fr, fq);
#undef PG8_SA
#undef PG8_SB
#undef PG8_STAGE
#undef PG8_LDA
#undef PG8_LDB
#undef PG8_MMA
#undef PG8_WAIT_V
#undef PG8_SEGSCALE
#undef PG8_WAIT_L
#undef PG8_BAR
#undef PG8_SCHED
}
}

constexpr int NWAVES = 8;
constexpr int BATCH = 2, SEQ = 8192, D = 1024, H = 16, HD = 64, FF = 2816;
constexpr int M = BATCH * SEQ;
constexpr size_t MiB = 1u << 20;
constexpr size_t WS_CTL = 0, CTL_ZERO_BYTES = 128 * 1024;
constexpr int CW_HALO = 8192;
constexpr size_t WS_ROPE = 1 * MiB;
constexpr size_t WS_SS = 3 * MiB;
constexpr size_t WS_LSE = 4 * MiB;
constexpr size_t WS_WIN = 6 * MiB;
constexpr size_t WS_WG = 8 * MiB;
constexpr size_t WS_WPO = 9 * MiB;
constexpr size_t WS_WGU0 = 11 * MiB;
constexpr size_t WS_WD0 = 22 * MiB;
constexpr size_t WS_WQKV = 28 * MiB;
constexpr size_t WS_WAO = 34 * MiB;
constexpr size_t WS_WGU1 = 36 * MiB;
constexpr size_t WS_WD1 = 47 * MiB;
constexpr size_t WS_BIG = 56 * MiB;
constexpr size_t WS_XB = 184 * MiB;
constexpr size_t WS_ZO = 216 * MiB;
constexpr size_t WS_HALO = 248 * MiB;
constexpr size_t WS_END = 250 * MiB;
constexpr int CW_BAR = 1024;

constexpr int LDS_BYTES = 147456;

#define GAS __attribute__((address_space(1)))
#define LAS __attribute__((address_space(3)))
typedef unsigned short bf16;
typedef unsigned v4u __attribute__((ext_vector_type(4)));
typedef unsigned v2u __attribute__((ext_vector_type(2)));
typedef float f32x4 __attribute__((ext_vector_type(4)));
#define LDS_WAIT() asm volatile("s_waitcnt lgkmcnt(0)" ::: "memory")
__device__ __forceinline__ unsigned f2bf(float f) { unsigned u = __builtin_bit_cast(unsigned, f); return (u + 0x7fffu + ((u >> 16) & 1u)) >> 16; }
__device__ __forceinline__ unsigned pk2(float lo, float hi) { return f2bf(lo) | (f2bf(hi) << 16); }
__device__ __forceinline__ float bflo(unsigned w) { return __builtin_bit_cast(float, w << 16); }
__device__ __forceinline__ float bfhi(unsigned w) { return __builtin_bit_cast(float, w & 0xffff0000u); }

#define XB_TMO      128
#define XB_XCNT(j)  (256  + 64 * (j))
#define XB_XSUB(j)  (1280 + 64 * (j))
#define XB_XGEN(j)  (2304 + 64 * (j))
#define XB_TOP      3328
#define XB_TOPGEN   3392
#define XCD_BAR_WORDS 3456
#define XB_SPIN_CAP (1u << 22)
__device__ __forceinline__ unsigned xb_ld(unsigned* p)              { return __hip_atomic_load(p, __ATOMIC_RELAXED, __HIP_MEMORY_SCOPE_AGENT); }
__device__ __forceinline__ unsigned xb_add(unsigned* p, unsigned v) { return __hip_atomic_fetch_add(p, v, __ATOMIC_RELAXED, __HIP_MEMORY_SCOPE_AGENT); }
__device__ __forceinline__ unsigned xb_xcc_id() { return (unsigned)__builtin_amdgcn_s_getreg((3 << 11) | 20) & 0xFu; }
#define XB_SPIN(cond, bar) do { unsigned _sp = 0; while (cond) { __builtin_amdgcn_s_sleep(1); \
    if ((++_sp & 255u) == 0u) { if (xb_ld(&(bar)[XB_TMO])) break; if (_sp > XB_SPIN_CAP) { atomicAdd(&(bar)[XB_TMO], 1u); break; } } } } while (0)
struct XcdBarrier { unsigned* bar; unsigned x; volatile LAS unsigned* st; };
__device__ __forceinline__ XcdBarrier xcd_barrier_post(unsigned* bar, volatile LAS unsigned* st) {
    XcdBarrier b; b.bar = bar; b.x = xb_xcc_id(); b.st = st;
    if (threadIdx.x == 0) (void)xb_add(&bar[XB_XCNT(b.x)], 1u);
    return b;
}
__device__ __forceinline__ void xcd_barrier_complete(unsigned* bar, unsigned x, unsigned& nloc, unsigned& nx) {
    const unsigned G = gridDim.x * gridDim.y * gridDim.z;
    unsigned sum, cnt, mine, sp = 0u;
    for (;;) {
        sum = 0u; cnt = 0u; mine = 0u;
#pragma unroll
        for (unsigned j = 0; j < 16; ++j) { const unsigned c = xb_ld(&bar[XB_XCNT(j)]); sum += c; cnt += (c > 0u) ? 1u : 0u; mine = (j == x) ? c : mine; }
        if (sum == G) break;
        __builtin_amdgcn_s_sleep(1);
        if ((++sp & 255u) == 0u) { if (xb_ld(&bar[XB_TMO])) break; if (sp > XB_SPIN_CAP) { atomicAdd(&bar[XB_TMO], 1u); break; } }
    }
    nloc = mine > 0u ? mine : 1u; nx = cnt > 0u ? cnt : 1u;
}
__device__ __forceinline__ void xcd_barrier(const XcdBarrier& b) {
    asm volatile("s_waitcnt vmcnt(0)" ::: "memory");
    __syncthreads();
    if (threadIdx.x == 0) {
        unsigned* bar = b.bar;
        __builtin_amdgcn_s_waitcnt(0);
        unsigned nloc = b.st[0], nx = b.st[1];
        if (nloc == 0u) { xcd_barrier_complete(bar, b.x, nloc, nx); b.st[0] = nloc; b.st[1] = nx; }
        const unsigned old = xb_add(&bar[XB_XSUB(b.x)], 1u);
        const unsigned gen = old / nloc;
        if (old + 1u == (gen + 1u) * nloc) {
            __builtin_amdgcn_fence(__ATOMIC_RELEASE, "agent");
            asm volatile("s_waitcnt vmcnt(0)" ::: "memory");
            const unsigned og = xb_add(&bar[XB_TOP], 1u);
            const unsigned tg = og / nx;
            if (og + 1u == (tg + 1u) * nx) xb_add(&bar[XB_TOPGEN], 1u);
            else XB_SPIN(xb_ld(&bar[XB_TOPGEN]) == tg, bar);
            __builtin_amdgcn_fence(__ATOMIC_ACQUIRE, "agent");
            xb_add(&bar[XB_XGEN(b.x)], 1u);
            asm volatile("s_waitcnt vmcnt(0)" ::: "memory");
        } else {
            XB_SPIN(xb_ld(&bar[XB_XGEN(b.x)]) == gen, bar);
            __builtin_amdgcn_fence(__ATOMIC_ACQUIRE, "agent");
            asm volatile("s_waitcnt vmcnt(0)" ::: "memory");
        }
    }
    __syncthreads();
}

struct EpiFinal {
    const bf16* xb; float* out; float* ss; const float* gf; XcdBarrier bar;
    __device__ __forceinline__ void load_base(int row, int col0, pg8::f32x4 (&nb)[4]) const {
        using pg8::f32x4; using pg8::u32x4; using pg8::bf_lo; using pg8::bf_hi;
        const bf16* bp = xb + (size_t)row * 1024 + col0; const u32x4 a = *(const u32x4*)(bp), c = *(const u32x4*)(bp + pg8::HALF);
        nb[0] = (f32x4){bf_lo(a.x), bf_hi(a.x), bf_lo(a.y), bf_hi(a.y)}; nb[1] = (f32x4){bf_lo(a.z), bf_hi(a.z), bf_lo(a.w), bf_hi(a.w)};
        nb[2] = (f32x4){bf_lo(c.x), bf_hi(c.x), bf_lo(c.y), bf_hi(c.y)}; nb[3] = (f32x4){bf_lo(c.z), bf_hi(c.z), bf_lo(c.w), bf_hi(c.w)};
    }
    __device__ __forceinline__ void operator()(pg8::f32x4 (&acc)[2][2][4][2], const pg8::Unit& u, int wr, int wc, int fr, int fq) const {
        using pg8::f32x4; using pg8::HALF; using pg8::BM;
        const int row0 = u.pm * BM + wr * 64 + fr, col0 = u.pn * BM + wc * 32 + 8 * fq;
        f32x4 nb[4];
        load_base(row0, col0, nb);
#pragma unroll
        for (int it = 0; it < 8; ++it) { const int ai = it >> 2, m = it & 3;
            const size_t row = (size_t)(row0 + ai * HALF + m * 16); float s = 0.f;
            const f32x4 b0 = nb[0], b1 = nb[1], b2 = nb[2], b3 = nb[3];
            if (it < 7) load_base(row0 + ((it + 1) >> 2) * HALF + ((it + 1) & 3) * 16, col0, nb);
#pragma unroll
            for (int bj = 0; bj < 2; ++bj) {
                const f32x4 v0 = acc[ai][bj][m][0] + (bj == 0 ? b0 : b2), v1 = acc[ai][bj][m][1] + (bj == 0 ? b1 : b3);
                acc[ai][bj][m][0] = v0; acc[ai][bj][m][1] = v1;
                s += (v0[0] * v0[0] + v0[1] * v0[1]) + (v0[2] * v0[2] + v0[3] * v0[3]) + (v1[0] * v1[0] + v1[1] * v1[1]) + (v1[2] * v1[2] + v1[3] * v1[3]); }
            s += __shfl_xor(s, 16); s += __shfl_xor(s, 32);
            if (fq == 0) ss[row * 16 + u.pn * 4 + wc] = s; }
        xcd_barrier(bar);
        f32x4 gq[2][2];
#pragma unroll
        for (int bj = 0; bj < 2; ++bj)
#pragma unroll
            for (int n = 0; n < 2; ++n) gq[bj][n] = *(const f32x4*)(gf + col0 + bj * HALF + 4 * n);
        f32x4 pr[8];
#pragma unroll
        for (int it = 0; it < 8; ++it) pr[it] = *(const f32x4*)(ss + (size_t)(row0 + (it >> 2) * HALF + (it & 3) * 16) * 16 + 4 * fq);
#pragma unroll
        for (int it = 0; it < 8; ++it) { const int ai = it >> 2, m = it & 3;
            const size_t row = (size_t)(row0 + ai * HALF + m * 16); const size_t off = row * 1024 + col0;
            float sq = (pr[it][0] + pr[it][1]) + (pr[it][2] + pr[it][3]); sq += __shfl_xor(sq, 16); sq += __shfl_xor(sq, 32);
            const float rstd = rsqrtf(sq * (1.0f / 1024.0f) + pg8::RMS_EPS);
#pragma unroll
            for (int bj = 0; bj < 2; ++bj) { *(f32x4*)(out + off + bj * HALF) = acc[ai][bj][m][0] * rstd * gq[bj][0]; *(f32x4*)(out + off + bj * HALF + 4) = acc[ai][bj][m][1] * rstd * gq[bj][1]; } }
    }
};

struct EpiPool {
    LAS unsigned char* lds; const bf16* h; const bf16* wt; bf16* p; bf16* hbuf; unsigned* flags; unsigned* tmo;
    static constexpr int PITCH = 528;
    __device__ __forceinline__ void operator()(pg8::f32x4 (&acc)[2][2][4][2], const pg8::Unit& u, int wr, int wc, int fr, int fq) const {
        using pg8::f32x4; using pg8::u32x4; using pg8::bf16x8; using pg8::cvt_pk_bf16;
        int tid = threadIdx.x; asm volatile("" : "+v"(tid)); const int lane = tid & 63; const int wid = __builtin_amdgcn_readfirstlane(tid >> 6);
#pragma unroll
        for (int ai = 0; ai < 2; ++ai)
#pragma unroll
            for (int m = 0; m < 4; ++m) { const int r = ai * 128 + wr * 64 + m * 16 + fr;
#pragma unroll
                for (int bj = 0; bj < 2; ++bj) { const f32x4 v0 = acc[ai][bj][m][0], v1 = acc[ai][bj][m][1];
                    u32x4 w; w.x = cvt_pk_bf16(v0[0], v0[1]); w.y = cvt_pk_bf16(v0[2], v0[3]); w.z = cvt_pk_bf16(v1[0], v1[1]); w.w = cvt_pk_bf16(v1[2], v1[3]);
                    *(LAS u32x4*)(lds + (16 + r) * PITCH + (bj * 128 + wc * 32 + 8 * fq) * 2) = w;
                    if (ai == 1 && m == 3 && wr == 1) {
                        bf16* hp_ = hbuf + ((size_t)(u.pm * 4 + u.pn) * 16 + fr) * 256 + bj * 128 + wc * 32 + 8 * fq;
                        asm volatile("global_store_dwordx4 %0, %1, off sc1\n\ts_nop 1" :: "v"(hp_), "v"(w) : "memory"); } } }
        asm volatile("s_waitcnt vmcnt(0)" ::: "memory");
        __syncthreads();
        if (tid == 0) __hip_atomic_store(flags + (u.pm * 4 + u.pn) * 64, 1u, __ATOMIC_RELAXED, __HIP_MEMORY_SCOPE_AGENT);
        const bool seq_start = (u.pm & 31) == 0;
        if (seq_start) { for (int e = tid; e < 16 * 32; e += 512) *(LAS u32x4*)(lds + (e >> 5) * PITCH + (e & 31) * 16) = (u32x4){0u, 0u, 0u, 0u}; }
        else {
            if (tid == 0) { unsigned* fl = flags + ((u.pm - 1) * 4 + u.pn) * 64; XB_SPIN(xb_ld(fl) == 0u, tmo);
                __builtin_amdgcn_fence(__ATOMIC_ACQUIRE, "agent"); asm volatile("s_waitcnt vmcnt(0)" ::: "memory"); }
            __syncthreads();
            const u32x4 hv = *(const GAS u32x4*)(hbuf + (size_t)((u.pm - 1) * 4 + u.pn) * 4096 + tid * 8);
            *(LAS u32x4*)(lds + (tid >> 5) * PITCH + (tid & 31) * 16) = hv;
        }
        LDS_WAIT(); __syncthreads();
        const int cq = tid & 63, seg = tid >> 6, w = 2 << u.pn;
        const LAS unsigned char* colp = lds + cq * 8;
#define EP_RD4(rowi) ({ const v2u q_ = *(const LAS v2u*)(colp + (rowi) * PITCH); (f32x4){bflo(q_.x), bfhi(q_.x), bflo(q_.y), bfhi(q_.y)}; })
        f32x4 S = {0.f, 0.f, 0.f, 0.f};
        for (int d = 1; d < w; ++d) S = S + EP_RD4(16 + 32 * seg - d);
        const float invw = 1.0f / (float)w;
        bf16* pp = p + (size_t)(u.pm * 256 + 32 * seg) * 1024 + u.pn * 256 + 4 * cq;
        const int t0 = ((u.pm & 31) * 256) + 32 * seg;
#pragma unroll 4
        for (int r = 0; r < 32; ++r) {
            const int lr = 16 + 32 * seg + r;
            const f32x4 uc = EP_RD4(lr);
            S = S + uc;
            const int t = t0 + r; const float inv = (t + 1 >= w) ? invw : 1.0f / (float)(t + 1);
            const f32x4 o = S * inv - uc;
            *(GAS v2u*)(pp + (size_t)r * 1024) = (v2u){pk2(o[0], o[1]), pk2(o[2], o[3])};
            S = S - EP_RD4(lr - (w - 1));
        }
#undef EP_RD4
        LDS_WAIT(); __syncthreads();
    }
};

struct Frame {
    LAS unsigned char* lds;
    int tid, lane, wave, vcu, G;
};
__device__ __forceinline__ float wave_sum(float v) {
#pragma unroll
    for (int o = 1; o < 64; o <<= 1) v += __shfl_xor(v, o);
    return v;
}

constexpr int LDS_RSTAB = 131072 + 4096;
__device__ __forceinline__ pg8::RsTab fill_rstd_tab(LAS unsigned char* lds, const float* ss, int pm) {
    LAS float* tab = (LAS float*)(lds + LDS_RSTAB);
    int tid = threadIdx.x; asm volatile("" : "+v"(tid));
    if (tid < 256) { const float* p = ss + ((size_t)pm * 256 + tid) * 16; float s = 0.f;
#pragma unroll
        for (int q = 0; q < 4; ++q) { const f32x4 v = *(const GAS f32x4*)(p + 4 * q); s += (v[0] + v[1]) + (v[2] + v[3]); }
        tab[tid] = rsqrtf(s * (1.0f / 1024.0f) + 1e-6f); }
    LDS_WAIT(); __syncthreads();
    pg8::RsTab r; r.tab = tab; r.pm = pm; return r;
}

__device__ __forceinline__ const LAS float* seg_fill(LAS unsigned char* lds, const float* lse, int pm) {
    LAS float* tab = (LAS float*)(lds + LDS_RSTAB);
    int tid = threadIdx.x; asm volatile("" : "+v"(tid));
    if (tid < 256) { const float* p = lse + ((size_t)pm * 256 + tid) * 16; float L[16];
#pragma unroll
        for (int q4 = 0; q4 < 4; ++q4) { const f32x4 v = *(const GAS f32x4*)(p + 4 * q4); L[4 * q4] = v[0]; L[4 * q4 + 1] = v[1]; L[4 * q4 + 2] = v[2]; L[4 * q4 + 3] = v[3]; }
        float lg0, lg1, lg2;
        { float mx = L[0];
_Pragma("unroll") for (int i = 1; i < 6; ++i) mx = fmaxf(mx, L[i]); float s = 0.f;
_Pragma("unroll") for (int i = 0; i < 6; ++i) s += __expf(L[i] - mx); lg0 = mx + __logf(s) - 1.791759469228055f; }
        { float mx = L[6];
_Pragma("unroll") for (int i = 7; i < 11; ++i) mx = fmaxf(mx, L[i]); float s = 0.f;
_Pragma("unroll") for (int i = 6; i < 11; ++i) s += __expf(L[i] - mx); lg1 = mx + __logf(s) - 1.6094379124341003f; }
        { float mx = L[11];
_Pragma("unroll") for (int i = 12; i < 16; ++i) mx = fmaxf(mx, L[i]); float s = 0.f;
_Pragma("unroll") for (int i = 11; i < 16; ++i) s += __expf(L[i] - mx); lg2 = mx + __logf(s) - 1.6094379124341003f; }
        const float mx = fmaxf(lg0, fmaxf(lg1, lg2));
        const float e0 = __expf(lg0 - mx), e1 = __expf(lg1 - mx), e2 = __expf(lg2 - mx); const float is = 3.0f / (e0 + e1 + e2);
        const float s0 = fmaxf(e0 * is, 1e-30f), s1 = fmaxf(e1 * is, 1e-30f), s2 = fmaxf(e2 * is, 1e-30f);
        tab[tid] = s0 / s1; tab[256 + tid] = s1 / s2; tab[512 + tid] = s2; }
    LDS_WAIT(); __syncthreads();
    return tab;
}

__device__ __forceinline__ int p0_map_row(int mode, int sel, int row_off, int n) {
    if (mode == 0) return row_off + n;
    if (mode == 1) return 256 * (n >> 7) + 128 * sel + (n & 127);
    const int pn = n >> 8, w = n & 255, wc = w >> 6, d = w & 63; return 256 * pn + 128 * (d >> 5) + 32 * wc + (d & 31);
}
__device__ __forceinline__ void p0_tr_item(const float* W, int K, int N, bf16* WT, int mode, int sel, int row_off, const float* kgain, const float* nscale, LAS unsigned* scr, int item, int lane) {
    const int nblk = N / 64, kb = item / nblk, nb = item % nblk, k0 = 64 * kb, n0 = 64 * nb;
    const int kq = lane >> 4, n4 = (lane & 15) * 4;
    f32x4 ns = (f32x4){1.f, 1.f, 1.f, 1.f}; if (nscale) ns = *(const GAS f32x4*)(nscale + n0 + n4);
    f32x4 v[16];
#pragma unroll
    for (int i = 0; i < 16; ++i) { const int k = 8 * (i >> 1) + 2 * kq + (i & 1); v[i] = *(const GAS f32x4*)(W + (size_t)(k0 + k) * N + n0 + n4); }
    if (kgain) {
#pragma unroll
        for (int i = 0; i < 16; ++i) { const int k = 8 * (i >> 1) + 2 * kq + (i & 1); v[i] = v[i] * kgain[k0 + k]; }
    }
#pragma unroll
    for (int ip = 0; ip < 8; ++ip) { const f32x4 e = v[2 * ip] * ns, o = v[2 * ip + 1] * ns;
#pragma unroll
        for (int c = 0; c < 4; ++c) scr[(n4 + c) * 33 + 4 * ip + kq] = pk2(e[c], o[c]); }
    LDS_WAIT(); asm volatile("" ::: "memory");
    const int kc = lane & 7;
#pragma unroll
    for (int jj = 0; jj < 8; ++jj) { const int n = (lane >> 3) + 8 * jj; const LAS unsigned* sp = scr + n * 33 + 4 * kc;
        v4u o; o.x = sp[0]; o.y = sp[1]; o.z = sp[2]; o.w = sp[3];
        *(GAS v4u*)(WT + (size_t)p0_map_row(mode, sel, row_off, n0 + n) * K + k0 + 8 * kc) = o; }
    LDS_WAIT(); asm volatile("" ::: "memory");
}

struct Args { const float* in[13]; float* out; unsigned char* ws; int ph_lo, ph_hi; };

__device__ __forceinline__ void sincos_acc(float angf, float& c, float& s) {
    const double x = (double)angf; const double k = __builtin_rint(x * 0.15915494309189535);
    double y = (x - k * 6.283185307179586) * 0.25;
    const double y2 = y * y;
    double sn = y * (1.0 + y2 * (-1.0 / 6 + y2 * (1.0 / 120 + y2 * (-1.0 / 5040 + y2 * (1.0 / 362880 + y2 * (-1.0 / 39916800 + y2 * (1.0 / 6227020800.0)))))));
    double cs = 1.0 + y2 * (-0.5 + y2 * (1.0 / 24 + y2 * (-1.0 / 720 + y2 * (1.0 / 40320 + y2 * (-1.0 / 3628800 + y2 * (1.0 / 479001600.0 + y2 * (-1.0 / 87178291200.0)))))));
#pragma unroll
    for (int i = 0; i < 2; ++i) { const double s2 = 2.0 * sn * cs, c2 = 1.0 - 2.0 * sn * sn; sn = s2; cs = c2; }
    c = (float)cs; s = (float)sn;
}

template <int GI>
__device__ __forceinline__ void pool_group(f32x4 (&cur)[16], f32x4 (&prev)[16], f32x4& S2, f32x4& S4, f32x4& S8, f32x4& S16, const f32x4 gv, const float* x, bf16* hp,
                                           int R0, bool bstart, int c4, int hl, int lane, int wq, LAS float* part, LAS float* rs) {
    const bool zero = (GI == 0) && bstart;
#pragma unroll
    for (int j = 0; j < 16; ++j) { const f32x4 v = cur[j]; part[j * 256 + hl] = (v[0] * v[0] + v[1] * v[1]) + (v[2] * v[2] + v[3] * v[3]); }
    LDS_WAIT(); __syncthreads();
#pragma unroll
    for (int q = 0; q < 4; ++q) { const int j = 4 * wq + q; const f32x4 p = *(const LAS f32x4*)(part + j * 256 + 4 * lane);
        const float s = wave_sum((p[0] + p[1]) + (p[2] + p[3])); if (lane == 0) rs[j] = zero ? 0.f : rsqrtf(s * (1.0f / D) + 1e-6f); }
    LDS_WAIT(); __syncthreads();
#pragma unroll
    for (int j = 0; j < 16; ++j) {
        const int row = R0 - 16 + GI * 16 + j;
        const f32x4 hv = cur[j] * rs[j] * gv;
        const f32x4 h2 = j >= 2 ? cur[j >= 2 ? j - 2 : 0] : prev[(j + 14) & 15], h4 = j >= 4 ? cur[j >= 4 ? j - 4 : 0] : prev[(j + 12) & 15], h8 = j >= 8 ? cur[j >= 8 ? j - 8 : 0] : prev[(j + 8) & 15];
        S2 = S2 + hv - h2; S4 = S4 + hv - h4; S8 = S8 + hv - h8; S16 = S16 + hv - prev[j];
        cur[j] = hv;
        if (GI < 2) prev[j] = *(const GAS f32x4*)(x + (size_t)(row + 16) * D + 4 * c4);
        if (GI > 0) {
            const int t = row & (SEQ - 1);
            const float i2 = t >= 1 ? 0.5f : 1.0f, i4 = t >= 3 ? 0.25f : 1.0f / (float)(t + 1), i8 = t >= 7 ? 0.125f : 1.0f / (float)(t + 1), i16 = t >= 15 ? 0.0625f : 1.0f / (float)(t + 1);
            const f32x4 o2 = S2 * i2 - hv, o4 = S4 * i4 - hv, o8 = S8 * i8 - hv, o16 = S16 * i16 - hv;
            const size_t off = (size_t)row * D + 4 * c4;
            *(GAS v2u*)(hp + off) = (v2u){pk2(o2[0], o2[1]), pk2(o2[2], o2[3])};
            *(GAS v2u*)(hp + (size_t)M * D + off) = (v2u){pk2(o4[0], o4[1]), pk2(o4[2], o4[3])};
            *(GAS v2u*)(hp + 2 * (size_t)M * D + off) = (v2u){pk2(o8[0], o8[1]), pk2(o8[2], o8[3])};
            *(GAS v2u*)(hp + 3 * (size_t)M * D + off) = (v2u){pk2(o16[0], o16[1]), pk2(o16[2], o16[3])};
        }
    }
}

constexpr int I_SQ = 16 * 16, I_GU = 16 * 44, I_DN = 44 * 16, I_QKV = 16 * 48, I_W2 = 4 * 32 * 8;
constexpr int W_EARLY = I_W2 + I_SQ + 2 * I_GU, W_ITEMS = W_EARLY + I_DN + I_QKV + I_SQ + 2 * I_GU + I_DN;
__device__ __forceinline__ void w2_item(const Args& a, int it, int lane) {
    typedef float f32x16 __attribute__((ext_vector_type(16)));
    const int g = it >> 8, r = it & 255, n0 = (r >> 3) * 32, c0 = (r & 7) * 32, i = lane & 31, h = lane >> 5;
    const float* wout = a.in[7] + (size_t)(g * 256) * 1024 + n0 + i;
    const float* wgr = a.in[5] + (size_t)g * 65536 + (size_t)(c0 + i) * 256;
    const float* sc = a.in[6] + g * 256;
    f32x16 acc = {0.f, 0.f, 0.f, 0.f, 0.f, 0.f, 0.f, 0.f, 0.f, 0.f, 0.f, 0.f, 0.f, 0.f, 0.f, 0.f};
#pragma unroll 1
    for (int ch = 0; ch < 4; ++ch) {
        float av[4][8]; f32x4 bv[4][2], sv[4][2];
#pragma unroll
        for (int ks = 0; ks < 4; ++ks) { const int j0 = 64 * ch + 16 * ks + 8 * h;
#pragma unroll
            for (int e = 0; e < 8; ++e) av[ks][e] = wout[(size_t)(j0 + e) * 1024];
            bv[ks][0] = *(const GAS f32x4*)(wgr + j0); bv[ks][1] = *(const GAS f32x4*)(wgr + j0 + 4);
            sv[ks][0] = *(const GAS f32x4*)(sc + j0); sv[ks][1] = *(const GAS f32x4*)(sc + j0 + 4); }
        asm volatile("" ::: "memory"); __builtin_amdgcn_sched_barrier(0);
#pragma unroll
        for (int ks = 0; ks < 4; ++ks) {
            pg8::u32x4 aw, bw; const f32x4 b0 = bv[ks][0] * sv[ks][0], b1 = bv[ks][1] * sv[ks][1];
            aw.x = pg8::cvt_pk_bf16(av[ks][0], av[ks][1]); aw.y = pg8::cvt_pk_bf16(av[ks][2], av[ks][3]); aw.z = pg8::cvt_pk_bf16(av[ks][4], av[ks][5]); aw.w = pg8::cvt_pk_bf16(av[ks][6], av[ks][7]);
            bw.x = pg8::cvt_pk_bf16(b0[0], b0[1]); bw.y = pg8::cvt_pk_bf16(b0[2], b0[3]); bw.z = pg8::cvt_pk_bf16(b1[0], b1[1]); bw.w = pg8::cvt_pk_bf16(b1[2], b1[3]);
            acc = __builtin_amdgcn_mfma_f32_32x32x16_bf16(__builtin_bit_cast(pg8::bf16x8, aw), __builtin_bit_cast(pg8::bf16x8, bw), acc, 0, 0, 0);
        }
    }
    bf16* W2T = (bf16*)(a.ws + WS_WPO) + (size_t)n0 * 1024 + g * 256 + c0 + i;
#pragma unroll
    for (int rr = 0; rr < 16; ++rr) W2T[(size_t)((rr & 3) + 8 * (rr >> 2) + 4 * h) * 1024] = (bf16)f2bf(acc[rr]);
}
__device__ __forceinline__ void weight_item(const Args& a, int it, LAS unsigned* scr, int lane) {
    unsigned char* ws = a.ws; const float* norm_mix = a.in[1]; const float* norm_ffn = a.in[2];
    int r = it;
    if (r < I_W2) { w2_item(a, r, lane); return; } r -= I_W2;
    if (r < I_SQ) { p0_tr_item(a.in[4], D, D, (bf16*)(ws + WS_WIN), 0, 0, 0, nullptr, nullptr, scr, r, lane); return; } r -= I_SQ;
    if (r < I_GU) { p0_tr_item(a.in[10], D, FF, (bf16*)(ws + WS_WGU0), 1, 0, 0, norm_ffn, nullptr, scr, r, lane); return; } r -= I_GU;
    if (r < I_GU) { p0_tr_item(a.in[11], D, FF, (bf16*)(ws + WS_WGU0), 1, 1, 0, norm_ffn, nullptr, scr, r, lane); return; } r -= I_GU;
    if (r < I_DN) { p0_tr_item(a.in[12], FF, D, (bf16*)(ws + WS_WD0), 0, 0, 0, nullptr, nullptr, scr, r, lane); return; } r -= I_DN;
    if (r < I_QKV) { p0_tr_item(a.in[8], D, 3 * D, (bf16*)(ws + WS_WQKV), 2, 0, 0, norm_mix + D, nullptr, scr, r, lane); return; } r -= I_QKV;
    if (r < I_SQ) { p0_tr_item(a.in[9], D, D, (bf16*)(ws + WS_WAO), 0, 0, 0, nullptr, nullptr, scr, r, lane); return; } r -= I_SQ;
    if (r < I_GU) { p0_tr_item(a.in[10] + (size_t)D * FF, D, FF, (bf16*)(ws + WS_WGU1), 1, 0, 0, norm_ffn + D, nullptr, scr, r, lane); return; } r -= I_GU;
    if (r < I_GU) { p0_tr_item(a.in[11] + (size_t)D * FF, D, FF, (bf16*)(ws + WS_WGU1), 1, 1, 0, norm_ffn + D, nullptr, scr, r, lane); return; } r -= I_GU;
    p0_tr_item(a.in[12] + (size_t)D * FF, FF, D, (bf16*)(ws + WS_WD1), 0, 0, 0, nullptr, nullptr, scr, r, lane);
}
__device__ __forceinline__ void rope_entries(unsigned char* ws, int first, int stride) {
    float* rope = (float*)(ws + WS_ROPE);
    for (int e = first; e < SEQ * 32; e += stride) {
        const int t = e >> 5, j = e & 31;
        const float invf = (float)(1.0 / (double)(float)exp2(13.287712379549449 * (double)j / 32.0));
        const float ang = (float)t * invf; float c, s; sincos_acc(ang, c, s);
        rope[(size_t)t * 64 + j] = c; rope[(size_t)t * 64 + 32 + j] = s;
    }
}
__device__ __forceinline__ void late_prep(const Args& a0, LAS unsigned char* lds, int widx, int nidle) {
    Args a = a0;
#pragma unroll
    for (int i = 0; i < 13; ++i) asm volatile("" : "+s"(a.in[i]));
    asm volatile("" : "+s"(a.ws));
    int tid = threadIdx.x; asm volatile("" : "+v"(tid)); const int lane = tid & 63, wave = __builtin_amdgcn_readfirstlane(tid >> 6);
    LAS unsigned* scr = (LAS unsigned*)(lds + wave * 16384);
    for (int it = W_EARLY + widx * NWAVES + wave; it < W_ITEMS; it += nidle * NWAVES) weight_item(a, it, scr, lane);
}

__device__ __forceinline__ void p0_prologue(const Frame& F0, const Args& a, bool defer_late, bool pool_epi) {
    Frame F = F0; { int tid = threadIdx.x; asm volatile("" : "+v"(tid)); F.tid = tid; F.lane = tid & 63; F.wave = __builtin_amdgcn_readfirstlane(tid >> 6); }
    unsigned char* ws = a.ws;
    LAS unsigned* scr = (LAS unsigned*)(F.lds + F.wave * 16384);
    const int gw = F.vcu * NWAVES + F.wave, NGW = F.G * NWAVES;
    const float* norm_mix = a.in[1];
    const int n_items = defer_late ? W_EARLY : W_ITEMS;
    for (int it = gw; it < n_items; it += NGW) weight_item(a, it, scr, F.lane);
    rope_entries(ws, F.vcu * NWAVES * 64 + F.tid, F.G * NWAVES * 64);
    __syncthreads();
    if (pool_epi) {
        const float* x = a.in[0]; bf16* hb = (bf16*)(ws + WS_BIG); bf16* xb0 = (bf16*)(ws + WS_XB);
        f32x4 gv[4];
#pragma unroll
        for (int j = 0; j < 4; ++j) gv[j] = *(const GAS f32x4*)(norm_mix + 4 * F.lane + 256 * j);
        const int gwr = F.vcu * NWAVES + F.wave;
        for (int m = gwr; m < M; m += 2 * NGW) {
            const int m2 = (m + NGW < M) ? m + NGW : m;
            const GAS f32x4* x1 = (const GAS f32x4*)(x + (size_t)m * D) + F.lane; const GAS f32x4* x2 = (const GAS f32x4*)(x + (size_t)m2 * D) + F.lane;
            f32x4 v[4], w2[4]; float s1 = 0.f, s2 = 0.f;
#pragma unroll
            for (int j = 0; j < 4; ++j) { v[j] = x1[64 * j]; w2[j] = x2[64 * j]; }
#pragma unroll
            for (int j = 0; j < 4; ++j) { s1 += (v[j][0] * v[j][0] + v[j][1] * v[j][1]) + (v[j][2] * v[j][2] + v[j][3] * v[j][3]); s2 += (w2[j][0] * w2[j][0] + w2[j][1] * w2[j][1]) + (w2[j][2] * w2[j][2] + w2[j][3] * w2[j][3]); }
            const float r1 = rsqrtf(wave_sum(s1) * (1.0f / D) + 1e-6f), r2 = rsqrtf(wave_sum(s2) * (1.0f / D) + 1e-6f);
            GAS v2u* o1 = (GAS v2u*)(hb + (size_t)m * D) + F.lane; GAS v2u* o2 = (GAS v2u*)(hb + (size_t)m2 * D) + F.lane;
            GAS v2u* y1 = (GAS v2u*)(xb0 + (size_t)m * D) + F.lane; GAS v2u* y2 = (GAS v2u*)(xb0 + (size_t)m2 * D) + F.lane;
#pragma unroll
            for (int j = 0; j < 4; ++j) { const f32x4 a1 = v[j] * r1 * gv[j], a2 = w2[j] * r2 * gv[j];
                o1[64 * j] = (v2u){pk2(a1[0], a1[1]), pk2(a1[2], a1[3])}; o2[64 * j] = (v2u){pk2(a2[0], a2[1]), pk2(a2[2], a2[3])};
                y1[64 * j] = (v2u){pk2(v[j][0], v[j][1]), pk2(v[j][2], v[j][3])}; y2[64 * j] = (v2u){pk2(w2[j][0], w2[j][1]), pk2(w2[j][2], w2[j][3])}; }
        }
    } else
    {
        const float* x = a.in[0]; const float* g0 = norm_mix;
        bf16* hp = (bf16*)(ws + WS_BIG);
        const int half = F.tid >> 8, c4 = F.tid & 255, hl = c4, wq = F.wave & 3;
        LAS float* part = (LAS float*)(F.lds) + half * (16 * 256);
        LAS float* rs = (LAS float*)(F.lds + 32768) + half * 16;
        const f32x4 gv = *(const GAS f32x4*)(g0 + 4 * c4);
        for (int blk = F.vcu; blk < M / 64; blk += F.G) {
            const int R0 = blk * 64 + half * 32;
            const bool bstart = (R0 & (SEQ - 1)) == 0;
            f32x4 A[16], B[16];
#pragma unroll
            for (int j = 0; j < 16; ++j) { B[j] = (f32x4){0.f, 0.f, 0.f, 0.f}; A[j] = B[j]; if (!bstart) A[j] = *(const GAS f32x4*)(x + (size_t)(R0 - 16 + j) * D + 4 * c4); }
            f32x4 S2 = B[0], S4 = B[0], S8 = B[0], S16 = B[0];
            pool_group<0>(A, B, S2, S4, S8, S16, gv, x, hp, R0, bstart, c4, hl, F.lane, wq, part, rs);
            pool_group<1>(B, A, S2, S4, S8, S16, gv, x, hp, R0, bstart, c4, hl, F.lane, wq, part, rs);
            pool_group<2>(A, B, S2, S4, S8, S16, gv, x, hp, R0, bstart, c4, hl, F.lane, wq, part, rs);
            __syncthreads();
        }
    }
}

namespace att {
typedef short bf16x8 __attribute__((ext_vector_type(8)));
typedef short s16x4 __attribute__((ext_vector_type(4)));
typedef float f32x16 __attribute__((ext_vector_type(16)));
typedef unsigned u32x4 __attribute__((ext_vector_type(4)));
constexpr int KCH = 6160;
constexpr int LDS_K = 0, LDS_V = 8 * KCH, VDH = 24 * 1024 + 64, LDS_OST = LDS_V + 2 * VDH, LDS_TOTAL = LDS_OST + 8 * 4096;
static_assert(LDS_TOTAL <= LDS_BYTES, "attention LDS");
__device__ __forceinline__ int crow(int r, int hi) { return (r & 3) + 8 * (r >> 2) + 4 * hi; }
__device__ __forceinline__ s16x4 vtr(const LAS unsigned char* p) { return __builtin_bit_cast(s16x4, __builtin_amdgcn_ds_read_tr16_b64_v4i16((LAS s16x4*)p)); }
struct KVQ { u32x4 k[6], v[6]; bf16x8 q[4]; };
__device__ __forceinline__ void attn_load(int item, const bf16* Qp, const bf16* Kp, const bf16* Vp, KVQ& R, int tid, int wid, int r32, int hi) {
    const int bh = item >> 5, j = item & 31, h = bh & 15;
    const int dsh = h < 6 ? 0 : (h < 11 ? 2 : 4);
    const bool first = (j & ((32 >> dsh) - 1)) == 0;
    const size_t hb = (size_t)bh * (SEQ * 64);
    const int pos0 = j * 256;
#pragma unroll
    for (int it = 0; it < 6; ++it) {
        const int p = tid + 512 * it, key = p >> 3, c = p & 7;
        const int keyc = (first && key < 128) ? 128 : key;
        const size_t go = hb + (size_t)(pos0 - 128 + keyc) * 64 + c * 8; R.k[it] = *(const GAS u32x4*)(Kp + go); R.v[it] = *(const GAS u32x4*)(Vp + go);
    }
#pragma unroll
    for (int d0 = 0; d0 < 4; ++d0) R.q[d0] = *(const GAS bf16x8*)(Qp + hb + (size_t)(pos0 + 32 * wid + r32) * 64 + d0 * 16 + hi * 8);
}
__device__ __forceinline__ void attn_phase(int item0, int nitems, const bf16* Qp, const bf16* Kp, const bf16* Vp, bf16* O, float* lse, LAS unsigned char* shm) {
    int tid = threadIdx.x; asm volatile("" : "+v"(tid));
    const int wid = __builtin_amdgcn_readfirstlane(tid >> 6);
    KVQ R;
    if (nitems > 0) attn_load(item0, Qp, Kp, Vp, R, tid, wid, tid & 31, (tid & 63) >> 5);
#pragma unroll 1
  for (int ii = 0; ii < nitems; ++ii) {
    asm volatile("" : "+v"(tid));
    const int lane = tid & 63, r32 = lane & 31, hi = lane >> 5;
    const int item = item0 + ii, bh = item >> 5, j = item & 31;
    const int b = bh >> 4, h = bh & 15;
    const int dsh = h < 6 ? 0 : (h < 11 ? 2 : 4);
    const int nqb = 32 >> dsh, r = j >> (5 - dsh), qb = j & (nqb - 1);
    const bool first = (qb == 0);
#pragma unroll
    for (int it = 0; it < 6; ++it) {
        const int p = tid + 512 * it, key = p >> 3, c = p & 7;
        const bool dead = first && key < 128; const u32x4 z4 = (u32x4){0u, 0u, 0u, 0u};
        *(LAS u32x4*)(shm + LDS_K + c * KCH + key * 16) = dead ? z4 : R.k[it];
        *(LAS u32x4*)(shm + LDS_V + (c >> 2) * VDH + (key >> 4) * 1024 + (key & 15) * 64 + (c & 3) * 16) = dead ? z4 : R.v[it];
    }
    bf16x8 qr[4];
#pragma unroll
    for (int d0 = 0; d0 < 4; ++d0) qr[d0] = R.q[d0];
    LDS_WAIT(); __syncthreads();
    if (ii + 1 < nitems) attn_load(item + 1, Qp, Kp, Vp, R, tid, wid, r32, hi);
    f32x16 P[5];
    const LAS unsigned char* kbase = shm + LDS_K + hi * KCH + (32 * wid + r32) * 16;
#pragma unroll
    for (int kt = 0; kt < 5; ++kt) {
        f32x16 acc = {0.f, 0.f, 0.f, 0.f, 0.f, 0.f, 0.f, 0.f, 0.f, 0.f, 0.f, 0.f, 0.f, 0.f, 0.f, 0.f};
#pragma unroll
        for (int d0 = 0; d0 < 4; ++d0) { const bf16x8 kf = *(const LAS bf16x8*)(kbase + (2 * d0) * KCH + kt * 512); acc = __builtin_amdgcn_mfma_f32_32x32x16_bf16(kf, qr[d0], acc, 0, 0, 0); }
        P[kt] = acc;
    }
    const float NEG = -INFINITY;
    const int lowlim = first ? (128 - 32 * wid) : 0;
    const int lo0 = r32 > lowlim ? r32 : lowlim;
#pragma unroll
    for (int rr = 0; rr < 16; ++rr) { const int cr = crow(rr, hi); if (cr < lo0) P[0][rr] = NEG; if (cr > r32) P[4][rr] = NEG; }
    if (first) {
#pragma unroll
        for (int kt = 1; kt < 4; ++kt)
#pragma unroll
            for (int rr = 0; rr < 16; ++rr) if (32 * kt + crow(rr, hi) < lowlim) P[kt][rr] = NEG;
    }
    float mx = NEG;
#pragma unroll
    for (int kt = 0; kt < 5; ++kt)
#pragma unroll
        for (int rr = 0; rr < 16; ++rr) mx = fmaxf(mx, P[kt][rr]);
    mx = fmaxf(mx, __shfl_xor(mx, 32));
    float l = 0.f;
#pragma unroll
    for (int kt = 0; kt < 5; ++kt)
#pragma unroll
        for (int rr = 0; rr < 16; ++rr) { const float e = __builtin_amdgcn_exp2f(P[kt][rr] - mx); P[kt][rr] = e; l += e; }
    l += __shfl_xor(l, 32);
    const float inv = __builtin_amdgcn_rcpf(l);
    {
        const int i = qb * 256 + 32 * wid + r32, t = (i << dsh) + r;
        if (hi == 0) lse[((size_t)b * SEQ + t) * 16 + h] = (mx + __log2f(l)) * 0.6931471805599453f;
    }
    f32x16 o[2];
    o[0] = (f32x16){0.f, 0.f, 0.f, 0.f, 0.f, 0.f, 0.f, 0.f, 0.f, 0.f, 0.f, 0.f, 0.f, 0.f, 0.f, 0.f}; o[1] = o[0];
    const LAS unsigned char* vb = shm + LDS_V + ((lane >> 4) & 1) * 32 + (lane & 3) * 8 + (4 * hi + ((lane & 15) >> 2)) * 64;
#pragma unroll
    for (int kt = 0; kt < 5; ++kt)
#pragma unroll
        for (int s = 0; s < 2; ++s) {
            u32x4 pw;
            pw.x = pg8::cvt_pk_bf16(P[kt][8 * s + 0] * inv, P[kt][8 * s + 1] * inv); pw.y = pg8::cvt_pk_bf16(P[kt][8 * s + 2] * inv, P[kt][8 * s + 3] * inv);
            pw.z = pg8::cvt_pk_bf16(P[kt][8 * s + 4] * inv, P[kt][8 * s + 5] * inv); pw.w = pg8::cvt_pk_bf16(P[kt][8 * s + 6] * inv, P[kt][8 * s + 7] * inv);
            const bf16x8 pa = __builtin_bit_cast(bf16x8, pw);
            const int kblk = 2 * wid + 2 * kt + s;
#pragma unroll
            for (int dh = 0; dh < 2; ++dh) {
                const s16x4 vlo = vtr(vb + dh * VDH + kblk * 1024), vhi = vtr(vb + dh * VDH + kblk * 1024 + 512);
                const bf16x8 vf = (bf16x8){vlo[0], vlo[1], vlo[2], vlo[3], vhi[0], vhi[1], vhi[2], vhi[3]};
                o[dh] = __builtin_amdgcn_mfma_f32_32x32x16_bf16(pa, vf, o[dh], 0, 0, 0);
            }
        }
    {
        LAS bf16* stg = (LAS bf16*)(shm + LDS_OST + wid * 4096);
#pragma unroll
        for (int rr = 0; rr < 16; ++rr) { const int orow = crow(rr, hi);
#pragma unroll
            for (int dh = 0; dh < 2; ++dh) stg[orow * 64 + dh * 32 + r32] = (bf16)f2bf(o[dh][rr]); }
        LDS_WAIT(); asm volatile("" ::: "memory");
#pragma unroll
        for (int i4 = 0; i4 < 4; ++i4) { const int row = i4 * 8 + (lane >> 3), ch = lane & 7; const u32x4 v = *(const LAS u32x4*)(stg + row * 64 + ch * 8);
            const int i = qb * 256 + 32 * wid + row, t = (i << dsh) + r;
            *(GAS u32x4*)(O + ((size_t)b * SEQ + t) * D + h * 64 + ch * 8) = v; }
    }
    LDS_WAIT(); __syncthreads();
  }
}
}

__global__ void __launch_bounds__(NWAVES * 64, 2) fwd_megakernel(Args args) {
    extern __shared__ __attribute__((aligned(16))) unsigned char lds[];
    Frame F;
    F.lds = (LAS unsigned char*)lds;
    F.tid = threadIdx.x; F.lane = F.tid & 63; F.wave = __builtin_amdgcn_readfirstlane(F.tid >> 6);
    F.G = gridDim.x; { const int bx = blockIdx.x; F.vcu = (F.G % 8 == 0) ? (bx % 8) * (F.G / 8) + bx / 8 : bx; }
    unsigned char* ws = args.ws;
    const int lo = args.ph_lo, hi = args.ph_hi;
    const bool one_launch = (hi - lo) > 1;
    volatile LAS unsigned* bst = (volatile LAS unsigned*)(F.lds + LDS_BYTES - 64);
    if (F.tid < 2) bst[F.tid] = 0u;
    __syncthreads();
    XcdBarrier bar; bar.bar = (unsigned*)(ws + WS_CTL) + CW_BAR; bar.x = 0; bar.st = bst;
    if (one_launch) bar = xcd_barrier_post((unsigned*)(ws + WS_CTL) + CW_BAR, bst);
#define IN(k) (lo <= (k) && (k) < hi)
#define SEAM(k) do { if (IN(k) && IN((k) + 1)) { xcd_barrier(bar); } } while (0)

    if (lo < 0) cg::this_grid().sync();
    float* resid = args.out;
    float* ssb = (float*)(ws + WS_SS);
    bf16* xb = (bf16*)(ws + WS_XB);
    bf16* zo = (bf16*)(ws + WS_ZO);
    bf16* big = (bf16*)(ws + WS_BIG);

    bool fused_done = false;
    const bool defer_late = one_launch && IN(0) && IN(4) && (F.G == 256);
    const bool pool_epi = (F.G == 256);
    if (IN(0)) { p0_prologue(F, args, defer_late, pool_epi); }
    SEAM(0);
    if (IN(1)) {
        pg8::StaticOrder S; S.init(M, D, F.G, (int)blockIdx.x);
        if (pool_epi) { pg8::Gemm g{big, (const bf16*)(ws + WS_WIN), M, D, D, D, D, 0};
            EpiPool E{F.lds, big, (const bf16*)(ws + WS_WIN), zo, (bf16*)(ws + WS_HALO), (unsigned*)(ws + WS_CTL) + CW_HALO, bar.bar};
            pg8::gemm_phase<EpiPool, pg8::StaticOrder, true, false, true>(F.lds, g, S, E); }
        else { pg8::Gemm g{big, (const bf16*)(ws + WS_WIN), M, D, D, D, D, (size_t)M * D * 2};
            pg8::EpiBf16 E{zo, D};
            pg8::gemm_phase<pg8::EpiBf16, pg8::StaticOrder, true>(F.lds, g, S, E); }
    }
    SEAM(1);
    if (IN(3)) {
        pg8::Gemm g{zo, (const bf16*)(ws + WS_WPO), M, D, D, D, D, 0};
        pg8::StaticOrder S; S.init(M, D, F.G, (int)blockIdx.x);
        if (pool_epi) { pg8::EpiRes<false> E{nullptr, xb, ssb, nullptr};
            pg8::gemm_phase<pg8::EpiRes<false>, pg8::StaticOrder, true>(F.lds, g, S, E); }
        else { pg8::EpiRes<true> E{args.in[0], xb, ssb, nullptr};
            pg8::gemm_phase<pg8::EpiRes<true>, pg8::StaticOrder, true>(F.lds, g, S, E); }
    }
    SEAM(3);
#pragma unroll 1
    for (int layer = 0; layer < 2; ++layer) {
        const int pb = layer == 0 ? 4 : 10;
        if (IN(pb)) {
            pg8::Gemm g{xb, (const bf16*)(ws + (layer == 0 ? WS_WGU0 : WS_WGU1)), M, 2 * FF, D, D, D, 0};
            pg8::StaticOrder S; S.init(M, 2 * FF, F.G, (int)blockIdx.x);
            pg8::Unit u0; const pg8::RsTab rt = fill_rstd_tab(F.lds, ssb, S.next(0, u0) ? u0.pm : 0);
            pg8::EpiSwiGLU E{big, ssb, FF, rt};
            pg8::gemm_phase<pg8::EpiSwiGLU, pg8::StaticOrder, true>(F.lds, g, S, E);
            if (layer == 0 && defer_late && (int)blockIdx.x >= 128) late_prep(args, F.lds, (int)blockIdx.x - 128, 128);
        }
        SEAM(pb);
#ifndef FUSE_FINAL
#define FUSE_FINAL 1
#endif
        const bool fuse_final = FUSE_FINAL && (layer == 1) && one_launch && IN(12) && (F.G == (M / 256) * (D / 256));
        if (IN(pb + 1)) {
            pg8::Gemm g{big, (const bf16*)(ws + (layer == 0 ? WS_WD0 : WS_WD1)), M, D, FF, FF, FF, 0};
            pg8::StaticOrder S; S.init(M, D, F.G, (int)blockIdx.x);
            if (fuse_final) { EpiFinal E{xb, resid, ssb, args.in[3], bar}; pg8::gemm_phase<EpiFinal, pg8::StaticOrder, true>(F.lds, g, S, E); }
            else { pg8::EpiRes<false> E{nullptr, xb, ssb, nullptr}; pg8::gemm_phase<pg8::EpiRes<false>, pg8::StaticOrder, true>(F.lds, g, S, E); }
        }
        if (fuse_final) { fused_done = true; break; }
        SEAM(pb + 1);
        if (layer == 0) {
            bf16* qb_ = big; bf16* kb_ = big + (size_t)M * D; bf16* vb_ = big + 2 * (size_t)M * D;
            if (IN(6)) {
                pg8::Gemm g{xb, (const bf16*)(ws + WS_WQKV), M, 3 * D, D, D, D, 0};
                pg8::StaticOrder S; S.init(M, 3 * D, F.G, (int)blockIdx.x);
                pg8::Unit u0; const pg8::RsTab rt = fill_rstd_tab(F.lds, ssb, S.next(0, u0) ? u0.pm : 0);
                pg8::EpiQKV E{qb_, ssb, (const float*)(ws + WS_ROPE), rt};
                pg8::gemm_phase<pg8::EpiQKV, pg8::StaticOrder, true>(F.lds, g, S, E);
            }
            SEAM(6);
            if (IN(7)) {
                const int ipw = (1024 + F.G - 1) / F.G;
                const int it0 = F.vcu * ipw, nit = it0 >= 1024 ? 0 : (1024 - it0 < ipw ? 1024 - it0 : ipw);
                att::attn_phase(it0, nit, qb_, kb_, vb_, zo, (float*)(ws + WS_LSE), F.lds);
            }
            SEAM(7);
            const bool merge_fused = one_launch && IN(8) && IN(9) && (F.G == (M / 256) * (D / 256));
            if (IN(8) && !merge_fused) {
                int tid8 = threadIdx.x; asm volatile("" : "+v"(tid8)); const int lane8 = tid8 & 63, wave8 = __builtin_amdgcn_readfirstlane(tid8 >> 6);
                const float* lse = (const float*)(ws + WS_LSE);
                for (int m = F.vcu * NWAVES + wave8; m < M; m += F.G * NWAVES) {
                    float L[16];
#pragma unroll
                    for (int q4 = 0; q4 < 4; ++q4) { const f32x4 v = *(const GAS f32x4*)(lse + (size_t)m * 16 + 4 * q4); L[4 * q4] = v[0]; L[4 * q4 + 1] = v[1]; L[4 * q4 + 2] = v[2]; L[4 * q4 + 3] = v[3]; }
                    float lg[3];
                    { float mx = L[0];
_Pragma("unroll") for (int i = 1; i < 6; ++i) mx = fmaxf(mx, L[i]); float s = 0.f;
_Pragma("unroll") for (int i = 0; i < 6; ++i) s += __expf(L[i] - mx); lg[0] = mx + __logf(s) - 1.791759469228055f; }
                    { float mx = L[6];
_Pragma("unroll") for (int i = 7; i < 11; ++i) mx = fmaxf(mx, L[i]); float s = 0.f;
_Pragma("unroll") for (int i = 6; i < 11; ++i) s += __expf(L[i] - mx); lg[1] = mx + __logf(s) - 1.6094379124341003f; }
                    { float mx = L[11];
_Pragma("unroll") for (int i = 12; i < 16; ++i) mx = fmaxf(mx, L[i]); float s = 0.f;
_Pragma("unroll") for (int i = 11; i < 16; ++i) s += __expf(L[i] - mx); lg[2] = mx + __logf(s) - 1.6094379124341003f; }
                    const float mx = fmaxf(lg[0], fmaxf(lg[1], lg[2]));
                    const float e0 = __expf(lg[0] - mx), e1 = __expf(lg[1] - mx), e2 = __expf(lg[2] - mx); const float is = 3.0f / (e0 + e1 + e2);
                    const int head = lane8 >> 2; const float sc = (head < 6 ? e0 : (head < 11 ? e1 : e2)) * is;
                    GAS v4u* p = (GAS v4u*)(zo + (size_t)m * D + 16 * lane8);
#pragma unroll
                    for (int q2 = 0; q2 < 2; ++q2) { v4u w = p[q2];
                        w.x = pk2(bflo(w.x) * sc, bfhi(w.x) * sc); w.y = pk2(bflo(w.y) * sc, bfhi(w.y) * sc); w.z = pk2(bflo(w.z) * sc, bfhi(w.z) * sc); w.w = pk2(bflo(w.w) * sc, bfhi(w.w) * sc);
                        p[q2] = w; }
                }
            }
            if (!merge_fused) SEAM(8);
            if (IN(9)) {
                pg8::Gemm g{zo, (const bf16*)(ws + WS_WAO), M, D, D, D, D, 0};
                pg8::StaticOrder S; S.init(M, D, F.G, (int)blockIdx.x);
                if (merge_fused) { pg8::Unit u0; const LAS float* st = seg_fill(F.lds, (const float*)(ws + WS_LSE), S.next(0, u0) ? u0.pm : 0);
                    pg8::EpiRes<false, true> E{nullptr, xb, ssb, st + 512};
                    pg8::gemm_phase<pg8::EpiRes<false, true>, pg8::StaticOrder, true, true>(F.lds, g, S, E, st); }
                else { pg8::EpiRes<false> E{nullptr, xb, ssb, nullptr};
                    pg8::gemm_phase<pg8::EpiRes<false>, pg8::StaticOrder, true>(F.lds, g, S, E); }
            }
            SEAM(9);
        }
    }
    if (IN(12) && !fused_done) {
        const float* gf = args.in[3];
        int tid12 = threadIdx.x; asm volatile("" : "+v"(tid12)); const int lane12 = tid12 & 63, wave12 = __builtin_amdgcn_readfirstlane(tid12 >> 6);
        for (int m = F.vcu * NWAVES + wave12; m < M; m += F.G * NWAVES) {
            float s = 0.f;
#pragma unroll
            for (int q4 = 0; q4 < 4; ++q4) { const f32x4 v = *(const GAS f32x4*)(ssb + (size_t)m * 16 + 4 * q4); s += (v[0] + v[1]) + (v[2] + v[3]); }
            const float rstd = rsqrtf(s * (1.0f / D) + 1e-6f);
            const GAS v4u* xr = (const GAS v4u*)(xb + (size_t)m * D + 16 * lane12);
            GAS f32x4* orow = (GAS f32x4*)(resid + (size_t)m * D + 16 * lane12);
#pragma unroll
            for (int q2 = 0; q2 < 2; ++q2) { const v4u w = xr[q2]; const GAS f32x4* gq = (const GAS f32x4*)(gf + 16 * lane12 + 8 * q2);
                orow[2 * q2] = (f32x4){bflo(w.x), bfhi(w.x), bflo(w.y), bfhi(w.y)} * rstd * gq[0];
                orow[2 * q2 + 1] = (f32x4){bflo(w.z), bfhi(w.z), bflo(w.w), bfhi(w.w)} * rstd * gq[1]; }
        }
    }
#undef IN
#undef SEAM
}

extern "C" void kernel_launch(void* const* d_in, const int* in_sizes, int n_in, void* d_out, int out_size, void* d_ws, size_t ws_size, hipStream_t stream) {
    static int grid = 0;
    if (grid == 0) {
        if (n_in != 13 || in_sizes[0] != M * D || out_size != M * D || ws_size < WS_END) { fprintf(stderr, "kernel_launch: unexpected shapes (n_in %d, in0 %d, out %d, ws %zu); nothing launched\n", n_in, n_in > 0 ? in_sizes[0] : -1, out_size, ws_size); grid = -1; return; }
        int dev = 0, cus = 0, per_cu = 0;
        if (hipGetDevice(&dev) != hipSuccess || hipDeviceGetAttribute(&cus, hipDeviceAttributeMultiprocessorCount, dev) != hipSuccess) { grid = -1; return; }
        if (hipFuncSetAttribute((const void*)fwd_megakernel, hipFuncAttributeMaxDynamicSharedMemorySize, LDS_BYTES) != hipSuccess) { fprintf(stderr, "kernel_launch: hipFuncSetAttribute failed\n"); grid = -1; return; }
        if (hipOccupancyMaxActiveBlocksPerMultiprocessor(&per_cu, (const void*)fwd_megakernel, NWAVES * 64, LDS_BYTES) != hipSuccess || per_cu < 1) { fprintf(stderr, "kernel_launch: occupancy query says %d blocks per CU\n", per_cu); per_cu = 1; }
        (void)hipGetLastError();
        grid = cus;
    }
    if (grid < 0) return;
    if (hipMemsetAsync((char*)d_ws + WS_CTL, 0, CTL_ZERO_BYTES, stream) != hipSuccess) { fprintf(stderr, "kernel_launch: memset failed\n"); return; }
    Args a{};
    for (int i = 0; i < 13; ++i) a.in[i] = (const float*)d_in[i];
    a.out = (float*)d_out; a.ws = (unsigned char*)d_ws;
#if MK_N_LAUNCHES == 1
    a.ph_lo = 0; a.ph_hi = 13;
    void* kargs[] = {&a};
    hipError_t e = hipLaunchCooperativeKernel((const void*)fwd_megakernel, dim3(grid), dim3(NWAVES * 64), kargs, LDS_BYTES, stream);
    if (e != hipSuccess) fprintf(stderr, "kernel_launch: cooperative launch failed: %s (grid %d)\n", hipGetErrorString(e), grid);
#else
    for (int p = 0; p < 13; ++p) { a.ph_lo = p; a.ph_hi = p + 1; hipLaunchKernelGGL(fwd_megakernel, dim3(grid), dim3(NWAVES * 64), LDS_BYTES, stream, a); }
#endif
}
```

```cpp
#include <hip/hip_runtime.h>
#include <hip/hip_cooperative_groups.h>
#include <cstdio>
#include <cstdint>
namespace cg = cooperative_groups;

#ifndef MK_N_LAUNCHES
#define MK_N_LAUNCHES 1
#endif

namespace pg8 {
#define PG8_LAS __attribute__((address_space(3)))
typedef unsigned short bf16_t;
typedef short bf16x8 __attribute__((ext_vector_type(8)));
typedef float f32x4 __attribute__((ext_vector_type(4)));
typedef unsigned u32x4 __attribute__((ext_vector_type(4)));
constexpr int BM = 256, BK = 64, HALF = 128, HTB = HALF * BK * 2, STAGE_BYTES = 8 * HTB, NXCD = 8, WGM = 8;

__host__ __device__ __forceinline__ int lds_byte(int r, int c) { const int st = (r >> 4) * 2 + (c >> 5), rr = r & 15, cc = c & 31, ob = rr * 64 + cc * 2; return st * 1024 + (ob ^ (((ob >> 9) & 1) << 5)); }
__host__ __device__ __forceinline__ void stage_rc(int b, int& R, int& C) { const int st = b / 1024, sb = b % 1024, swz = sb ^ (((sb >> 9) & 1) << 5); R = (st >> 1) * 16 + swz / 64; C = (st & 1) * 32 + (swz % 64) / 2; }
__host__ __device__ __forceinline__ int perm32(int rho) { const int n = rho >> 4, i = rho & 15; return 8 * (i >> 2) + 4 * n + (i & 3); }

struct Unit { int pm, pn; };
struct Gemm { const bf16_t* A; const bf16_t* Bt; int M, N, K, lda, ldb; size_t a_pn_bytes; };

struct StaticOrder {
    int nM, nN, nwg, G, c;
    __host__ __device__ void init(int M, int N, int G_, int c_) { nM = M / BM; nN = N / BM; nwg = nM * nN; G = G_; c = c_; }
    __host__ __device__ bool next(int i, Unit& u) const {
        const long L = (long)i * G + c; if (L >= nwg) return false;
        int wgid = (int)L; { const int q = nwg / NXCD, r = nwg % NXCD, xcd = wgid % NXCD, off = wgid / NXCD; wgid = (xcd < r ? xcd * (q + 1) : r * (q + 1) + (xcd - r) * q) + off; }
        const int nig = WGM * nN, gid = wgid / nig, fm = gid * WGM, gsz = (nM - fm) < WGM ? (nM - fm) : WGM;
        u.pm = fm + ((wgid % nig) % gsz); u.pn = (wgid % nig) / gsz; return true;
    }
};

__device__ __forceinline__ unsigned cvt_pk_bf16(float lo, float hi) { unsigned r; asm volatile("v_cvt_pk_bf16_f32 %0, %1, %2" : "=v"(r) : "v"(lo), "v"(hi)); return r; }

constexpr float RMS_EPS = 1e-6f;

struct EpiBf16 {
    bf16_t* O; int ldc;
    __device__ __forceinline__ void operator()(const f32x4 (&acc)[2][2][4][2], const Unit& u, int wr, int wc, int fr, int fq) const {
        const int row0 = u.pm * BM + wr * 64 + fr, col0 = u.pn * BM + wc * 32 + 8 * fq;
#pragma unroll
        for (int ai = 0; ai < 2; ++ai)
#pragma unroll
            for (int m = 0; m < 4; ++m) { bf16_t* rowp = O + (size_t)(row0 + ai * HALF + m * 16) * ldc + col0;
#pragma unroll
                for (int bj = 0; bj < 2; ++bj) { const f32x4 v0 = acc[ai][bj][m][0], v1 = acc[ai][bj][m][1];
                    u32x4 w; w.x = cvt_pk_bf16(v0[0], v0[1]); w.y = cvt_pk_bf16(v0[2], v0[3]); w.z = cvt_pk_bf16(v1[0], v1[1]); w.w = cvt_pk_bf16(v1[2], v1[3]);
                    *(u32x4*)(rowp + bj * HALF) = w; } }
    }
};
__device__ __forceinline__ float bf_lo(unsigned w) { return __builtin_bit_cast(float, w << 16); }
__device__ __forceinline__ float bf_hi(unsigned w) { return __builtin_bit_cast(float, w & 0xffff0000u); }
template <bool BASE_F32, bool SCALE = false> struct EpiRes {
    const float* basef; bf16_t* xb; float* ss; const PG8_LAS float* ctab;
    __device__ __forceinline__ void load_base(int row, int col0, f32x4 (&nb)[4]) const {
        if (BASE_F32) { const float* bp = basef + (size_t)row * 1024 + col0; nb[0] = *(const f32x4*)(bp); nb[1] = *(const f32x4*)(bp + 4); nb[2] = *(const f32x4*)(bp + HALF); nb[3] = *(const f32x4*)(bp + HALF + 4); }
        else { const bf16_t* bp = xb + (size_t)row * 1024 + col0; const u32x4 a = *(const u32x4*)(bp), c = *(const u32x4*)(bp + HALF);
            nb[0] = (f32x4){bf_lo(a.x), bf_hi(a.x), bf_lo(a.y), bf_hi(a.y)}; nb[1] = (f32x4){bf_lo(a.z), bf_hi(a.z), bf_lo(a.w), bf_hi(a.w)};
            nb[2] = (f32x4){bf_lo(c.x), bf_hi(c.x), bf_lo(c.y), bf_hi(c.y)}; nb[3] = (f32x4){bf_lo(c.z), bf_hi(c.z), bf_lo(c.w), bf_hi(c.w)}; }
    }
    __device__ __forceinline__ void operator()(const f32x4 (&acc)[2][2][4][2], const Unit& u, int wr, int wc, int fr, int fq) const {
        const int row0 = u.pm * BM + wr * 64 + fr, col0 = u.pn * BM + wc * 32 + 8 * fq;
        f32x4 nb[4];
        load_base(row0, col0, nb);
#pragma unroll
        for (int it = 0; it < 8; ++it) { const int ai = it >> 2, m = it & 3;
            const size_t row = (size_t)(row0 + ai * HALF + m * 16); const size_t off = row * 1024 + col0; float s = 0.f;
            const f32x4 b0 = nb[0], b1 = nb[1], b2 = nb[2], b3 = nb[3];
            if (it < 7) load_base(row0 + ((it + 1) >> 2) * HALF + ((it + 1) & 3) * 16, col0, nb);
            const float cs = SCALE ? ctab[wr * 64 + fr + ai * HALF + m * 16] : 1.0f;
#pragma unroll
            for (int bj = 0; bj < 2; ++bj) {
                const f32x4 v0 = acc[ai][bj][m][0] * cs + (bj == 0 ? b0 : b2), v1 = acc[ai][bj][m][1] * cs + (bj == 0 ? b1 : b3);
                s += (v0[0] * v0[0] + v0[1] * v0[1]) + (v0[2] * v0[2] + v0[3] * v0[3]) + (v1[0] * v1[0] + v1[1] * v1[1]) + (v1[2] * v1[2] + v1[3] * v1[3]);
                u32x4 w; w.x = cvt_pk_bf16(v0[0], v0[1]); w.y = cvt_pk_bf16(v0[2], v0[3]); w.z = cvt_pk_bf16(v1[0], v1[1]); w.w = cvt_pk_bf16(v1[2], v1[3]);
                *(u32x4*)(xb + off + bj * HALF) = w; }
            s += __shfl_xor(s, 16); s += __shfl_xor(s, 32);
            if (fq == 0) ss[row * 16 + u.pn * 4 + wc] = s; }
    }
};
struct RsTab { const PG8_LAS float* tab; int pm; };
__device__ __forceinline__ float row_rstd(const float* ss, size_t row, int fq) {
    const f32x4 p = *(const f32x4*)(ss + row * 16 + 4 * fq); float s = (p[0] + p[1]) + (p[2] + p[3]);
    s += __shfl_xor(s, 16); s += __shfl_xor(s, 32);
    return rsqrtf(s * (1.0f / 1024.0f) + RMS_EPS);
}
struct EpiSwiGLU {
    bf16_t* act; const float* ss; int ldc; RsTab rt;
    __device__ __forceinline__ void operator()(const f32x4 (&acc)[2][2][4][2], const Unit& u, int wr, int wc, int fr, int fq) const {
        const int row0 = u.pm * BM + wr * 64 + fr, col0 = u.pn * HALF + wc * 32 + 8 * fq;
        const bool use_tab = (u.pm == rt.pm);
#pragma unroll
        for (int ai = 0; ai < 2; ++ai)
#pragma unroll
            for (int m = 0; m < 4; ++m) { const size_t row = (size_t)(row0 + ai * HALF + m * 16); float rstd; if (__builtin_expect(use_tab, 1)) rstd = rt.tab[wr * 64 + fr + ai * HALF + m * 16]; else { asm volatile("; rstd from global (grid != 256)" ::: "memory"); rstd = row_rstd(ss, row, fq); }
                float a[8];
#pragma unroll
                for (int n = 0; n < 2; ++n)
#pragma unroll
                    for (int i = 0; i < 4; ++i) { const float g = acc[ai][0][m][n][i] * rstd, up = acc[ai][1][m][n][i] * rstd;
                        a[n * 4 + i] = g * up * __builtin_amdgcn_rcpf(1.0f + __builtin_amdgcn_exp2f(-1.4426950408889634f * g)); }
                u32x4 w; w.x = cvt_pk_bf16(a[0], a[1]); w.y = cvt_pk_bf16(a[2], a[3]); w.z = cvt_pk_bf16(a[4], a[5]); w.w = cvt_pk_bf16(a[6], a[7]);
                *(u32x4*)(act + row * ldc + col0) = w; }
    }
};
struct EpiQKV {
    bf16_t* qkv; const float* ss; const float* rope; RsTab rt;
    __device__ __forceinline__ void operator()(const f32x4 (&acc)[2][2][4][2], const Unit& u, int wr, int wc, int fr, int fq) const {
        const int row0 = u.pm * BM + wr * 64 + fr; const int sect = u.pn >> 2, head = (u.pn & 3) * 4 + wc;
        const int dsh = head < 6 ? 0 : (head < 11 ? 2 : 4);
        bf16_t* dst = qkv + (size_t)sect * ((size_t)16384 * 1024);
        const float qs = sect == 0 ? 0.125f * 1.4426950408889634f : 1.0f;
        const bool use_tab = (u.pm == rt.pm);
        const bool rot = sect < 2;
        f32x4 nr[4];
        if (rot) { const float* rp = rope + (size_t)(row0 & 8191) * 64 + 8 * fq; nr[0] = *(const f32x4*)(rp); nr[1] = *(const f32x4*)(rp + 4); nr[2] = *(const f32x4*)(rp + 32); nr[3] = *(const f32x4*)(rp + 36); }
#pragma unroll
        for (int it = 0; it < 8; ++it) { const int ai = it >> 2, m = it & 3;
            const int row = row0 + ai * HALF + m * 16; float rstd; if (__builtin_expect(use_tab, 1)) rstd = rt.tab[wr * 64 + fr + ai * HALF + m * 16]; else { asm volatile("; rstd from global (grid != 256)" ::: "memory"); rstd = row_rstd(ss, (size_t)row, fq); } rstd *= qs;
            const int b = row >> 13, t = row & 8191; const int pos = ((t & ((1 << dsh) - 1)) << (13 - dsh)) + (t >> dsh);
            bf16_t* o = dst + ((size_t)(b * 16 + head) * 8192 + pos) * 64 + 8 * fq;
            const f32x4 c0 = nr[0], c1 = nr[1], s0 = nr[2], s1 = nr[3];
            if (rot && it < 7) { const int row2 = row0 + ((it + 1) >> 2) * HALF + ((it + 1) & 3) * 16; const float* rp = rope + (size_t)(row2 & 8191) * 64 + 8 * fq;
                nr[0] = *(const f32x4*)(rp); nr[1] = *(const f32x4*)(rp + 4); nr[2] = *(const f32x4*)(rp + 32); nr[3] = *(const f32x4*)(rp + 36); }
            float lo[8], hi[8];
#pragma unroll
            for (int n = 0; n < 2; ++n)
#pragma unroll
                for (int i = 0; i < 4; ++i) { lo[n * 4 + i] = acc[ai][0][m][n][i] * rstd; hi[n * 4 + i] = acc[ai][1][m][n][i] * rstd; }
            if (rot) {
#pragma unroll
                for (int i = 0; i < 8; ++i) { const float cs = i < 4 ? c0[i & 3] : c1[i & 3], sn = i < 4 ? s0[i & 3] : s1[i & 3];
                    const float l = lo[i], h = hi[i]; lo[i] = l * cs - h * sn; hi[i] = h * cs + l * sn; }
            }
            u32x4 w; w.x = cvt_pk_bf16(lo[0], lo[1]); w.y = cvt_pk_bf16(lo[2], lo[3]); w.z = cvt_pk_bf16(lo[4], lo[5]); w.w = cvt_pk_bf16(lo[6], lo[7]);
            *(u32x4*)(o) = w;
            w.x = cvt_pk_bf16(hi[0], hi[1]); w.y = cvt_pk_bf16(hi[2], hi[3]); w.z = cvt_pk_bf16(hi[4], hi[5]); w.w = cvt_pk_bf16(hi[6], hi[7]);
            *(u32x4*)(o + 32) = w; }
    }
};

template <class Epi, class Sched, bool ALIGN_EPI, bool SEG = false, bool AFTER_DRAIN = false>
__device__ __forceinline__ void gemm_phase(PG8_LAS unsigned char* lds, const Gemm g, const Sched& S, const Epi& E, const PG8_LAS float* segtab = nullptr) {
    int tid = threadIdx.x; asm volatile("" : "+v"(tid));
    const int wid = __builtin_amdgcn_readfirstlane(tid >> 6), lane = tid & 63, wr = wid >> 2, wc = wid & 3, fr = lane & 15, fq = lane >> 4;
    const int K = g.K, nt = K / BK;
    unsigned voffA[2], voffB[2];
#pragma unroll
    for (int i = 0; i < 2; ++i) { int R, C; stage_rc(tid * 16 + i * 8192, R, C); const int Rb = (R & ~31) + perm32(R & 31);
        voffA[i] = (unsigned)(R * g.lda + C) * 2u; voffB[i] = (unsigned)(Rb * g.ldb + C) * 2u; }
    const size_t kstep = (size_t)(BK * 2);
    const size_t hstepA = (size_t)HALF * g.lda * 2, hstepB = (size_t)HALF * g.ldb * 2;
    const size_t tstepA = 2 * hstepA, tstepB = 2 * hstepB;
    const unsigned ldsw = (unsigned)wid * 1024u;
    const int aoff = lds_byte(wr * 64 + fr, fq * 8), boff = lds_byte(wc * 32 + fr, fq * 8);
#define PG8_SA(b, h) (((b) * 2 + (h)) * HTB)
#define PG8_SB(b, h) ((4 + (b) * 2 + (h)) * HTB)
#define PG8_STAGE(bufoff, gbase, voff) do { _Pragma("unroll") for (int _i = 0; _i < 2; ++_i) \
        __builtin_amdgcn_global_load_lds((const unsigned*)((const char*)(gbase) + (voff)[_i]), (PG8_LAS unsigned*)(lds + (bufoff) + ldsw + _i * 8192), 16, 0, 0); } while (0)
#define PG8_LDA(dst, b, h) do { _Pragma("unroll") for (int m = 0; m < 4; ++m) _Pragma("unroll") for (int k = 0; k < 2; ++k) dst[m][k] = *(const PG8_LAS bf16x8*)(lds + PG8_SA(b, h) + aoff + m * 2048 + k * 1024); } while (0)
#define PG8_LDB(dst, b, h) do { _Pragma("unroll") for (int n = 0; n < 2; ++n) _Pragma("unroll") for (int k = 0; k < 2; ++k) dst[n][k] = *(const PG8_LAS bf16x8*)(lds + PG8_SB(b, h) + boff + n * 2048 + k * 1024); } while (0)
#define PG8_MMA(ai, bj, At, Bt) do { __builtin_amdgcn_s_setprio(1); _Pragma("unroll") for (int m = 0; m < 4; ++m) _Pragma("unroll") for (int n = 0; n < 2; ++n) _Pragma("unroll") for (int k = 0; k < 2; ++k) \
        acc[ai][bj][m][n] = __builtin_amdgcn_mfma_f32_16x16x32_bf16(Bt[n][k], At[m][k], acc[ai][bj][m][n], 0, 0, 0); __builtin_amdgcn_s_setprio(0); } while (0)
#define PG8_SEGSCALE(tb) do { _Pragma("unroll") for (int ai = 0; ai < 2; ++ai) _Pragma("unroll") for (int m = 0; m < 4; ++m) { const float f_ = (tb)[wr * 64 + fr + ai * HALF + m * 16]; \
        _Pragma("unroll") for (int bj = 0; bj < 2; ++bj) _Pragma("unroll") for (int n = 0; n < 2; ++n) acc[ai][bj][m][n] = acc[ai][bj][m][n] * f_; } } while (0)
#define PG8_WAIT_V(n) asm volatile("s_waitcnt vmcnt(" #n ")" ::: "memory")
#define PG8_WAIT_L(n) asm volatile("s_waitcnt lgkmcnt(" #n ")" ::: "memory")
#define PG8_BAR __builtin_amdgcn_s_barrier()
#define PG8_SCHED __builtin_amdgcn_sched_barrier(0)
    Unit cur, nxt; int ui = 0;
    if (!S.next(0, cur)) return;
    f32x4 acc[2][2][4][2];
#pragma unroll
    for (int a = 0; a < 2; ++a)
#pragma unroll
        for (int b = 0; b < 2; ++b)
#pragma unroll
            for (int m = 0; m < 4; ++m)
#pragma unroll
                for (int n = 0; n < 2; ++n) acc[a][b][m][n] = (f32x4){0.f, 0.f, 0.f, 0.f};
    bf16x8 At[4][2], B0[2][2], B1[2][2];
    const char* cA = (const char*)g.A + (size_t)cur.pm * tstepA + (size_t)cur.pn * g.a_pn_bytes; const char* cB = (const char*)g.Bt + (size_t)cur.pn * tstepB;
    PG8_STAGE(PG8_SB(0, 0), cB, voffB); PG8_STAGE(PG8_SB(0, 1), cB + hstepB, voffB); PG8_STAGE(PG8_SA(0, 0), cA, voffA); PG8_STAGE(PG8_SA(0, 1), cA + hstepA, voffA);
    if (wr == 1) PG8_BAR;
    PG8_WAIT_V(2); PG8_BAR;
    PG8_STAGE(PG8_SB(1, 0), cB + kstep, voffB); PG8_STAGE(PG8_SA(1, 0), cA + kstep, voffA); PG8_STAGE(PG8_SB(1, 1), cB + hstepB + kstep, voffB);
    PG8_WAIT_V(6); PG8_BAR;
    for (;;) {
        const bool has_next = S.next(ui + 1, nxt);
        const char* nA = has_next ? (const char*)g.A + (size_t)nxt.pm * tstepA + (size_t)nxt.pn * g.a_pn_bytes : cA; const char* nB = has_next ? (const char*)g.Bt + (size_t)nxt.pn * tstepB : cB;
        for (int t = 0; t < nt; t += 2) {
            const bool last = (t == nt - 2);
            const char* a1 = cA + (size_t)(t + 1) * kstep;
            const char* a2 = last ? nA : cA + (size_t)(t + 2) * kstep; const char* b2 = last ? nB : cB + (size_t)(t + 2) * kstep;
            const char* a3 = a2 + kstep; const char* b3 = b2 + kstep;
            if constexpr (SEG) { if (t == 6) PG8_SEGSCALE(segtab); }
            PG8_LDB(B0, 0, 0); PG8_LDB(B1, 0, 1); PG8_SCHED; PG8_LDA(At, 0, 0); PG8_STAGE(PG8_SA(1, 1), a1 + hstepA, voffA);
            PG8_WAIT_V(8); PG8_WAIT_L(0); PG8_BAR; PG8_MMA(0, 0, At, B0); PG8_MMA(0, 1, At, B1); PG8_BAR; PG8_SCHED;
            PG8_LDA(At, 0, 1); PG8_STAGE(PG8_SB(0, 0), b2, voffB); PG8_STAGE(PG8_SB(0, 1), b2 + hstepB, voffB); PG8_STAGE(PG8_SA(0, 0), a2, voffA);
            PG8_WAIT_V(8); PG8_WAIT_L(0); PG8_BAR; PG8_MMA(1, 0, At, B0); PG8_MMA(1, 1, At, B1); PG8_BAR; PG8_SCHED;
            if constexpr (SEG) { if (t == 10) PG8_SEGSCALE(segtab + 256); }
            PG8_LDB(B0, 1, 0); PG8_LDB(B1, 1, 1); PG8_SCHED; PG8_LDA(At, 1, 0); PG8_STAGE(PG8_SA(0, 1), a2 + hstepA, voffA);
            PG8_WAIT_V(8); PG8_WAIT_L(0); PG8_BAR; PG8_MMA(0, 0, At, B0); PG8_MMA(0, 1, At, B1); PG8_BAR; PG8_SCHED;
            PG8_LDA(At, 1, 1); PG8_STAGE(PG8_SB(1, 0), b3, voffB); PG8_STAGE(PG8_SB(1, 1), b3 + hstepB, voffB); PG8_STAGE(PG8_SA(1, 0), a3, voffA);
            PG8_WAIT_V(8); PG8_WAIT_L(0); PG8_BAR; PG8_MMA(1, 0, At, B0); PG8_MMA(1, 1, At, B1); PG8_BAR; PG8_SCHED;
        }
        if constexpr (ALIGN_EPI) { if (wr == 0) PG8_BAR; }
        if constexpr (!AFTER_DRAIN) E(acc, cur, wr, wc, fr, fq);
        if (!has_next) break;
#pragma unroll
        for (int a = 0; a < 2; ++a)
#pragma unroll
            for (int b = 0; b < 2; ++b)
#pragma unroll
                for (int m = 0; m < 4; ++m)
#pragma unroll
                    for (int n = 0; n < 2; ++n) acc[a][b][m][n] = (f32x4){0.f, 0.f, 0.f, 0.f};
        cur = nxt; cA = nA; cB = nB; ++ui;
        if constexpr (ALIGN_EPI) { if (wr == 1) PG8_BAR; }
    }
    PG8_WAIT_V(0);
    if constexpr (!ALIGN_EPI) { if (wr == 0) PG8_BAR; }
    PG8_BAR;
    if constexpr (AFTER_DRAIN) E(acc, cur, wr, wc, fr, fq);
#undef PG8_SA
#undef PG8_SB
#undef PG8_STAGE
#undef PG8_LDA
#undef PG8_LDB
#undef PG8_MMA
#undef PG8_WAIT_V
#undef PG8_SEGSCALE
#undef PG8_WAIT_L
#undef PG8_BAR
#undef PG8_SCHED
}
}

constexpr int NWAVES = 8;
constexpr int BATCH = 2, SEQ = 8192, D = 1024, H = 16, HD = 64, FF = 2816;
constexpr int M = BATCH * SEQ;
constexpr size_t MiB = 1u << 20;
constexpr size_t WS_CTL = 0, CTL_ZERO_BYTES = 128 * 1024;
constexpr int CW_HALO = 8192;
constexpr size_t WS_ROPE = 1 * MiB;
constexpr size_t WS_SS = 3 * MiB;
constexpr size_t WS_LSE = 4 * MiB;
constexpr size_t WS_WIN = 6 * MiB;
constexpr size_t WS_WG = 8 * MiB;
constexpr size_t WS_WPO = 9 * MiB;
constexpr size_t WS_WGU0 = 11 * MiB;
constexpr size_t WS_WD0 = 22 * MiB;
constexpr size_t WS_WQKV = 28 * MiB;
constexpr size_t WS_WAO = 34 * MiB;
constexpr size_t WS_WGU1 = 36 * MiB;
constexpr size_t WS_WD1 = 47 * MiB;
constexpr size_t WS_BIG = 56 * MiB;
constexpr size_t WS_XB = 184 * MiB;
constexpr size_t WS_ZO = 216 * MiB;
constexpr size_t WS_HALO = 248 * MiB;
constexpr size_t WS_END = 250 * MiB;
constexpr int CW_BAR = 1024;

constexpr int LDS_BYTES = 147456;

#define GAS __attribute__((address_space(1)))
#define LAS __attribute__((address_space(3)))
typedef unsigned short bf16;
typedef unsigned v4u __attribute__((ext_vector_type(4)));
typedef unsigned v2u __attribute__((ext_vector_type(2)));
typedef float f32x4 __attribute__((ext_vector_type(4)));
#define LDS_WAIT() asm volatile("s_waitcnt lgkmcnt(0)" ::: "memory")
__device__ __forceinline__ unsigned f2bf(float f) { unsigned u = __builtin_bit_cast(unsigned, f); return (u + 0x7fffu + ((u >> 16) & 1u)) >> 16; }
__device__ __forceinline__ unsigned pk2(float lo, float hi) { return pg8::cvt_pk_bf16(lo, hi); }
__device__ __forceinline__ float bflo(unsigned w) { return __builtin_bit_cast(float, w << 16); }
__device__ __forceinline__ float bfhi(unsigned w) { return __builtin_bit_cast(float, w & 0xffff0000u); }

#define XB_TMO      128
#define XB_XCNT(j)  (256  + 64 * (j))
#define XB_XSUB(j)  (1280 + 64 * (j))
#define XB_XGEN(j)  (2304 + 64 * (j))
#define XB_TOP      3328
#define XB_TOPGEN   3392
#define XCD_BAR_WORDS 3456
#define XB_SPIN_CAP (1u << 22)
__device__ __forceinline__ unsigned xb_ld(unsigned* p)              { return __hip_atomic_load(p, __ATOMIC_RELAXED, __HIP_MEMORY_SCOPE_AGENT); }
__device__ __forceinline__ unsigned xb_add(unsigned* p, unsigned v) { return __hip_atomic_fetch_add(p, v, __ATOMIC_RELAXED, __HIP_MEMORY_SCOPE_AGENT); }
__device__ __forceinline__ unsigned xb_xcc_id() { return (unsigned)__builtin_amdgcn_s_getreg((3 << 11) | 20) & 0xFu; }
#define XB_SPIN(cond, bar) do { unsigned _sp = 0; while (cond) { __builtin_amdgcn_s_sleep(1); \
    if ((++_sp & 255u) == 0u) { if (xb_ld(&(bar)[XB_TMO])) break; if (_sp > XB_SPIN_CAP) { atomicAdd(&(bar)[XB_TMO], 1u); break; } } } } while (0)
struct XcdBarrier { unsigned* bar; unsigned x; volatile LAS unsigned* st; };
__device__ __forceinline__ XcdBarrier xcd_barrier_post(unsigned* bar, volatile LAS unsigned* st) {
    XcdBarrier b; b.bar = bar; b.x = xb_xcc_id(); b.st = st;
    if (threadIdx.x == 0) (void)xb_add(&bar[XB_XCNT(b.x)], 1u);
    return b;
}
__device__ __forceinline__ void xcd_barrier_complete(unsigned* bar, unsigned x, unsigned& nloc, unsigned& nx) {
    const unsigned G = gridDim.x * gridDim.y * gridDim.z;
    unsigned sum, cnt, mine, sp = 0u;
    for (;;) {
        sum = 0u; cnt = 0u; mine = 0u;
#pragma unroll
        for (unsigned j = 0; j < 16; ++j) { const unsigned c = xb_ld(&bar[XB_XCNT(j)]); sum += c; cnt += (c > 0u) ? 1u : 0u; mine = (j == x) ? c : mine; }
        if (sum == G) break;
        __builtin_amdgcn_s_sleep(1);
        if ((++sp & 255u) == 0u) { if (xb_ld(&bar[XB_TMO])) break; if (sp > XB_SPIN_CAP) { atomicAdd(&bar[XB_TMO], 1u); break; } }
    }
    nloc = mine > 0u ? mine : 1u; nx = cnt > 0u ? cnt : 1u;
}
__device__ __forceinline__ void xcd_barrier(const XcdBarrier& b) {
    asm volatile("s_waitcnt vmcnt(0)" ::: "memory");
    __syncthreads();
    if (threadIdx.x == 0) {
        unsigned* bar = b.bar;
        __builtin_amdgcn_s_waitcnt(0);
        unsigned nloc = b.st[0], nx = b.st[1];
        if (nloc == 0u) { xcd_barrier_complete(bar, b.x, nloc, nx); b.st[0] = nloc; b.st[1] = nx; }
        const unsigned old = xb_add(&bar[XB_XSUB(b.x)], 1u);
        const unsigned gen = old / nloc;
        if (old + 1u == (gen + 1u) * nloc) {
            __builtin_amdgcn_fence(__ATOMIC_RELEASE, "agent");
            asm volatile("s_waitcnt vmcnt(0)" ::: "memory");
            const unsigned og = xb_add(&bar[XB_TOP], 1u);
            const unsigned tg = og / nx;
            if (og + 1u == (tg + 1u) * nx) xb_add(&bar[XB_TOPGEN], 1u);
            else XB_SPIN(xb_ld(&bar[XB_TOPGEN]) == tg, bar);
            __builtin_amdgcn_fence(__ATOMIC_ACQUIRE, "agent");
            xb_add(&bar[XB_XGEN(b.x)], 1u);
            asm volatile("s_waitcnt vmcnt(0)" ::: "memory");
        } else {
            XB_SPIN(xb_ld(&bar[XB_XGEN(b.x)]) == gen, bar);
            __builtin_amdgcn_fence(__ATOMIC_ACQUIRE, "agent");
            asm volatile("s_waitcnt vmcnt(0)" ::: "memory");
        }
    }
    __syncthreads();
}

struct EpiFinal {
    const bf16* xb; float* out; float* ss; const float* gf; XcdBarrier bar;
    __device__ __forceinline__ void load_base(int row, int col0, pg8::f32x4 (&nb)[4]) const {
        using pg8::f32x4; using pg8::u32x4; using pg8::bf_lo; using pg8::bf_hi;
        const bf16* bp = xb + (size_t)row * 1024 + col0; const u32x4 a = *(const u32x4*)(bp), c = *(const u32x4*)(bp + pg8::HALF);
        nb[0] = (f32x4){bf_lo(a.x), bf_hi(a.x), bf_lo(a.y), bf_hi(a.y)}; nb[1] = (f32x4){bf_lo(a.z), bf_hi(a.z), bf_lo(a.w), bf_hi(a.w)};
        nb[2] = (f32x4){bf_lo(c.x), bf_hi(c.x), bf_lo(c.y), bf_hi(c.y)}; nb[3] = (f32x4){bf_lo(c.z), bf_hi(c.z), bf_lo(c.w), bf_hi(c.w)};
    }
    __device__ __forceinline__ void operator()(pg8::f32x4 (&acc)[2][2][4][2], const pg8::Unit& u, int wr, int wc, int fr, int fq) const {
        using pg8::f32x4; using pg8::HALF; using pg8::BM;
        const int row0 = u.pm * BM + wr * 64 + fr, col0 = u.pn * BM + wc * 32 + 8 * fq;
        f32x4 nb[4];
        load_base(row0, col0, nb);
#pragma unroll
        for (int it = 0; it < 8; ++it) { const int ai = it >> 2, m = it & 3;
            const size_t row = (size_t)(row0 + ai * HALF + m * 16); float s = 0.f;
            const f32x4 b0 = nb[0], b1 = nb[1], b2 = nb[2], b3 = nb[3];
            if (it < 7) load_base(row0 + ((it + 1) >> 2) * HALF + ((it + 1) & 3) * 16, col0, nb);
#pragma unroll
            for (int bj = 0; bj < 2; ++bj) {
                const f32x4 v0 = acc[ai][bj][m][0] + (bj == 0 ? b0 : b2), v1 = acc[ai][bj][m][1] + (bj == 0 ? b1 : b3);
                acc[ai][bj][m][0] = v0; acc[ai][bj][m][1] = v1;
                s += (v0[0] * v0[0] + v0[1] * v0[1]) + (v0[2] * v0[2] + v0[3] * v0[3]) + (v1[0] * v1[0] + v1[1] * v1[1]) + (v1[2] * v1[2] + v1[3] * v1[3]); }
            s += __shfl_xor(s, 16); s += __shfl_xor(s, 32);
            if (fq == 0) ss[row * 16 + u.pn * 4 + wc] = s; }
        xcd_barrier(bar);
        f32x4 gq[2][2];
#pragma unroll
        for (int bj = 0; bj < 2; ++bj)
#pragma unroll
            for (int n = 0; n < 2; ++n) gq[bj][n] = *(const f32x4*)(gf + col0 + bj * HALF + 4 * n);
        f32x4 pr[8];
#pragma unroll
        for (int it = 0; it < 8; ++it) pr[it] = *(const f32x4*)(ss + (size_t)(row0 + (it >> 2) * HALF + (it & 3) * 16) * 16 + 4 * fq);
#pragma unroll
        for (int it = 0; it < 8; ++it) { const int ai = it >> 2, m = it & 3;
            const size_t row = (size_t)(row0 + ai * HALF + m * 16); const size_t off = row * 1024 + col0;
            float sq = (pr[it][0] + pr[it][1]) + (pr[it][2] + pr[it][3]); sq += __shfl_xor(sq, 16); sq += __shfl_xor(sq, 32);
            const float rstd = rsqrtf(sq * (1.0f / 1024.0f) + pg8::RMS_EPS);
#pragma unroll
            for (int bj = 0; bj < 2; ++bj) { *(f32x4*)(out + off + bj * HALF) = acc[ai][bj][m][0] * rstd * gq[bj][0]; *(f32x4*)(out + off + bj * HALF + 4) = acc[ai][bj][m][1] * rstd * gq[bj][1]; } }
    }
};

struct EpiPool {
    LAS unsigned char* lds; const bf16* h; const bf16* wt; bf16* p; bf16* hbuf; unsigned* flags; unsigned* tmo;
    static constexpr int PITCH = 528;
    __device__ __forceinline__ void operator()(pg8::f32x4 (&acc)[2][2][4][2], const pg8::Unit& u, int wr, int wc, int fr, int fq) const {
        using pg8::f32x4; using pg8::u32x4; using pg8::bf16x8; using pg8::cvt_pk_bf16;
        int tid = threadIdx.x; asm volatile("" : "+v"(tid)); const int lane = tid & 63; const int wid = __builtin_amdgcn_readfirstlane(tid >> 6);
#pragma unroll
        for (int ai = 0; ai < 2; ++ai)
#pragma unroll
            for (int m = 0; m < 4; ++m) { const int r = ai * 128 + wr * 64 + m * 16 + fr;
#pragma unroll
                for (int bj = 0; bj < 2; ++bj) { const f32x4 v0 = acc[ai][bj][m][0], v1 = acc[ai][bj][m][1];
                    u32x4 w; w.x = cvt_pk_bf16(v0[0], v0[1]); w.y = cvt_pk_bf16(v0[2], v0[3]); w.z = cvt_pk_bf16(v1[0], v1[1]); w.w = cvt_pk_bf16(v1[2], v1[3]);
                    *(LAS u32x4*)(lds + (16 + r) * PITCH + (bj * 128 + wc * 32 + 8 * fq) * 2) = w;
                    if (ai == 1 && m == 3 && wr == 1) {
                        bf16* hp_ = hbuf + ((size_t)(u.pm * 4 + u.pn) * 16 + fr) * 256 + bj * 128 + wc * 32 + 8 * fq;
                        asm volatile("global_store_dwordx4 %0, %1, off sc1\n\ts_nop 1" :: "v"(hp_), "v"(w) : "memory"); } } }
        asm volatile("s_waitcnt vmcnt(0)" ::: "memory");
        __syncthreads();
        if (tid == 0) __hip_atomic_store(flags + (u.pm * 4 + u.pn) * 64, 1u, __ATOMIC_RELAXED, __HIP_MEMORY_SCOPE_AGENT);
        const bool seq_start = (u.pm & 31) == 0;
        if (seq_start) { for (int e = tid; e < 16 * 32; e += 512) *(LAS u32x4*)(lds + (e >> 5) * PITCH + (e & 31) * 16) = (u32x4){0u, 0u, 0u, 0u}; }
        else {
            if (tid == 0) { unsigned* fl = flags + ((u.pm - 1) * 4 + u.pn) * 64; XB_SPIN(xb_ld(fl) == 0u, tmo);
                __builtin_amdgcn_fence(__ATOMIC_ACQUIRE, "agent"); asm volatile("s_waitcnt vmcnt(0)" ::: "memory"); }
            __syncthreads();
            const u32x4 hv = *(const GAS u32x4*)(hbuf + (size_t)((u.pm - 1) * 4 + u.pn) * 4096 + tid * 8);
            *(LAS u32x4*)(lds + (tid >> 5) * PITCH + (tid & 31) * 16) = hv;
        }
        LDS_WAIT(); __syncthreads();
        const int cq = tid & 63, seg = tid >> 6, w = 2 << u.pn;
        const LAS unsigned char* colp = lds + cq * 8;
#define EP_RD4(rowi) ({ const v2u q_ = *(const LAS v2u*)(colp + (rowi) * PITCH); (f32x4){bflo(q_.x), bfhi(q_.x), bflo(q_.y), bfhi(q_.y)}; })
        f32x4 S = {0.f, 0.f, 0.f, 0.f};
        for (int d = 1; d < w; ++d) S = S + EP_RD4(16 + 32 * seg - d);
        const float invw = 1.0f / (float)w;
        bf16* pp = p + (size_t)(u.pm * 256 + 32 * seg) * 1024 + u.pn * 256 + 4 * cq;
        const int t0 = ((u.pm & 31) * 256) + 32 * seg;
#pragma unroll 4
        for (int r = 0; r < 32; ++r) {
            const int lr = 16 + 32 * seg + r;
            const f32x4 uc = EP_RD4(lr);
            S = S + uc;
            const int t = t0 + r; const float inv = (t + 1 >= w) ? invw : 1.0f / (float)(t + 1);
            const f32x4 o = S * inv - uc;
            *(GAS v2u*)(pp + (size_t)r * 1024) = (v2u){pk2(o[0], o[1]), pk2(o[2], o[3])};
            S = S - EP_RD4(lr - (w - 1));
        }
#undef EP_RD4
        LDS_WAIT(); __syncthreads();
    }
};

struct Frame {
    LAS unsigned char* lds;
    int tid, lane, wave, vcu, G;
};
__device__ __forceinline__ float wave_sum(float v) {
#pragma unroll
    for (int o = 1; o < 64; o <<= 1) v += __shfl_xor(v, o);
    return v;
}

constexpr int LDS_RSTAB = 131072 + 4096;
__device__ __forceinline__ pg8::RsTab fill_rstd_tab(LAS unsigned char* lds, const float* ss, int pm) {
    LAS float* tab = (LAS float*)(lds + LDS_RSTAB);
    int tid = threadIdx.x; asm volatile("" : "+v"(tid));
    if (tid < 256) { const float* p = ss + ((size_t)pm * 256 + tid) * 16; float s = 0.f;
#pragma unroll
        for (int q = 0; q < 4; ++q) { const f32x4 v = *(const GAS f32x4*)(p + 4 * q); s += (v[0] + v[1]) + (v[2] + v[3]); }
        tab[tid] = rsqrtf(s * (1.0f / 1024.0f) + 1e-6f); }
    LDS_WAIT(); __syncthreads();
    pg8::RsTab r; r.tab = tab; r.pm = pm; return r;
}

__device__ __forceinline__ const LAS float* seg_fill(LAS unsigned char* lds, const float* lse, int pm) {
    LAS float* tab = (LAS float*)(lds + LDS_RSTAB);
    int tid = threadIdx.x; asm volatile("" : "+v"(tid));
    if (tid < 256) { const float* p = lse + ((size_t)pm * 256 + tid) * 16; float L[16];
#pragma unroll
        for (int q4 = 0; q4 < 4; ++q4) { const f32x4 v = *(const GAS f32x4*)(p + 4 * q4); L[4 * q4] = v[0]; L[4 * q4 + 1] = v[1]; L[4 * q4 + 2] = v[2]; L[4 * q4 + 3] = v[3]; }
        float lg0, lg1, lg2;
        { float mx = L[0];
_Pragma("unroll") for (int i = 1; i < 6; ++i) mx = fmaxf(mx, L[i]); float s = 0.f;
_Pragma("unroll") for (int i = 0; i < 6; ++i) s += __expf(L[i] - mx); lg0 = mx + __logf(s) - 1.791759469228055f; }
        { float mx = L[6];
_Pragma("unroll") for (int i = 7; i < 11; ++i) mx = fmaxf(mx, L[i]); float s = 0.f;
_Pragma("unroll") for (int i = 6; i < 11; ++i) s += __expf(L[i] - mx); lg1 = mx + __logf(s) - 1.6094379124341003f; }
        { float mx = L[11];
_Pragma("unroll") for (int i = 12; i < 16; ++i) mx = fmaxf(mx, L[i]); float s = 0.f;
_Pragma("unroll") for (int i = 11; i < 16; ++i) s += __expf(L[i] - mx); lg2 = mx + __logf(s) - 1.6094379124341003f; }
        const float mx = fmaxf(lg0, fmaxf(lg1, lg2));
        const float e0 = __expf(lg0 - mx), e1 = __expf(lg1 - mx), e2 = __expf(lg2 - mx); const float is = 3.0f / (e0 + e1 + e2);
        const float s0 = fmaxf(e0 * is, 1e-30f), s1 = fmaxf(e1 * is, 1e-30f), s2 = fmaxf(e2 * is, 1e-30f);
        tab[tid] = s0 / s1; tab[256 + tid] = s1 / s2; tab[512 + tid] = s2; }
    LDS_WAIT(); __syncthreads();
    return tab;
}

__device__ __forceinline__ int p0_map_row(int mode, int sel, int row_off, int n) {
    if (mode == 0) return row_off + n;
    if (mode == 1) return 256 * (n >> 7) + 128 * sel + (n & 127);
    const int pn = n >> 8, w = n & 255, wc = w >> 6, d = w & 63; return 256 * pn + 128 * (d >> 5) + 32 * wc + (d & 31);
}
__device__ __forceinline__ void p0_tr_item(const float* W, int K, int N, bf16* WT, int mode, int sel, int row_off, const float* kgain, const float* nscale, LAS unsigned* scr, int item, int lane) {
    const int nblk = N / 64, kb = item / nblk, nb = item % nblk, k0 = 64 * kb, n0 = 64 * nb;
    const int kq = lane >> 4, n4 = (lane & 15) * 4;
    f32x4 ns = (f32x4){1.f, 1.f, 1.f, 1.f}; if (nscale) ns = *(const GAS f32x4*)(nscale + n0 + n4);
    f32x4 v[16];
#pragma unroll
    for (int i = 0; i < 16; ++i) { const int k = 8 * (i >> 1) + 2 * kq + (i & 1); v[i] = *(const GAS f32x4*)(W + (size_t)(k0 + k) * N + n0 + n4); }
    if (kgain) {
#pragma unroll
        for (int i = 0; i < 16; ++i) { const int k = 8 * (i >> 1) + 2 * kq + (i & 1); v[i] = v[i] * kgain[k0 + k]; }
    }
#pragma unroll
    for (int ip = 0; ip < 8; ++ip) { const f32x4 e = v[2 * ip] * ns, o = v[2 * ip + 1] * ns;
#pragma unroll
        for (int c = 0; c < 4; ++c) scr[(n4 + c) * 33 + 4 * ip + kq] = pk2(e[c], o[c]); }
    LDS_WAIT(); asm volatile("" ::: "memory");
    const int kc = lane & 7;
#pragma unroll
    for (int jj = 0; jj < 8; ++jj) { const int n = (lane >> 3) + 8 * jj; const LAS unsigned* sp = scr + n * 33 + 4 * kc;
        v4u o; o.x = sp[0]; o.y = sp[1]; o.z = sp[2]; o.w = sp[3];
        *(GAS v4u*)(WT + (size_t)p0_map_row(mode, sel, row_off, n0 + n) * K + k0 + 8 * kc) = o; }
    LDS_WAIT(); asm volatile("" ::: "memory");
}

struct Args { const float* in[13]; float* out; unsigned char* ws; int ph_lo, ph_hi; };

__device__ __forceinline__ void sincos_acc(float angf, float& c, float& s) {
    const double x = (double)angf; const double k = __builtin_rint(x * 0.15915494309189535);
    double y = (x - k * 6.283185307179586) * 0.25;
    const double y2 = y * y;
    double sn = y * (1.0 + y2 * (-1.0 / 6 + y2 * (1.0 / 120 + y2 * (-1.0 / 5040 + y2 * (1.0 / 362880 + y2 * (-1.0 / 39916800 + y2 * (1.0 / 6227020800.0)))))));
    double cs = 1.0 + y2 * (-0.5 + y2 * (1.0 / 24 + y2 * (-1.0 / 720 + y2 * (1.0 / 40320 + y2 * (-1.0 / 3628800 + y2 * (1.0 / 479001600.0 + y2 * (-1.0 / 87178291200.0)))))));
#pragma unroll
    for (int i = 0; i < 2; ++i) { const double s2 = 2.0 * sn * cs, c2 = 1.0 - 2.0 * sn * sn; sn = s2; cs = c2; }
    c = (float)cs; s = (float)sn;
}

template <int GI>
__device__ __forceinline__ void pool_group(f32x4 (&cur)[16], f32x4 (&prev)[16], f32x4& S2, f32x4& S4, f32x4& S8, f32x4& S16, const f32x4 gv, const float* x, bf16* hp,
                                           int R0, bool bstart, int c4, int hl, int lane, int wq, LAS float* part, LAS float* rs) {
    const bool zero = (GI == 0) && bstart;
#pragma unroll
    for (int j = 0; j < 16; ++j) { const f32x4 v = cur[j]; part[j * 256 + hl] = (v[0] * v[0] + v[1] * v[1]) + (v[2] * v[2] + v[3] * v[3]); }
    LDS_WAIT(); __syncthreads();
#pragma unroll
    for (int q = 0; q < 4; ++q) { const int j = 4 * wq + q; const f32x4 p = *(const LAS f32x4*)(part + j * 256 + 4 * lane);
        const float s = wave_sum((p[0] + p[1]) + (p[2] + p[3])); if (lane == 0) rs[j] = zero ? 0.f : rsqrtf(s * (1.0f / D) + 1e-6f); }
    LDS_WAIT(); __syncthreads();
#pragma unroll
    for (int j = 0; j < 16; ++j) {
        const int row = R0 - 16 + GI * 16 + j;
        const f32x4 hv = cur[j] * rs[j] * gv;
        const f32x4 h2 = j >= 2 ? cur[j >= 2 ? j - 2 : 0] : prev[(j + 14) & 15], h4 = j >= 4 ? cur[j >= 4 ? j - 4 : 0] : prev[(j + 12) & 15], h8 = j >= 8 ? cur[j >= 8 ? j - 8 : 0] : prev[(j + 8) & 15];
        S2 = S2 + hv - h2; S4 = S4 + hv - h4; S8 = S8 + hv - h8; S16 = S16 + hv - prev[j];
        cur[j] = hv;
        if (GI < 2) prev[j] = *(const GAS f32x4*)(x + (size_t)(row + 16) * D + 4 * c4);
        if (GI > 0) {
            const int t = row & (SEQ - 1);
            const float i2 = t >= 1 ? 0.5f : 1.0f, i4 = t >= 3 ? 0.25f : 1.0f / (float)(t + 1), i8 = t >= 7 ? 0.125f : 1.0f / (float)(t + 1), i16 = t >= 15 ? 0.0625f : 1.0f / (float)(t + 1);
            const f32x4 o2 = S2 * i2 - hv, o4 = S4 * i4 - hv, o8 = S8 * i8 - hv, o16 = S16 * i16 - hv;
            const size_t off = (size_t)row * D + 4 * c4;
            *(GAS v2u*)(hp + off) = (v2u){pk2(o2[0], o2[1]), pk2(o2[2], o2[3])};
            *(GAS v2u*)(hp + (size_t)M * D + off) = (v2u){pk2(o4[0], o4[1]), pk2(o4[2], o4[3])};
            *(GAS v2u*)(hp + 2 * (size_t)M * D + off) = (v2u){pk2(o8[0], o8[1]), pk2(o8[2], o8[3])};
            *(GAS v2u*)(hp + 3 * (size_t)M * D + off) = (v2u){pk2(o16[0], o16[1]), pk2(o16[2], o16[3])};
        }
    }
}

constexpr int I_SQ = 16 * 16, I_GU = 16 * 44, I_DN = 44 * 16, I_QKV = 16 * 48, I_W2 = 4 * 32 * 8;
constexpr int W_EARLY = I_W2 + I_SQ + 2 * I_GU, W_ITEMS = W_EARLY + I_DN + I_QKV + I_SQ + 2 * I_GU + I_DN;
__device__ __forceinline__ void w2_item(const Args& a, int it, int lane) {
    typedef float f32x16 __attribute__((ext_vector_type(16)));
    const int g = it >> 8, r = it & 255, n0 = (r >> 3) * 32, c0 = (r & 7) * 32, i = lane & 31, h = lane >> 5;
    const float* wout = a.in[7] + (size_t)(g * 256) * 1024 + n0 + i;
    const float* wgr = a.in[5] + (size_t)g * 65536 + (size_t)(c0 + i) * 256;
    const float* sc = a.in[6] + g * 256;
    f32x16 acc = {0.f, 0.f, 0.f, 0.f, 0.f, 0.f, 0.f, 0.f, 0.f, 0.f, 0.f, 0.f, 0.f, 0.f, 0.f, 0.f};
#pragma unroll 1
    for (int ch = 0; ch < 4; ++ch) {
        float av[4][8]; f32x4 bv[4][2], sv[4][2];
#pragma unroll
        for (int ks = 0; ks < 4; ++ks) { const int j0 = 64 * ch + 16 * ks + 8 * h;
#pragma unroll
            for (int e = 0; e < 8; ++e) av[ks][e] = wout[(size_t)(j0 + e) * 1024];
            bv[ks][0] = *(const GAS f32x4*)(wgr + j0); bv[ks][1] = *(const GAS f32x4*)(wgr + j0 + 4);
            sv[ks][0] = *(const GAS f32x4*)(sc + j0); sv[ks][1] = *(const GAS f32x4*)(sc + j0 + 4); }
        asm volatile("" ::: "memory"); __builtin_amdgcn_sched_barrier(0);
#pragma unroll
        for (int ks = 0; ks < 4; ++ks) {
            pg8::u32x4 aw, bw; const f32x4 b0 = bv[ks][0] * sv[ks][0], b1 = bv[ks][1] * sv[ks][1];
            aw.x = pg8::cvt_pk_bf16(av[ks][0], av[ks][1]); aw.y = pg8::cvt_pk_bf16(av[ks][2], av[ks][3]); aw.z = pg8::cvt_pk_bf16(av[ks][4], av[ks][5]); aw.w = pg8::cvt_pk_bf16(av[ks][6], av[ks][7]);
            bw.x = pg8::cvt_pk_bf16(b0[0], b0[1]); bw.y = pg8::cvt_pk_bf16(b0[2], b0[3]); bw.z = pg8::cvt_pk_bf16(b1[0], b1[1]); bw.w = pg8::cvt_pk_bf16(b1[2], b1[3]);
            acc = __builtin_amdgcn_mfma_f32_32x32x16_bf16(__builtin_bit_cast(pg8::bf16x8, aw), __builtin_bit_cast(pg8::bf16x8, bw), acc, 0, 0, 0);
        }
    }
    bf16* W2T = (bf16*)(a.ws + WS_WPO) + (size_t)n0 * 1024 + g * 256 + c0 + i;
#pragma unroll
    for (int rr = 0; rr < 16; ++rr) W2T[(size_t)((rr & 3) + 8 * (rr >> 2) + 4 * h) * 1024] = (bf16)f2bf(acc[rr]);
}
__device__ __forceinline__ void weight_item(const Args& a, int it, LAS unsigned* scr, int lane) {
    unsigned char* ws = a.ws; const float* norm_mix = a.in[1]; const float* norm_ffn = a.in[2];
    int r = it;
    if (r < I_W2) { w2_item(a, r, lane); return; } r -= I_W2;
    if (r < I_SQ) { p0_tr_item(a.in[4], D, D, (bf16*)(ws + WS_WIN), 0, 0, 0, nullptr, nullptr, scr, r, lane); return; } r -= I_SQ;
    if (r < I_GU) { p0_tr_item(a.in[10], D, FF, (bf16*)(ws + WS_WGU0), 1, 0, 0, norm_ffn, nullptr, scr, r, lane); return; } r -= I_GU;
    if (r < I_GU) { p0_tr_item(a.in[11], D, FF, (bf16*)(ws + WS_WGU0), 1, 1, 0, norm_ffn, nullptr, scr, r, lane); return; } r -= I_GU;
    if (r < I_DN) { p0_tr_item(a.in[12], FF, D, (bf16*)(ws + WS_WD0), 0, 0, 0, nullptr, nullptr, scr, r, lane); return; } r -= I_DN;
    if (r < I_QKV) { p0_tr_item(a.in[8], D, 3 * D, (bf16*)(ws + WS_WQKV), 2, 0, 0, norm_mix + D, nullptr, scr, r, lane); return; } r -= I_QKV;
    if (r < I_SQ) { p0_tr_item(a.in[9], D, D, (bf16*)(ws + WS_WAO), 0, 0, 0, nullptr, nullptr, scr, r, lane); return; } r -= I_SQ;
    if (r < I_GU) { p0_tr_item(a.in[10] + (size_t)D * FF, D, FF, (bf16*)(ws + WS_WGU1), 1, 0, 0, norm_ffn + D, nullptr, scr, r, lane); return; } r -= I_GU;
    if (r < I_GU) { p0_tr_item(a.in[11] + (size_t)D * FF, D, FF, (bf16*)(ws + WS_WGU1), 1, 1, 0, norm_ffn + D, nullptr, scr, r, lane); return; } r -= I_GU;
    p0_tr_item(a.in[12] + (size_t)D * FF, FF, D, (bf16*)(ws + WS_WD1), 0, 0, 0, nullptr, nullptr, scr, r, lane);
}
__device__ __forceinline__ void rope_entries(unsigned char* ws, int first, int stride) {
    float* rope = (float*)(ws + WS_ROPE);
    for (int e = first; e < SEQ * 32; e += stride) {
        const int t = e >> 5, j = e & 31;
        const float invf = (float)(1.0 / (double)(float)exp2(13.287712379549449 * (double)j / 32.0));
        const float ang = (float)t * invf; float c, s; sincos_acc(ang, c, s);
        rope[(size_t)t * 64 + j] = c; rope[(size_t)t * 64 + 32 + j] = s;
    }
}
__device__ __forceinline__ void late_prep(const Args& a0, LAS unsigned char* lds, int widx, int nidle) {
    Args a = a0;
#pragma unroll
    for (int i = 0; i < 13; ++i) asm volatile("" : "+s"(a.in[i]));
    asm volatile("" : "+s"(a.ws));
    int tid = threadIdx.x; asm volatile("" : "+v"(tid)); const int lane = tid & 63, wave = __builtin_amdgcn_readfirstlane(tid >> 6);
    LAS unsigned* scr = (LAS unsigned*)(lds + wave * 16384);
    for (int it = W_EARLY + widx * NWAVES + wave; it < W_ITEMS; it += nidle * NWAVES) weight_item(a, it, scr, lane);
}

__device__ __forceinline__ void p0_prologue(const Frame& F0, const Args& a, bool defer_late, bool pool_epi) {
    Frame F = F0; { int tid = threadIdx.x; asm volatile("" : "+v"(tid)); F.tid = tid; F.lane = tid & 63; F.wave = __builtin_amdgcn_readfirstlane(tid >> 6); }
    unsigned char* ws = a.ws;
    LAS unsigned* scr = (LAS unsigned*)(F.lds + F.wave * 16384);
    const int gw = F.vcu * NWAVES + F.wave, NGW = F.G * NWAVES;
    const float* norm_mix = a.in[1];
    const int n_items = defer_late ? W_EARLY : W_ITEMS;
    if (NGW == 2048 && n_items <= 3072) {
        if (gw < n_items) weight_item(a, gw, scr, F.lane);
        if (gw >= 1024 && 1024 + gw < n_items) weight_item(a, 1024 + gw, scr, F.lane);
    } else { for (int it = gw; it < n_items; it += NGW) weight_item(a, it, scr, F.lane); }
    rope_entries(ws, F.vcu * NWAVES * 64 + F.tid, F.G * NWAVES * 64);
    __syncthreads();
    if (pool_epi) {
        const float* x = a.in[0]; bf16* hb = (bf16*)(ws + WS_BIG); bf16* xb0 = (bf16*)(ws + WS_XB);
        f32x4 gv[4];
#pragma unroll
        for (int j = 0; j < 4; ++j) gv[j] = *(const GAS f32x4*)(norm_mix + 4 * F.lane + 256 * j);
        const int gwr = F.vcu * NWAVES + F.wave;
        for (int m = gwr; m < M; m += 2 * NGW) {
            const int m2 = (m + NGW < M) ? m + NGW : m;
            const GAS f32x4* x1 = (const GAS f32x4*)(x + (size_t)m * D) + F.lane; const GAS f32x4* x2 = (const GAS f32x4*)(x + (size_t)m2 * D) + F.lane;
            f32x4 v[4], w2[4]; float s1 = 0.f, s2 = 0.f;
#pragma unroll
            for (int j = 0; j < 4; ++j) { v[j] = x1[64 * j]; w2[j] = x2[64 * j]; }
#pragma unroll
            for (int j = 0; j < 4; ++j) { s1 += (v[j][0] * v[j][0] + v[j][1] * v[j][1]) + (v[j][2] * v[j][2] + v[j][3] * v[j][3]); s2 += (w2[j][0] * w2[j][0] + w2[j][1] * w2[j][1]) + (w2[j][2] * w2[j][2] + w2[j][3] * w2[j][3]); }
            const float r1 = rsqrtf(wave_sum(s1) * (1.0f / D) + 1e-6f), r2 = rsqrtf(wave_sum(s2) * (1.0f / D) + 1e-6f);
            GAS v2u* o1 = (GAS v2u*)(hb + (size_t)m * D) + F.lane; GAS v2u* o2 = (GAS v2u*)(hb + (size_t)m2 * D) + F.lane;
            GAS v2u* y1 = (GAS v2u*)(xb0 + (size_t)m * D) + F.lane; GAS v2u* y2 = (GAS v2u*)(xb0 + (size_t)m2 * D) + F.lane;
#pragma unroll
            for (int j = 0; j < 4; ++j) { const f32x4 a1 = v[j] * r1 * gv[j], a2 = w2[j] * r2 * gv[j];
                o1[64 * j] = (v2u){pk2(a1[0], a1[1]), pk2(a1[2], a1[3])}; o2[64 * j] = (v2u){pk2(a2[0], a2[1]), pk2(a2[2], a2[3])};
                y1[64 * j] = (v2u){pk2(v[j][0], v[j][1]), pk2(v[j][2], v[j][3])}; y2[64 * j] = (v2u){pk2(w2[j][0], w2[j][1]), pk2(w2[j][2], w2[j][3])}; }
        }
    } else
    {
        const float* x = a.in[0]; const float* g0 = norm_mix;
        bf16* hp = (bf16*)(ws + WS_BIG);
        const int half = F.tid >> 8, c4 = F.tid & 255, hl = c4, wq = F.wave & 3;
        LAS float* part = (LAS float*)(F.lds) + half * (16 * 256);
        LAS float* rs = (LAS float*)(F.lds + 32768) + half * 16;
        const f32x4 gv = *(const GAS f32x4*)(g0 + 4 * c4);
        for (int blk = F.vcu; blk < M / 64; blk += F.G) {
            const int R0 = blk * 64 + half * 32;
            const bool bstart = (R0 & (SEQ - 1)) == 0;
            f32x4 A[16], B[16];
#pragma unroll
            for (int j = 0; j < 16; ++j) { B[j] = (f32x4){0.f, 0.f, 0.f, 0.f}; A[j] = B[j]; if (!bstart) A[j] = *(const GAS f32x4*)(x + (size_t)(R0 - 16 + j) * D + 4 * c4); }
            f32x4 S2 = B[0], S4 = B[0], S8 = B[0], S16 = B[0];
            pool_group<0>(A, B, S2, S4, S8, S16, gv, x, hp, R0, bstart, c4, hl, F.lane, wq, part, rs);
            pool_group<1>(B, A, S2, S4, S8, S16, gv, x, hp, R0, bstart, c4, hl, F.lane, wq, part, rs);
            pool_group<2>(A, B, S2, S4, S8, S16, gv, x, hp, R0, bstart, c4, hl, F.lane, wq, part, rs);
            __syncthreads();
        }
    }
}

namespace att {
typedef short bf16x8 __attribute__((ext_vector_type(8)));
typedef short s16x4 __attribute__((ext_vector_type(4)));
typedef float f32x16 __attribute__((ext_vector_type(16)));
typedef unsigned u32x4 __attribute__((ext_vector_type(4)));
constexpr int KCH = 6160;
constexpr int LDS_K = 0, LDS_V = 8 * KCH, VDH = 24 * 1024 + 64, LDS_OST = LDS_V + 2 * VDH, LDS_TOTAL = LDS_OST + 8 * 4096;
static_assert(LDS_TOTAL <= LDS_BYTES, "attention LDS");
__device__ __forceinline__ int crow(int r, int hi) { return (r & 3) + 8 * (r >> 2) + 4 * hi; }
__device__ __forceinline__ s16x4 vtr(const LAS unsigned char* p) { return __builtin_bit_cast(s16x4, __builtin_amdgcn_ds_read_tr16_b64_v4i16((LAS s16x4*)p)); }
struct KVQ { u32x4 k[6], v[6]; bf16x8 q[4]; };
__device__ __forceinline__ void attn_load(int item, const bf16* Qp, const bf16* Kp, const bf16* Vp, KVQ& R, int tid, int wid, int r32, int hi) {
    const int bh = item >> 5, j = item & 31, h = bh & 15;
    const int dsh = h < 6 ? 0 : (h < 11 ? 2 : 4);
    const bool first = (j & ((32 >> dsh) - 1)) == 0;
    const size_t hb = (size_t)bh * (SEQ * 64);
    const int pos0 = j * 256;
#pragma unroll
    for (int it = 0; it < 6; ++it) {
        const int p = tid + 512 * it, key = p >> 3, c = p & 7;
        const int keyc = (first && key < 128) ? 128 : key;
        const size_t go = hb + (size_t)(pos0 - 128 + keyc) * 64 + c * 8; R.k[it] = *(const GAS u32x4*)(Kp + go); R.v[it] = *(const GAS u32x4*)(Vp + go);
    }
#pragma unroll
    for (int d0 = 0; d0 < 4; ++d0) R.q[d0] = *(const GAS bf16x8*)(Qp + hb + (size_t)(pos0 + 32 * wid + r32) * 64 + d0 * 16 + hi * 8);
}
__device__ __forceinline__ void attn_phase(int item0, int nitems, const bf16* Qp, const bf16* Kp, const bf16* Vp, bf16* O, float* lse, LAS unsigned char* shm) {
    int tid = threadIdx.x; asm volatile("" : "+v"(tid));
    const int wid = __builtin_amdgcn_readfirstlane(tid >> 6);
    KVQ R;
    if (nitems > 0) attn_load(item0, Qp, Kp, Vp, R, tid, wid, tid & 31, (tid & 63) >> 5);
#pragma unroll 1
  for (int ii = 0; ii < nitems; ++ii) {
    asm volatile("" : "+v"(tid));
    const int lane = tid & 63, r32 = lane & 31, hi = lane >> 5;
    const int item = item0 + ii, bh = item >> 5, j = item & 31;
    const int b = bh >> 4, h = bh & 15;
    const int dsh = h < 6 ? 0 : (h < 11 ? 2 : 4);
    const int nqb = 32 >> dsh, r = j >> (5 - dsh), qb = j & (nqb - 1);
    const bool first = (qb == 0);
#pragma unroll
    for (int it = 0; it < 6; ++it) {
        const int p = tid + 512 * it, key = p >> 3, c = p & 7;
        const bool dead = first && key < 128; const u32x4 z4 = (u32x4){0u, 0u, 0u, 0u};
        *(LAS u32x4*)(shm + LDS_K + c * KCH + key * 16) = dead ? z4 : R.k[it];
        *(LAS u32x4*)(shm + LDS_V + (c >> 2) * VDH + (key >> 4) * 1024 + (key & 15) * 64 + (c & 3) * 16) = dead ? z4 : R.v[it];
    }
    bf16x8 qr[4];
#pragma unroll
    for (int d0 = 0; d0 < 4; ++d0) qr[d0] = R.q[d0];
    LDS_WAIT(); __syncthreads();
    if (ii + 1 < nitems) attn_load(item + 1, Qp, Kp, Vp, R, tid, wid, r32, hi);
    f32x16 P[5];
    const LAS unsigned char* kbase = shm + LDS_K + hi * KCH + (32 * wid + r32) * 16;
#pragma unroll
    for (int kt = 0; kt < 5; ++kt) {
        f32x16 acc = {0.f, 0.f, 0.f, 0.f, 0.f, 0.f, 0.f, 0.f, 0.f, 0.f, 0.f, 0.f, 0.f, 0.f, 0.f, 0.f};
#pragma unroll
        for (int d0 = 0; d0 < 4; ++d0) { const bf16x8 kf = *(const LAS bf16x8*)(kbase + (2 * d0) * KCH + kt * 512); acc = __builtin_amdgcn_mfma_f32_32x32x16_bf16(kf, qr[d0], acc, 0, 0, 0); }
        P[kt] = acc;
    }
    const float NEG = -INFINITY;
    const int lowlim = first ? (128 - 32 * wid) : 0;
    const int lo0 = r32 > lowlim ? r32 : lowlim;
#pragma unroll
    for (int rr = 0; rr < 16; ++rr) { const int cr = crow(rr, hi); if (cr < lo0) P[0][rr] = NEG; if (cr > r32) P[4][rr] = NEG; }
    if (first) {
#pragma unroll
        for (int kt = 1; kt < 4; ++kt)
#pragma unroll
            for (int rr = 0; rr < 16; ++rr) if (32 * kt + crow(rr, hi) < lowlim) P[kt][rr] = NEG;
    }
    float mx = NEG;
#pragma unroll
    for (int kt = 0; kt < 5; ++kt)
#pragma unroll
        for (int rr = 0; rr < 16; ++rr) mx = fmaxf(mx, P[kt][rr]);
    mx = fmaxf(mx, __shfl_xor(mx, 32));
    float l = 0.f;
#pragma unroll
    for (int kt = 0; kt < 5; ++kt)
#pragma unroll
        for (int rr = 0; rr < 16; ++rr) { const float e = __builtin_amdgcn_exp2f(P[kt][rr] - mx); P[kt][rr] = e; l += e; }
    l += __shfl_xor(l, 32);
    const float inv = __builtin_amdgcn_rcpf(l);
    {
        const int i = qb * 256 + 32 * wid + r32, t = (i << dsh) + r;
        if (hi == 0) lse[((size_t)b * SEQ + t) * 16 + h] = (mx + __log2f(l)) * 0.6931471805599453f;
    }
    f32x16 o[2];
    o[0] = (f32x16){0.f, 0.f, 0.f, 0.f, 0.f, 0.f, 0.f, 0.f, 0.f, 0.f, 0.f, 0.f, 0.f, 0.f, 0.f, 0.f}; o[1] = o[0];
    const LAS unsigned char* vb = shm + LDS_V + ((lane >> 4) & 1) * 32 + (lane & 3) * 8 + (4 * hi + ((lane & 15) >> 2)) * 64;
#pragma unroll
    for (int kt = 0; kt < 5; ++kt)
#pragma unroll
        for (int s = 0; s < 2; ++s) {
            u32x4 pw;
            pw.x = pg8::cvt_pk_bf16(P[kt][8 * s + 0] * inv, P[kt][8 * s + 1] * inv); pw.y = pg8::cvt_pk_bf16(P[kt][8 * s + 2] * inv, P[kt][8 * s + 3] * inv);
            pw.z = pg8::cvt_pk_bf16(P[kt][8 * s + 4] * inv, P[kt][8 * s + 5] * inv); pw.w = pg8::cvt_pk_bf16(P[kt][8 * s + 6] * inv, P[kt][8 * s + 7] * inv);
            const bf16x8 pa = __builtin_bit_cast(bf16x8, pw);
            const int kblk = 2 * wid + 2 * kt + s;
#pragma unroll
            for (int dh = 0; dh < 2; ++dh) {
                const s16x4 vlo = vtr(vb + dh * VDH + kblk * 1024), vhi = vtr(vb + dh * VDH + kblk * 1024 + 512);
                const bf16x8 vf = (bf16x8){vlo[0], vlo[1], vlo[2], vlo[3], vhi[0], vhi[1], vhi[2], vhi[3]};
                o[dh] = __builtin_amdgcn_mfma_f32_32x32x16_bf16(pa, vf, o[dh], 0, 0, 0);
            }
        }
    {
        LAS bf16* stg = (LAS bf16*)(shm + LDS_OST + wid * 4096);
#pragma unroll
        for (int rr = 0; rr < 16; ++rr) { const int orow = crow(rr, hi);
#pragma unroll
            for (int dh = 0; dh < 2; ++dh) stg[orow * 64 + dh * 32 + r32] = (bf16)f2bf(o[dh][rr]); }
        LDS_WAIT(); asm volatile("" ::: "memory");
#pragma unroll
        for (int i4 = 0; i4 < 4; ++i4) { const int row = i4 * 8 + (lane >> 3), ch = lane & 7; const u32x4 v = *(const LAS u32x4*)(stg + row * 64 + ch * 8);
            const int i = qb * 256 + 32 * wid + row, t = (i << dsh) + r;
            *(GAS u32x4*)(O + ((size_t)b * SEQ + t) * D + h * 64 + ch * 8) = v; }
    }
    LDS_WAIT(); __syncthreads();
  }
}
}

__global__ void __launch_bounds__(NWAVES * 64, 2) fwd_megakernel(Args args) {
    extern __shared__ __attribute__((aligned(16))) unsigned char lds[];
    Frame F;
    F.lds = (LAS unsigned char*)lds;
    F.tid = threadIdx.x; F.lane = F.tid & 63; F.wave = __builtin_amdgcn_readfirstlane(F.tid >> 6);
    F.G = gridDim.x; { const int bx = blockIdx.x; F.vcu = (F.G % 8 == 0) ? (bx % 8) * (F.G / 8) + bx / 8 : bx; }
    unsigned char* ws = args.ws;
    const int lo = args.ph_lo, hi = args.ph_hi;
    const bool one_launch = (hi - lo) > 1;
    volatile LAS unsigned* bst = (volatile LAS unsigned*)(F.lds + LDS_BYTES - 64);
    if (F.tid < 2) bst[F.tid] = 0u;
    __syncthreads();
    XcdBarrier bar; bar.bar = (unsigned*)(ws + WS_CTL) + CW_BAR; bar.x = 0; bar.st = bst;
    if (one_launch) bar = xcd_barrier_post((unsigned*)(ws + WS_CTL) + CW_BAR, bst);
#define IN(k) (lo <= (k) && (k) < hi)
#define SEAM(k) do { if (IN(k) && IN((k) + 1)) { xcd_barrier(bar); } } while (0)

    if (lo < 0) cg::this_grid().sync();
    float* resid = args.out;
    float* ssb = (float*)(ws + WS_SS);
    bf16* xb = (bf16*)(ws + WS_XB);
    bf16* zo = (bf16*)(ws + WS_ZO);
    bf16* big = (bf16*)(ws + WS_BIG);

    bool fused_done = false;
    const bool defer_late = one_launch && IN(0) && IN(4) && (F.G == 256);
    const bool pool_epi = (F.G == 256);
    if (IN(0)) { p0_prologue(F, args, defer_late, pool_epi); }
    SEAM(0);
    if (IN(1)) {
        pg8::StaticOrder S; S.init(M, D, F.G, (int)blockIdx.x);
        if (pool_epi) { pg8::Gemm g{big, (const bf16*)(ws + WS_WIN), M, D, D, D, D, 0};
            EpiPool E{F.lds, big, (const bf16*)(ws + WS_WIN), zo, (bf16*)(ws + WS_HALO), (unsigned*)(ws + WS_CTL) + CW_HALO, bar.bar};
            pg8::gemm_phase<EpiPool, pg8::StaticOrder, true, false, true>(F.lds, g, S, E); }
        else { pg8::Gemm g{big, (const bf16*)(ws + WS_WIN), M, D, D, D, D, (size_t)M * D * 2};
            pg8::EpiBf16 E{zo, D};
            pg8::gemm_phase<pg8::EpiBf16, pg8::StaticOrder, true>(F.lds, g, S, E); }
    }
    SEAM(1);
    if (IN(3)) {
        pg8::Gemm g{zo, (const bf16*)(ws + WS_WPO), M, D, D, D, D, 0};
        pg8::StaticOrder S; S.init(M, D, F.G, (int)blockIdx.x);
        if (pool_epi) { pg8::EpiRes<false> E{nullptr, xb, ssb, nullptr};
            pg8::gemm_phase<pg8::EpiRes<false>, pg8::StaticOrder, true>(F.lds, g, S, E); }
        else { pg8::EpiRes<true> E{args.in[0], xb, ssb, nullptr};
            pg8::gemm_phase<pg8::EpiRes<true>, pg8::StaticOrder, true>(F.lds, g, S, E); }
    }
    SEAM(3);
#pragma unroll 1
    for (int layer = 0; layer < 2; ++layer) {
        const int pb = layer == 0 ? 4 : 10;
        if (IN(pb)) {
            pg8::Gemm g{xb, (const bf16*)(ws + (layer == 0 ? WS_WGU0 : WS_WGU1)), M, 2 * FF, D, D, D, 0};
            pg8::StaticOrder S; S.init(M, 2 * FF, F.G, (int)blockIdx.x);
            pg8::Unit u0; const pg8::RsTab rt = fill_rstd_tab(F.lds, ssb, S.next(0, u0) ? u0.pm : 0);
            pg8::EpiSwiGLU E{big, ssb, FF, rt};
            pg8::gemm_phase<pg8::EpiSwiGLU, pg8::StaticOrder, true>(F.lds, g, S, E);
            if (layer == 0 && defer_late && (int)blockIdx.x >= 128) late_prep(args, F.lds, (int)blockIdx.x - 128, 128);
        }
        SEAM(pb);
#ifndef FUSE_FINAL
#define FUSE_FINAL 1
#endif
        const bool fuse_final = FUSE_FINAL && (layer == 1) && one_launch && IN(12) && (F.G == (M / 256) * (D / 256));
        if (IN(pb + 1)) {
            pg8::Gemm g{big, (const bf16*)(ws + (layer == 0 ? WS_WD0 : WS_WD1)), M, D, FF, FF, FF, 0};
            pg8::StaticOrder S; S.init(M, D, F.G, (int)blockIdx.x);
            if (fuse_final) { EpiFinal E{xb, resid, ssb, args.in[3], bar}; pg8::gemm_phase<EpiFinal, pg8::StaticOrder, true>(F.lds, g, S, E); }
            else { pg8::EpiRes<false> E{nullptr, xb, ssb, nullptr}; pg8::gemm_phase<pg8::EpiRes<false>, pg8::StaticOrder, true>(F.lds, g, S, E); }
        }
        if (fuse_final) { fused_done = true; break; }
        SEAM(pb + 1);
        if (layer == 0) {
            bf16* qb_ = big; bf16* kb_ = big + (size_t)M * D; bf16* vb_ = big + 2 * (size_t)M * D;
            if (IN(6)) {
                pg8::Gemm g{xb, (const bf16*)(ws + WS_WQKV), M, 3 * D, D, D, D, 0};
                pg8::StaticOrder S; S.init(M, 3 * D, F.G, (int)blockIdx.x);
                pg8::Unit u0; const pg8::RsTab rt = fill_rstd_tab(F.lds, ssb, S.next(0, u0) ? u0.pm : 0);
                pg8::EpiQKV E{qb_, ssb, (const float*)(ws + WS_ROPE), rt};
                pg8::gemm_phase<pg8::EpiQKV, pg8::StaticOrder, true>(F.lds, g, S, E);
            }
            SEAM(6);
            if (IN(7)) {
                const int ipw = (1024 + F.G - 1) / F.G;
                const int it0 = F.vcu * ipw, nit = it0 >= 1024 ? 0 : (1024 - it0 < ipw ? 1024 - it0 : ipw);
                att::attn_phase(it0, nit, qb_, kb_, vb_, zo, (float*)(ws + WS_LSE), F.lds);
            }
            SEAM(7);
            const bool merge_fused = one_launch && IN(8) && IN(9) && (F.G == (M / 256) * (D / 256));
            if (IN(8) && !merge_fused) {
                int tid8 = threadIdx.x; asm volatile("" : "+v"(tid8)); const int lane8 = tid8 & 63, wave8 = __builtin_amdgcn_readfirstlane(tid8 >> 6);
                const float* lse = (const float*)(ws + WS_LSE);
                for (int m = F.vcu * NWAVES + wave8; m < M; m += F.G * NWAVES) {
                    float L[16];
#pragma unroll
                    for (int q4 = 0; q4 < 4; ++q4) { const f32x4 v = *(const GAS f32x4*)(lse + (size_t)m * 16 + 4 * q4); L[4 * q4] = v[0]; L[4 * q4 + 1] = v[1]; L[4 * q4 + 2] = v[2]; L[4 * q4 + 3] = v[3]; }
                    float lg[3];
                    { float mx = L[0];
_Pragma("unroll") for (int i = 1; i < 6; ++i) mx = fmaxf(mx, L[i]); float s = 0.f;
_Pragma("unroll") for (int i = 0; i < 6; ++i) s += __expf(L[i] - mx); lg[0] = mx + __logf(s) - 1.791759469228055f; }
                    { float mx = L[6];
_Pragma("unroll") for (int i = 7; i < 11; ++i) mx = fmaxf(mx, L[i]); float s = 0.f;
_Pragma("unroll") for (int i = 6; i < 11; ++i) s += __expf(L[i] - mx); lg[1] = mx + __logf(s) - 1.6094379124341003f; }
                    { float mx = L[11];
_Pragma("unroll") for (int i = 12; i < 16; ++i) mx = fmaxf(mx, L[i]); float s = 0.f;
_Pragma("unroll") for (int i = 11; i < 16; ++i) s += __expf(L[i] - mx); lg[2] = mx + __logf(s) - 1.6094379124341003f; }
                    const float mx = fmaxf(lg[0], fmaxf(lg[1], lg[2]));
                    const float e0 = __expf(lg[0] - mx), e1 = __expf(lg[1] - mx), e2 = __expf(lg[2] - mx); const float is = 3.0f / (e0 + e1 + e2);
                    const int head = lane8 >> 2; const float sc = (head < 6 ? e0 : (head < 11 ? e1 : e2)) * is;
                    GAS v4u* p = (GAS v4u*)(zo + (size_t)m * D + 16 * lane8);
#pragma unroll
                    for (int q2 = 0; q2 < 2; ++q2) { v4u w = p[q2];
                        w.x = pk2(bflo(w.x) * sc, bfhi(w.x) * sc); w.y = pk2(bflo(w.y) * sc, bfhi(w.y) * sc); w.z = pk2(bflo(w.z) * sc, bfhi(w.z) * sc); w.w = pk2(bflo(w.w) * sc, bfhi(w.w) * sc);
                        p[q2] = w; }
                }
            }
            if (!merge_fused) SEAM(8);
            if (IN(9)) {
                pg8::Gemm g{zo, (const bf16*)(ws + WS_WAO), M, D, D, D, D, 0};
                pg8::StaticOrder S; S.init(M, D, F.G, (int)blockIdx.x);
                if (merge_fused) { pg8::Unit u0; const LAS float* st = seg_fill(F.lds, (const float*)(ws + WS_LSE), S.next(0, u0) ? u0.pm : 0);
                    pg8::EpiRes<false, true> E{nullptr, xb, ssb, st + 512};
                    pg8::gemm_phase<pg8::EpiRes<false, true>, pg8::StaticOrder, true, true>(F.lds, g, S, E, st); }
                else { pg8::EpiRes<false> E{nullptr, xb, ssb, nullptr};
                    pg8::gemm_phase<pg8::EpiRes<false>, pg8::StaticOrder, true>(F.lds, g, S, E); }
            }
            SEAM(9);
        }
    }
    if (IN(12) && !fused_done) {
        const float* gf = args.in[3];
        int tid12 = threadIdx.x; asm volatile("" : "+v"(tid12)); const int lane12 = tid12 & 63, wave12 = __builtin_amdgcn_readfirstlane(tid12 >> 6);
        for (int m = F.vcu * NWAVES + wave12; m < M; m += F.G * NWAVES) {
            float s = 0.f;
#pragma unroll
            for (int q4 = 0; q4 < 4; ++q4) { const f32x4 v = *(const GAS f32x4*)(ssb + (size_t)m * 16 + 4 * q4); s += (v[0] + v[1]) + (v[2] + v[3]); }
            const float rstd = rsqrtf(s * (1.0f / D) + 1e-6f);
            const GAS v4u* xr = (const GAS v4u*)(xb + (size_t)m * D + 16 * lane12);
            GAS f32x4* orow = (GAS f32x4*)(resid + (size_t)m * D + 16 * lane12);
#pragma unroll
            for (int q2 = 0; q2 < 2; ++q2) { const v4u w = xr[q2]; const GAS f32x4* gq = (const GAS f32x4*)(gf + 16 * lane12 + 8 * q2);
                orow[2 * q2] = (f32x4){bflo(w.x), bfhi(w.x), bflo(w.y), bfhi(w.y)} * rstd * gq[0];
                orow[2 * q2 + 1] = (f32x4){bflo(w.z), bfhi(w.z), bflo(w.w), bfhi(w.w)} * rstd * gq[1]; }
        }
    }
#undef IN
#undef SEAM
}

extern "C" void kernel_launch(void* const* d_in, const int* in_sizes, int n_in, void* d_out, int out_size, void* d_ws, size_t ws_size, hipStream_t stream) {
    static int grid = 0;
    if (grid == 0) {
        if (n_in != 13 || in_sizes[0] != M * D || out_size != M * D || ws_size < WS_END) { fprintf(stderr, "kernel_launch: unexpected shapes (n_in %d, in0 %d, out %d, ws %zu); nothing launched\n", n_in, n_in > 0 ? in_sizes[0] : -1, out_size, ws_size); grid = -1; return; }
        int dev = 0, cus = 0, per_cu = 0;
        if (hipGetDevice(&dev) != hipSuccess || hipDeviceGetAttribute(&cus, hipDeviceAttributeMultiprocessorCount, dev) != hipSuccess) { grid = -1; return; }
        if (hipFuncSetAttribute((const void*)fwd_megakernel, hipFuncAttributeMaxDynamicSharedMemorySize, LDS_BYTES) != hipSuccess) { fprintf(stderr, "kernel_launch: hipFuncSetAttribute failed\n"); grid = -1; return; }
        if (hipOccupancyMaxActiveBlocksPerMultiprocessor(&per_cu, (const void*)fwd_megakernel, NWAVES * 64, LDS_BYTES) != hipSuccess || per_cu < 1) { fprintf(stderr, "kernel_launch: occupancy query says %d blocks per CU\n", per_cu); per_cu = 1; }
        (void)hipGetLastError();
        grid = cus;
    }
    if (grid < 0) return;
    if (hipMemsetAsync((char*)d_ws + WS_CTL, 0, CTL_ZERO_BYTES, stream) != hipSuccess) { fprintf(stderr, "kernel_launch: memset failed\n"); return; }
    Args a{};
    for (int i = 0; i < 13; ++i) a.in[i] = (const float*)d_in[i];
    a.out = (float*)d_out; a.ws = (unsigned char*)d_ws;
#if MK_N_LAUNCHES == 1
    a.ph_lo = 0; a.ph_hi = 13;
    void* kargs[] = {&a};
    hipError_t e = hipLaunchCooperativeKernel((const void*)fwd_megakernel, dim3(grid), dim3(NWAVES * 64), kargs, LDS_BYTES, stream);
    if (e != hipSuccess) fprintf(stderr, "kernel_launch: cooperative launch failed: %s (grid %d)\n", hipGetErrorString(e), grid);
#else
    for (int p = 0; p < 13; ++p) { a.ph_lo = p; a.ph_hi = p + 1; hipLaunchKernelGGL(fwd_megakernel, dim3(grid), dim3(NWAVES * 64), LDS_BYTES, stream, a); }
#endif
}
```
